# Optimizing an MI355X kernel written in HIP

```python
import jax, jax.numpy as jnp
from jax import lax
import numpy as np

D_MODEL = 1024
BATCH = 8
SEQ = 2048
DEPTH = 1

CTX_LEN = 256
GRID_W = 64
HEAD_DIM = 64
MIX_WIDTH = D_MODEL
ATTN_HEADS = MIX_WIDTH // (2 * HEAD_DIM)
ATTN_KV_HEADS = ATTN_HEADS // 4
RET_HEADS = MIX_WIDTH // (2 * HEAD_DIM)
ATTN_W = ATTN_HEADS * HEAD_DIM
KV_W = ATTN_KV_HEADS * HEAD_DIM
RET_W = RET_HEADS * HEAD_DIM
Q_BLOCK = 128
RET_CHUNK = 128
ROPE_THETA = 10000.0
N_EXPERTS = 256
TOP_K = 8
N_GROUPS = 8
TOPK_GROUPS = 4
EXPERT_FF = D_MODEL // 4
SHARED_FF = D_MODEL // 4
ROUTED_SCALE = 2.5
MOE_BLOCK = 128
EPS = 1e-6

OFF_AK = 0
OFF_AV = OFF_AK + KV_W
OFF_RK = OFF_AV + KV_W
OFF_RV = OFF_RK + RET_W
CTX_KV_COLS = OFF_RV + RET_W
OFF_AQ = CTX_KV_COLS
OFF_RQ = OFF_AQ + ATTN_W
OFF_RG = OFF_RQ + RET_W
IN_COLS = OFF_RG + RET_W

kernel_name = "hymba_attn_retention_moe_dit_block"


def rms_norm(x, w):
    xf = x.astype(jnp.float32)
    y = xf * lax.rsqrt(jnp.mean(xf * xf, axis=-1, keepdims=True) + EPS)
    return (y * w.astype(jnp.float32)).astype(x.dtype)


def rms_unit(xf):
    return xf * lax.rsqrt(jnp.mean(xf * xf, axis=-1, keepdims=True) + EPS)


def modulate(h, shift, scale):
    return h * (1.0 + scale) + shift


def heads(z, off, n_heads):
    B, L = z.shape[:2]
    return z[..., off:off + n_heads * HEAD_DIM].reshape(B, L, n_heads, HEAD_DIM)


def flip(t):
    return jnp.flip(t, axis=1)


def axial_rope_tables(L):
    rows = L // GRID_W
    r = jnp.repeat(jnp.arange(rows), GRID_W).astype(jnp.float32)
    col = jnp.tile(jnp.arange(GRID_W), rows).astype(jnp.float32)
    n_f = HEAD_DIM // 4
    freqs = ROPE_THETA ** (-jnp.arange(n_f, dtype=jnp.float32) / n_f)
    ang = jnp.concatenate([r[:, None] * freqs, col[:, None] * freqs], axis=-1)
    return jnp.cos(ang), jnp.sin(ang)


def apply_rope(x, cos, sin):
    xf = x.astype(jnp.float32).reshape(*x.shape[:-1], HEAD_DIM // 2, 2)
    a, b = xf[..., 0], xf[..., 1]
    cs, sn = cos[None, :, None, :], sin[None, :, None, :]
    out = jnp.stack([a * cs - b * sn, a * sn + b * cs], axis=-1).reshape(x.shape)
    return out.astype(x.dtype)


def latent_attention(q, k, v, kc, vc):
    B, L = q.shape[:2]
    G = ATTN_HEADS // ATTN_KV_HEADS
    nb = L // Q_BLOCK
    scale = HEAD_DIM ** -0.5
    qb = q.reshape(B, nb, Q_BLOCK, ATTN_KV_HEADS, G, HEAD_DIM).transpose(1, 0, 2, 3, 4, 5)

    def one_block(qblk):
        s_lat = jnp.einsum('bqkgd,bskd->bkgqs', qblk, k, preferred_element_type=jnp.float32)
        s_ctx = jnp.einsum('bqkgd,bskd->bkgqs', qblk, kc, preferred_element_type=jnp.float32)
        p = jax.nn.softmax(jnp.concatenate([s_lat, s_ctx], axis=-1) * scale, axis=-1).astype(v.dtype)
        return (jnp.einsum('bkgqs,bskd->bqkgd', p[..., :L], v)
                + jnp.einsum('bkgqs,bskd->bqkgd', p[..., L:], vc))

    o = lax.map(one_block, qb)
    return o.transpose(1, 0, 2, 3, 4, 5).reshape(B, L, ATTN_W)


def context_attention(qc, kc, vc):
    B, Lc = qc.shape[:2]
    G = ATTN_HEADS // ATTN_KV_HEADS
    q = qc.reshape(B, Lc, ATTN_KV_HEADS, G, HEAD_DIM)
    s = jnp.einsum('bqkgd,bskd->bkgqs', q, kc, preferred_element_type=jnp.float32) * HEAD_DIM ** -0.5
    p = jax.nn.softmax(s, axis=-1).astype(vc.dtype)
    return jnp.einsum('bkgqs,bskd->bqkgd', p, vc).reshape(B, Lc, ATTN_W)


def retention_chunkwise(q, k, v, log_g, s0):
    B, L, H, d = q.shape
    C = RET_CHUNK
    n = L // C

    def chunks(t):
        return t.astype(jnp.float32).reshape(B, n, C, H, d).transpose(1, 0, 3, 2, 4)

    qc, kc, vc = chunks(q), chunks(k), chunks(v)
    pos = jnp.arange(C, dtype=jnp.float32)
    diff = pos[:, None] - pos[None, :]
    decay = jnp.where(diff[None] >= 0,
                      jnp.exp(jnp.maximum(diff, 0.0)[None] * log_g[:, None, None]), 0.0)
    inner = jnp.einsum('nbhcd,nbhsd->nbhcs', qc, kc) * decay[None, None]
    inner = jnp.einsum('nbhcs,nbhse->nbhce', inner, vc)
    zeta = jnp.exp((C - 1 - pos)[None, :] * log_g[:, None])
    contrib = jnp.einsum('nbhsd,hs,nbhse->nbhde', kc, zeta, vc)
    g_chunk = jnp.exp(C * log_g)[:, None, None]

    def step(s, ci):
        return g_chunk * s + ci, s

    s_final, s_prev = lax.scan(step, s0, contrib)
    xi = jnp.exp((pos + 1.0)[None, :] * log_g[:, None])
    cross = jnp.einsum('nbhcd,nbhde->nbhce', qc, s_prev) * xi[None, None, :, :, None]
    out = (inner + cross).transpose(1, 0, 3, 2, 4).reshape(B, L, H, d)
    return out, s_final


def retention_final_state(k, v, log_g):
    L = k.shape[1]
    w = jnp.exp((L - 1 - jnp.arange(L, dtype=jnp.float32))[:, None] * log_g[None, :])
    return jnp.einsum('blhd,lh,blhe->bhde', k.astype(jnp.float32), w, v.astype(jnp.float32))


def retention_readout(y, gate, dtype):
    B, L = y.shape[:2]
    y = rms_unit(y).reshape(B, L, RET_W)
    return (y * jax.nn.silu(gate.astype(jnp.float32))).astype(dtype)


def swiglu(x, wg, wu, wd):
    return (jax.nn.silu(x @ wg) * (x @ wu)) @ wd


def route(h, router_w, router_bias):
    T = h.shape[0]
    scores = jax.nn.sigmoid(jnp.dot(h.astype(jnp.float32), router_w.astype(jnp.float32)))
    grouped = (scores + router_bias.astype(jnp.float32)).reshape(T, N_GROUPS, N_EXPERTS // N_GROUPS)
    group_score = lax.top_k(grouped, 2)[0].sum(-1)
    _, top_groups = lax.top_k(group_score, TOPK_GROUPS)
    keep = jax.nn.one_hot(top_groups, N_GROUPS, dtype=jnp.float32).sum(1) > 0
    masked = jnp.where(keep[:, :, None], grouped, -jnp.inf).reshape(T, N_EXPERTS)
    _, idx = lax.top_k(masked, TOP_K)
    w = jnp.take_along_axis(scores, idx, axis=-1)
    w = w / jnp.sum(w, axis=-1, keepdims=True) * ROUTED_SCALE
    return idx, w


def routed_experts(h, idx, w, w_gate, w_up, w_down):
    T, D = h.shape
    A = T * TOP_K
    flat_e = idx.reshape(A)
    flat_tok = jnp.repeat(jnp.arange(T, dtype=jnp.int32), TOP_K)
    flat_w = w.reshape(A)
    order = jnp.argsort(flat_e)
    e_sorted = flat_e[order]
    counts = jnp.bincount(flat_e, length=N_EXPERTS)
    padded = (counts + MOE_BLOCK - 1) // MOE_BLOCK * MOE_BLOCK
    pad_end = jnp.cumsum(padded)
    pad_start = pad_end - padded
    start = jnp.cumsum(counts) - counts
    dest = pad_start[e_sorted] + jnp.arange(A) - start[e_sorted]
    n_blocks = -(-A // MOE_BLOCK) + N_EXPERTS
    n_pad = n_blocks * MOE_BLOCK
    slot_tok = jnp.full((n_pad,), T, jnp.int32).at[dest].set(flat_tok[order])
    slot_w = jnp.zeros((n_pad,), jnp.float32).at[dest].set(flat_w[order])
    block_e = jnp.minimum(jnp.searchsorted(pad_end, jnp.arange(n_blocks) * MOE_BLOCK, side='right'),
                          N_EXPERTS - 1)
    h_pad = jnp.concatenate([h, jnp.zeros((1, D), h.dtype)], axis=0)

    def one_block(args):
        tok, e = args
        return swiglu(h_pad[tok], w_gate[e], w_up[e], w_down[e])

    y = lax.map(one_block, (slot_tok.reshape(n_blocks, MOE_BLOCK), block_e)).reshape(n_pad, D)
    y = (y.astype(jnp.float32) * slot_w[:, None])
    return jax.ops.segment_sum(y, slot_tok, num_segments=T + 1)[:T].astype(h.dtype)


def channel_mixer(h, router_w, router_bias, eg, eu, ed, sg, su, sd):
    B, L, D = h.shape
    t = h.reshape(B * L, D)
    idx, w = route(t, router_w, router_bias)
    y = routed_experts(t, idx, w, eg, eu, ed) + swiglu(t, sg, su, sd)
    return y.reshape(B, L, D)


def setup_inputs(seed: int = 0) -> dict:
    key = jax.random.key(seed)
    ks = jax.random.split(key, 24)
    D = D_MODEL
    f32 = jnp.float32

    def nrm(k, shape, fan_in, s=1.0):
        return jax.random.normal(k, shape, f32) * (s * fan_in ** -0.5)

    base_decay = jnp.asarray(np.log(2.0 ** (5 + np.arange(RET_HEADS)) - 1.0).astype(np.float32))
    return {
        "x": jax.random.normal(ks[0], (BATCH, SEQ, D), f32),
        "c": jax.random.normal(ks[1], (BATCH, D), f32),
        "ctx": jax.random.normal(ks[2], (BATCH, CTX_LEN, D), f32),
        "c_ctx": jax.random.normal(ks[3], (D,), f32),
        "w_mod": nrm(ks[4], (DEPTH, D, 6 * D), D, 0.5),
        "b_mod": 0.02 * jax.random.normal(ks[5], (DEPTH, 6 * D), f32),
        "norm1_w": 1.0 + 0.02 * jax.random.normal(ks[6], (DEPTH, D), f32),
        "norm2_w": 1.0 + 0.02 * jax.random.normal(ks[7], (DEPTH, D), f32),
        "w_in": nrm(ks[8], (DEPTH, D, IN_COLS), D),
        "q_norm_w": 1.0 + 0.02 * jax.random.normal(ks[9], (DEPTH, HEAD_DIM), f32),
        "k_norm_w": 1.0 + 0.02 * jax.random.normal(ks[10], (DEPTH, HEAD_DIM), f32),
        "ret_decay_fwd": base_decay + 0.1 * jax.random.normal(ks[11], (DEPTH, RET_HEADS), f32),
        "ret_decay_bwd": base_decay + 0.1 * jax.random.normal(ks[12], (DEPTH, RET_HEADS), f32),
        "w_out": nrm(ks[13], (DEPTH, MIX_WIDTH, D), MIX_WIDTH),
        "router_w": nrm(ks[14], (DEPTH, D, N_EXPERTS), D),
        "router_bias": 0.01 * jax.random.normal(ks[15], (DEPTH, N_EXPERTS), f32),
        "exp_w_gate": nrm(ks[16], (DEPTH, N_EXPERTS, D, EXPERT_FF), D),
        "exp_w_up": nrm(ks[17], (DEPTH, N_EXPERTS, D, EXPERT_FF), D),
        "exp_w_down": nrm(ks[18], (DEPTH, N_EXPERTS, EXPERT_FF, D), EXPERT_FF),
        "sh_w_gate": nrm(ks[19], (DEPTH, D, SHARED_FF), D),
        "sh_w_up": nrm(ks[20], (DEPTH, D, SHARED_FF), D),
        "sh_w_down": nrm(ks[21], (DEPTH, SHARED_FF, D), SHARED_FF),
    }


def reference(x, c, ctx, c_ctx, w_mod, b_mod, norm1_w, norm2_w, w_in, q_norm_w, k_norm_w,
              ret_decay_fwd, ret_decay_bwd, w_out, router_w, router_bias,
              exp_w_gate, exp_w_up, exp_w_down, sh_w_gate, sh_w_up, sh_w_down):
    B, L, D = x.shape
    cos, sin = axial_rope_tables(L)
    for layer in range(DEPTH):
        last = layer == DEPTH - 1
        Wm, bm, Wi = w_mod[layer], b_mod[layer], w_in[layer]
        mod = (jax.nn.silu(c) @ Wm + bm)[:, None, :]
        sh1, sc1, g1, sh2, sc2, g2 = jnp.split(mod, 6, axis=-1)
        n_cm = 2 * D if last else 6 * D
        modc = jax.nn.silu(c_ctx) @ Wm[:, :n_cm] + bm[:n_cm]
        lg_f = jax.nn.log_sigmoid(ret_decay_fwd[layer].astype(jnp.float32))
        lg_b = jax.nn.log_sigmoid(ret_decay_bwd[layer].astype(jnp.float32))

        hc = modulate(rms_norm(ctx, norm1_w[layer]), modc[:D], modc[D:2 * D])
        zc = hc @ (Wi[:, :CTX_KV_COLS] if last else Wi)
        cak = rms_norm(heads(zc, OFF_AK, ATTN_KV_HEADS), k_norm_w[layer])
        cav = heads(zc, OFF_AV, ATTN_KV_HEADS)
        crk = heads(zc, OFF_RK, RET_HEADS) * HEAD_DIM ** -0.5
        crv = heads(zc, OFF_RV, RET_HEADS)
        if last:
            s_f = retention_final_state(crk, crv, lg_f)
            s_b = retention_final_state(flip(crk), flip(crv), lg_b)
        else:
            zero = jnp.zeros((B, RET_HEADS, HEAD_DIM, HEAD_DIM), jnp.float32)
            crq = heads(zc, OFF_RQ, RET_HEADS)
            yc_f, s_f = retention_chunkwise(crq, crk, crv, lg_f, zero)
            yc_b, s_b = retention_chunkwise(flip(crq), flip(crk), flip(crv), lg_b, zero)

        h = modulate(rms_norm(x, norm1_w[layer]), sh1, sc1)
        z = h @ Wi
        aq = apply_rope(rms_norm(heads(z, OFF_AQ, ATTN_HEADS), q_norm_w[layer]), cos, sin)
        ak = apply_rope(rms_norm(heads(z, OFF_AK, ATTN_KV_HEADS), k_norm_w[layer]), cos, sin)
        av = heads(z, OFF_AV, ATTN_KV_HEADS)
        attn = latent_attention(aq, ak, av, cak, cav)
        rq = heads(z, OFF_RQ, RET_HEADS)
        rk = heads(z, OFF_RK, RET_HEADS) * HEAD_DIM ** -0.5
        rv = heads(z, OFF_RV, RET_HEADS)
        y_f, _ = retention_chunkwise(rq, rk, rv, lg_f, s_f)
        y_b, _ = retention_chunkwise(flip(rq), flip(rk), flip(rv), lg_b, s_b)
        ret = retention_readout(y_f + flip(y_b), z[..., OFF_RG:OFF_RG + RET_W], x.dtype)
        x = x + g1 * (jnp.concatenate([attn, ret], axis=-1) @ w_out[layer])
        h2 = modulate(rms_norm(x, norm2_w[layer]), sh2, sc2)
        x = x + g2 * channel_mixer(h2, router_w[layer], router_bias[layer], exp_w_gate[layer],
                                   exp_w_up[layer], exp_w_down[layer], sh_w_gate[layer],
                                   sh_w_up[layer], sh_w_down[layer])

        if not last:
            caq = rms_norm(heads(zc, OFF_AQ, ATTN_HEADS), q_norm_w[layer])
            attn_c = context_attention(caq, cak, cav)
            ret_c = retention_readout(yc_f + flip(yc_b), zc[..., OFF_RG:OFF_RG + RET_W], ctx.dtype)
            ctx = ctx + modc[2 * D:3 * D] * (jnp.concatenate([attn_c, ret_c], axis=-1) @ w_out[layer])
            hc2 = modulate(rms_norm(ctx, norm2_w[layer]), modc[3 * D:4 * D], modc[4 * D:5 * D])
            ctx = ctx + modc[5 * D:] * channel_mixer(hc2, router_w[layer], router_bias[layer],
                                                     exp_w_gate[layer], exp_w_up[layer],
                                                     exp_w_down[layer], sh_w_gate[layer],
                                                     sh_w_up[layer], sh_w_down[layer])
    return x
```

```cpp
#define DBG 0
#define DBG_PH_HI 11
#include <hip/hip_runtime.h>
#include <hip/hip_bf16.h>
#include <cstdio>
#include <cstdint>
#include <cmath>

#ifndef DBG
#define DBG 0
#endif

constexpr int D = 1024, NB = 8, L = 2048, LC = 256, T = NB * L, TC = NB * LC, TALL = T + TC;
constexpr int HD = 64, AH = 8, KVH = 2, RH = 8;
constexpr int OFF_AK = 0, OFF_AV = 128, OFF_RK = 256, OFF_RV = 768, CTXC = 1280, OFF_AQ = 1280, OFF_RQ = 1792, OFF_RG = 2304, INC = 2816;
constexpr int NE = 256, TOPK = 8, FF = 256;
constexpr int LK = L + LC;
constexpr int NCH = LK / 128;
constexpr int NASSIGN = T * TOPK;
constexpr int CAP = 16384;
constexpr float EPS = 1e-6f;
constexpr float C2 = 0.125f * 1.4426950408889634f;

typedef unsigned short bf16_t;
typedef float f32x4 __attribute__((ext_vector_type(4)));
typedef unsigned u32x4 __attribute__((ext_vector_type(4)));
typedef unsigned u32x2 __attribute__((ext_vector_type(2)));
typedef short bf16x8 __attribute__((ext_vector_type(8)));

__device__ __forceinline__ float siluf(float v) { return v / (1.f + __expf(-v)); }
__device__ __forceinline__ float sigmoidf_(float v) { return 1.f / (1.f + __expf(-v)); }
__device__ __forceinline__ unsigned f2bf(float f) { unsigned u = __builtin_bit_cast(unsigned, f); return (u + 0x7fffu + ((u >> 16) & 1u)) >> 16; }
__device__ __forceinline__ unsigned pk2(float lo, float hi) { return f2bf(lo) | (f2bf(hi) << 16); }
__device__ __forceinline__ float bf2f(unsigned short h) { return __builtin_bit_cast(float, (unsigned)h << 16); }
__device__ __forceinline__ float bflo(unsigned w) { return __builtin_bit_cast(float, w << 16); }
__device__ __forceinline__ float bfhi(unsigned w) { return __builtin_bit_cast(float, w & 0xffff0000u); }

constexpr size_t MiB = 1u << 20;
constexpr size_t al256(size_t x) { return (x + 255) / 256 * 256; }
constexpr size_t WS_CTL = 0, CTL_ZERO_BYTES = 1 * MiB;
constexpr size_t WS_MODV = WS_CTL + CTL_ZERO_BYTES;
constexpr size_t WS_ROPE = WS_MODV + al256((size_t)9 * 6 * D * 4);
constexpr size_t WS_WIN = WS_ROPE + al256((size_t)(32 + 64) * 16 * 8);
constexpr size_t WS_WOUT = WS_WIN + al256((size_t)INC * D * 2);
constexpr size_t WS_WR = WS_WOUT + al256((size_t)D * D * 2);
constexpr size_t WS_WSGU = WS_WR + al256((size_t)512 * D * 2);
constexpr size_t WS_WSD = WS_WSGU + al256((size_t)512 * D * 2);
constexpr size_t WS_HB = WS_WSD + al256((size_t)D * FF * 2);
constexpr size_t WS_QB = WS_HB + al256((size_t)TALL * D * 2);
constexpr size_t WS_KB = WS_QB + al256((size_t)T * 512 * 2);
constexpr size_t WS_VB = WS_KB + al256((size_t)NB * LK * 128 * 2);
constexpr size_t WS_RKB = WS_VB + al256((size_t)NB * LK * 128 * 2);
constexpr size_t WS_RVB = WS_RKB + al256((size_t)NB * LK * 512 * 2);
constexpr size_t WS_RQB = WS_RVB + al256((size_t)NB * LK * 512 * 2);
constexpr size_t WS_RGB = WS_RQB + al256((size_t)T * 512 * 2);
constexpr size_t WS_CST = WS_RGB + al256((size_t)T * 512 * 2);
constexpr size_t WS_CAT = WS_CST + al256((size_t)NB * RH * NCH * 2 * 4096 * 4);
constexpr size_t WS_X1 = WS_CAT + al256((size_t)T * D * 2);
constexpr size_t WS_H2B = WS_X1 + al256((size_t)T * D * 4);
constexpr size_t WS_LOGP = WS_H2B + al256((size_t)2 * T * D * 2);
constexpr size_t WS_ACTS = WS_LOGP + al256((size_t)3 * T * NE * 4);
constexpr size_t WS_RIDX = WS_ACTS + al256((size_t)T * FF * 2);
constexpr size_t WS_RWT = WS_RIDX + al256((size_t)NASSIGN * 4);
constexpr size_t WS_SDST = WS_RWT + al256((size_t)NASSIGN * 4);
constexpr size_t WS_SW = WS_SDST + al256((size_t)NE * 16384 * 4);
constexpr size_t WS_END_A = WS_SW + al256((size_t)NE * 16384 * 4);
constexpr size_t WS_ACT = WS_END_A;
constexpr size_t WS_YEXP = WS_ACT + al256((size_t)NASSIGN * FF * 2);
constexpr size_t WS_END_B = WS_YEXP + al256((size_t)NASSIGN * D * 2);
constexpr int CW_BAR = 4096;
constexpr int CW_ECNT = 16384;

#define GAS __attribute__((address_space(1)))
#define LAS __attribute__((address_space(3)))
#define LDS_WAIT() asm volatile("s_waitcnt lgkmcnt(0)" ::: "memory")
#define VM_WAIT() asm volatile("s_waitcnt vmcnt(0)" ::: "memory")
constexpr int NWAVES = 8, NTHR = NWAVES * 64;
constexpr int RING_BYTES = 131072, LDSCTL_OFF = RING_BYTES, MISC_OFF = LDSCTL_OFF + 320, LDS_BYTES = 147456;

struct Params {
    const float* in[22];
    float* out;
    unsigned char* ws;
    int ph_lo, ph_hi, li, pad;
};
namespace pg8 {
#define PG8_LAS __attribute__((address_space(3)))
typedef unsigned short bf16_t;
typedef short bf16x8 __attribute__((ext_vector_type(8)));
typedef float f32x4 __attribute__((ext_vector_type(4)));
typedef unsigned u32x4 __attribute__((ext_vector_type(4)));
constexpr int BM = 256, BK = 64, HALF = 128, HTB = HALF * BK * 2  , STAGE_BYTES = 8 * HTB, NXCD = 8, WGM = 8;

__host__ __device__ __forceinline__ int lds_byte(int r, int c) { const int st = (r >> 4) * 2 + (c >> 5), rr = r & 15, cc = c & 31, ob = rr * 64 + cc * 2; return st * 1024 + (ob ^ (((ob >> 9) & 1) << 5)); }
__host__ __device__ __forceinline__ void stage_rc(int b, int& R, int& C) { const int st = b / 1024, sb = b % 1024, swz = sb ^ (((sb >> 9) & 1) << 5); R = (st >> 1) * 16 + swz / 64; C = (st & 1) * 32 + (swz % 64) / 2; }
__host__ __device__ __forceinline__ int perm32(int rho) { const int n = rho >> 4, i = rho & 15; return 8 * (i >> 2) + 4 * n + (i & 3); }

struct Unit { int pm, pn; };
struct Gemm { const bf16_t* A; const bf16_t* Bt; int M, N, K; };

struct StaticOrder {
    int nM, nN, nwg, G, c;
    __host__ __device__ void init(int M, int N, int G_, int c_) { nM = M / BM; nN = N / BM; nwg = nM * nN; G = G_; c = c_; }
    __host__ __device__ bool next(int i, Unit& u) const {
        const long L = (long)i * G + c; if (L >= nwg) return false;
        int wgid = (int)L; { const int q = nwg / NXCD, r = nwg % NXCD, xcd = wgid % NXCD, off = wgid / NXCD; wgid = (xcd < r ? xcd * (q + 1) : r * (q + 1) + (xcd - r) * q) + off; }
        const int nig = WGM * nN, gid = wgid / nig, fm = gid * WGM, gsz = (nM - fm) < WGM ? (nM - fm) : WGM;
        u.pm = fm + ((wgid % nig) % gsz); u.pn = (wgid % nig) / gsz; return true;
    }
    __device__ __forceinline__ void a_ready(const Unit&) const {}
    __device__ __forceinline__ void done(const Unit&) const {}
};

__device__ __forceinline__ unsigned cvt_pk_bf16(float lo, float hi) { unsigned r; asm volatile("v_cvt_pk_bf16_f32 %0, %1, %2" : "=v"(r) : "v"(lo), "v"(hi)); return r; }
typedef float f32x2 __attribute__((ext_vector_type(2)));

template <class Epi, class Sched, bool ALIGN_EPI = false, bool SP2 = false>
__device__ __forceinline__ void gemm_phase(PG8_LAS unsigned char* lds, const Gemm g, const Sched& S, const Epi& E) {
    const int tid = threadIdx.x, wid = __builtin_amdgcn_readfirstlane(tid >> 6), lane = tid & 63, wr = wid >> 2, wc = wid & 3, fr = lane & 15, fq = lane >> 4;
    const int K = g.K, nt = K / BK;
    unsigned voffA[2], voffB[2];
#pragma unroll
    for (int i = 0; i < 2; ++i) { int R, C; stage_rc(tid * 16 + i * 8192, R, C); const int Rb = Epi::HEADPERM ? (64 * (R >> 5) + perm32(R & 31)) : (Epi::PERM ? ((R & ~31) + perm32(R & 31)) : R);
        voffA[i] = (unsigned)(R * K + C) * 2u; voffB[i] = (unsigned)(Rb * K + C) * 2u; }
    const size_t kstep = (size_t)(BK * 2);
    const size_t hstep = (size_t)HALF * K * 2;
    const size_t tstep = 2 * hstep; const size_t bhstep = Epi::HEADPERM ? (size_t)32 * K * 2 : hstep;
    const unsigned ldsw = (unsigned)wid * 1024u;
    const int aoff = lds_byte(wr * 64 + fr, fq * 8), boff = lds_byte(wc * 32 + fr, fq * 8);
#define PG8_SA(b, h) (((b) * 2 + (h)) * HTB)
#define PG8_SB(b, h) ((4 + (b) * 2 + (h)) * HTB)
#define PG8_STAGE(bufoff, gbase, voff) do { _Pragma("unroll") for (int _i = 0; _i < 2; ++_i) \
        __builtin_amdgcn_global_load_lds((const unsigned*)((const char*)(gbase) + (voff)[_i]), (PG8_LAS unsigned*)(lds + (bufoff) + ldsw + _i * 8192), 16, 0, 0); } while (0)
#define PG8_LDA(dst, b, h) do { _Pragma("unroll") for (int m = 0; m < 4; ++m) _Pragma("unroll") for (int k = 0; k < 2; ++k) dst[m][k] = *(const PG8_LAS bf16x8*)(lds + PG8_SA(b, h) + aoff + m * 2048 + k * 1024); } while (0)
#define PG8_LDB(dst, b, h) do { _Pragma("unroll") for (int n = 0; n < 2; ++n) _Pragma("unroll") for (int k = 0; k < 2; ++k) dst[n][k] = *(const PG8_LAS bf16x8*)(lds + PG8_SB(b, h) + boff + n * 2048 + k * 1024); } while (0)
#define PG8_MMA(ai, bj, At, Bt) do { __builtin_amdgcn_s_setprio(1); _Pragma("unroll") for (int m = 0; m < 4; ++m) _Pragma("unroll") for (int n = 0; n < 2; ++n) _Pragma("unroll") for (int k = 0; k < 2; ++k) \
        acc[ai][bj][m][n] = __builtin_amdgcn_mfma_f32_16x16x32_bf16(Bt[n][k], At[m][k], acc[ai][bj][m][n], 0, 0, 0); __builtin_amdgcn_s_setprio(0); } while (0)
#define PG8_WAIT_V(n) asm volatile("s_waitcnt vmcnt(" #n ")" ::: "memory")
#define PG8_WAIT_L(n) asm volatile("s_waitcnt lgkmcnt(" #n ")" ::: "memory")
#define PG8_BAR __builtin_amdgcn_s_barrier()
#define PG8_SCHED __builtin_amdgcn_sched_barrier(0)
    Unit cur, nxt; int ui = 0;
    if (!S.next(0, cur)) return;
    f32x4 acc[2][2][4][2];
#pragma unroll
    for (int a = 0; a < 2; ++a)
#pragma unroll
        for (int b = 0; b < 2; ++b)
#pragma unroll
            for (int m = 0; m < 4; ++m)
#pragma unroll
                for (int n = 0; n < 2; ++n) acc[a][b][m][n] = (f32x4){0.f, 0.f, 0.f, 0.f};
    bf16x8 At[4][2], B0[2][2], B1[2][2];
    const char* cA = (const char*)g.A + (size_t)cur.pm * tstep; const char* cB = (const char*)g.Bt + (size_t)cur.pn * tstep;
    S.a_ready(cur);
    if constexpr (SP2) {
        PG8_STAGE(PG8_SB(0, 0), cB, voffB); PG8_STAGE(PG8_SB(0, 1), cB + bhstep, voffB); PG8_STAGE(PG8_SA(0, 0), cA, voffA); PG8_STAGE(PG8_SA(0, 1), cA + hstep, voffA);
        if (wr == 1) PG8_BAR;
        PG8_WAIT_V(2); PG8_BAR;
        PG8_STAGE(PG8_SB(1, 0), cB + kstep, voffB); PG8_STAGE(PG8_SA(1, 0), cA + kstep, voffA); PG8_STAGE(PG8_SB(1, 1), cB + bhstep + kstep, voffB);
        PG8_WAIT_V(6); PG8_BAR;
    } else {
        PG8_STAGE(PG8_SB(0, 0), cB, voffB); PG8_STAGE(PG8_SA(0, 0), cA, voffA); PG8_STAGE(PG8_SB(0, 1), cB + bhstep, voffB); PG8_STAGE(PG8_SA(0, 1), cA + hstep, voffA);
        if (wr == 1) PG8_BAR;
        PG8_WAIT_V(4); PG8_BAR;
        PG8_STAGE(PG8_SB(1, 0), cB + kstep, voffB); PG8_STAGE(PG8_SA(1, 0), cA + kstep, voffA); PG8_STAGE(PG8_SB(1, 1), cB + bhstep + kstep, voffB);
        PG8_WAIT_V(6); PG8_BAR;
    }
    for (;;) {
        const bool has_next = S.next(ui + 1, nxt);
        const char* nA = has_next ? (const char*)g.A + (size_t)nxt.pm * tstep : cA; const char* nB = has_next ? (const char*)g.Bt + (size_t)nxt.pn * tstep : cB;
        for (int t = 0; t < nt; t += 2) {
            const bool last = (t == nt - 2);
            const char* a1 = cA + (size_t)(t + 1) * kstep;
            const char* a2 = last ? nA : cA + (size_t)(t + 2) * kstep; const char* b2 = last ? nB : cB + (size_t)(t + 2) * kstep;
            const char* a3 = a2 + kstep; const char* b3 = b2 + kstep;
            if (last && has_next) S.a_ready(nxt);
            if constexpr (SP2) {
            PG8_LDB(B0, 0, 0); PG8_LDB(B1, 0, 1); PG8_SCHED; PG8_LDA(At, 0, 0); PG8_STAGE(PG8_SA(1, 1), a1 + hstep, voffA);
            PG8_WAIT_V(8); PG8_WAIT_L(0); PG8_BAR; PG8_MMA(0, 0, At, B0); PG8_MMA(0, 1, At, B1); PG8_BAR; PG8_SCHED;
            PG8_LDA(At, 0, 1); PG8_STAGE(PG8_SB(0, 0), b2, voffB); PG8_STAGE(PG8_SB(0, 1), b2 + bhstep, voffB); PG8_STAGE(PG8_SA(0, 0), a2, voffA);
            PG8_WAIT_V(8); PG8_WAIT_L(0); PG8_BAR; PG8_MMA(1, 0, At, B0); PG8_MMA(1, 1, At, B1); PG8_BAR; PG8_SCHED;
            PG8_LDB(B0, 1, 0); PG8_LDB(B1, 1, 1); PG8_SCHED; PG8_LDA(At, 1, 0); PG8_STAGE(PG8_SA(0, 1), a2 + hstep, voffA);
            PG8_WAIT_V(8); PG8_WAIT_L(0); PG8_BAR; PG8_MMA(0, 0, At, B0); PG8_MMA(0, 1, At, B1); PG8_BAR; PG8_SCHED;
            PG8_LDA(At, 1, 1); PG8_STAGE(PG8_SB(1, 0), b3, voffB); PG8_STAGE(PG8_SB(1, 1), b3 + bhstep, voffB); PG8_STAGE(PG8_SA(1, 0), a3, voffA);
            PG8_WAIT_V(8); PG8_WAIT_L(0); PG8_BAR; PG8_MMA(1, 0, At, B0); PG8_MMA(1, 1, At, B1); PG8_BAR; PG8_SCHED;
            } else {
            PG8_LDB(B0, 0, 0); PG8_SCHED; PG8_LDA(At, 0, 0); PG8_STAGE(PG8_SA(1, 1), a1 + hstep, voffA);
            PG8_WAIT_L(8); PG8_BAR; PG8_WAIT_L(0); PG8_MMA(0, 0, At, B0); PG8_BAR; PG8_SCHED;
            PG8_LDB(B1, 0, 1); PG8_STAGE(PG8_SB(0, 0), b2, voffB);
            PG8_BAR; PG8_WAIT_L(0); PG8_MMA(0, 1, At, B1); PG8_BAR;
            PG8_LDA(At, 0, 1); PG8_STAGE(PG8_SA(0, 0), a2, voffA);
            PG8_BAR; PG8_WAIT_L(0); PG8_MMA(1, 0, At, B0); PG8_BAR; PG8_SCHED;
            PG8_STAGE(PG8_SB(0, 1), b2 + bhstep, voffB);
            PG8_WAIT_V(6); PG8_BAR; PG8_MMA(1, 1, At, B1); PG8_BAR;
            PG8_LDB(B0, 1, 0); PG8_SCHED; PG8_LDA(At, 1, 0); PG8_STAGE(PG8_SA(0, 1), a2 + hstep, voffA);
            PG8_WAIT_L(8); PG8_BAR; PG8_WAIT_L(0); PG8_MMA(0, 0, At, B0); PG8_BAR; PG8_SCHED;
            PG8_LDB(B1, 1, 1); PG8_STAGE(PG8_SB(1, 0), b3, voffB);
            PG8_BAR; PG8_WAIT_L(0); PG8_MMA(0, 1, At, B1); PG8_BAR;
            PG8_LDA(At, 1, 1); PG8_STAGE(PG8_SA(1, 0), a3, voffA);
            PG8_BAR; PG8_WAIT_L(0); PG8_MMA(1, 0, At, B0); PG8_BAR; PG8_SCHED;
            PG8_STAGE(PG8_SB(1, 1), b3 + bhstep, voffB);
            PG8_WAIT_V(6); PG8_BAR; PG8_MMA(1, 1, At, B1); PG8_BAR;
            }
        }
        if constexpr (ALIGN_EPI) { if (wr == 0) PG8_BAR; }
        if constexpr (!Epi::AFTER_DRAIN) { E(acc, cur, wr, wc, fr, fq); S.done(cur); }
        if (!has_next) break;
#pragma unroll
        for (int a = 0; a < 2; ++a)
#pragma unroll
            for (int b = 0; b < 2; ++b)
#pragma unroll
                for (int m = 0; m < 4; ++m)
#pragma unroll
                    for (int n = 0; n < 2; ++n) acc[a][b][m][n] = (f32x4){0.f, 0.f, 0.f, 0.f};
        cur = nxt; cA = nA; cB = nB; ++ui;
        if constexpr (ALIGN_EPI) { if (wr == 1) PG8_BAR; }
    }
    PG8_WAIT_V(0);
    if constexpr (!ALIGN_EPI) { if (wr == 0) PG8_BAR; }
    PG8_BAR;
    if constexpr (Epi::AFTER_DRAIN) { E.fused(acc, cur, wr, wc, fr, fq, lds, wid, lane); S.done(cur); }
#undef PG8_SA
#undef PG8_SB
#undef PG8_STAGE
#undef PG8_LDA
#undef PG8_LDB
#undef PG8_MMA
#undef PG8_WAIT_V
#undef PG8_WAIT_L
#undef PG8_BAR
#undef PG8_SCHED
}
}
namespace attn_body {
using bf16=__hip_bfloat16;
using bf16x8=__attribute__((ext_vector_type(8)))short;
using s16x4=__attribute__((ext_vector_type(4)))short;
using f32x16=__attribute__((ext_vector_type(16)))float;
using u32x4=__attribute__((ext_vector_type(4)))unsigned;
constexpr int D=64, QP=512, KP=128, OP=1024, NKEYS=2304, NQ=2048;
constexpr int NW=8,QBLK=32,QB=QBLK*NW,KVBLK=64,NQB=NQ/QB;
constexpr int ATTN_UNIT_ROWS=QB;
__device__ __forceinline__ int crow(int r,int hi){return (r&3)+8*(r>>2)+4*hi;}
#define SBAR() __builtin_amdgcn_sched_barrier(0)
constexpr int NSLOT=3, SLOTB=8192;
constexpr int LDS_K=0, LDS_V=NSLOT*SLOTB, LDS_WS=2*NSLOT*SLOTB, LDS_OST=LDS_WS+NW*64*4, LDS_BYTES=LDS_OST+NW*4096;
constexpr float C2=0.125f*1.4426950408889634f;
__device__ __forceinline__ void glds16(const void*gsrc,unsigned lds_dst){unsigned keep;
  asm volatile("s_mov_b32 %0, m0\n\ts_mov_b32 m0, %2\n\ts_nop 0\n\tglobal_load_lds_dwordx4 %1, off\n\ts_mov_b32 m0, %0":"=&s"(keep):"v"(gsrc),"s"(lds_dst):"memory");}
__device__ __forceinline__ float max3f(float a,float b,float c){float r;asm("v_max3_f32 %0, %1, %2, %3":"=v"(r):"v"(a),"v"(b),"v"(c));return r;}
__device__ __forceinline__ float max2f(float a,float b){float r;asm("v_max_f32_e32 %0, %1, %2":"=v"(r):"v"(a),"v"(b));return r;}
__device__ __forceinline__ float fadd_s(float a,float b){float r;asm("v_add_f32_e32 %0, %1, %2":"=v"(r):"v"(a),"v"(b));return r;}
__device__ __forceinline__ float fsub_s(float a,float b){float r;asm("v_sub_f32_e32 %0, %1, %2":"=v"(r):"v"(a),"v"(b));return r;}
typedef float f32x2_t __attribute__((ext_vector_type(2))); typedef __bf16 bf16x2_t __attribute__((ext_vector_type(2)));
__device__ __forceinline__ unsigned cvtpk_s(float lo,float hi){f32x2_t v={lo,hi};bf16x2_t b=__builtin_convertvector(v,bf16x2_t);return __builtin_bit_cast(unsigned,b);}
#define WAIT_BAR(N) asm volatile("s_waitcnt vmcnt(" #N ") lgkmcnt(0)\n\ts_barrier":::"memory")

__device__ __forceinline__ void qkt(f32x16&p0,f32x16&p1,const char*Kslot,const bf16x8*qr,const f32x16&negm,int r32,int hi){
  const char*kb=Kslot+hi*1024+r32*16;
  #pragma unroll
  for(int d0=0;d0<4;++d0){
    const bf16x8 b0=*reinterpret_cast<const bf16x8*>(kb+d0*2048);
    const bf16x8 b1=*reinterpret_cast<const bf16x8*>(kb+d0*2048+512);
    if(d0==0){p0=__builtin_amdgcn_mfma_f32_32x32x16_bf16(b0,qr[0],negm,0,0,0);p1=__builtin_amdgcn_mfma_f32_32x32x16_bf16(b1,qr[0],negm,0,0,0);}
    else{p0=__builtin_amdgcn_mfma_f32_32x32x16_bf16(b0,qr[d0],p0,0,0,0);p1=__builtin_amdgcn_mfma_f32_32x32x16_bf16(b1,qr[d0],p1,0,0,0);}}
}
typedef __attribute__((address_space(3))) const char* lds_cptr;
typedef short v4i16_t __attribute__((ext_vector_type(4)));
__device__ __forceinline__ void kload8(bf16x8*kf,lds_cptr kp){
  kf[0]=*(const __attribute__((address_space(3))) bf16x8*)(kp);      kf[1]=*(const __attribute__((address_space(3))) bf16x8*)(kp+512);
  kf[2]=*(const __attribute__((address_space(3))) bf16x8*)(kp+2048); kf[3]=*(const __attribute__((address_space(3))) bf16x8*)(kp+2560);
  kf[4]=*(const __attribute__((address_space(3))) bf16x8*)(kp+4096); kf[5]=*(const __attribute__((address_space(3))) bf16x8*)(kp+4608);
  kf[6]=*(const __attribute__((address_space(3))) bf16x8*)(kp+6144); kf[7]=*(const __attribute__((address_space(3))) bf16x8*)(kp+6656);
}
__device__ __forceinline__ void kload2(bf16x8*kf,lds_cptr kp,int j){ kf[2*j]=*(const __attribute__((address_space(3))) bf16x8*)(kp+j*2048); kf[2*j+1]=*(const __attribute__((address_space(3))) bf16x8*)(kp+j*2048+512); }
__device__ __forceinline__ s16x4 vtr(lds_cptr p){ return __builtin_bit_cast(s16x4,__builtin_amdgcn_ds_read_tr16_b64_v4i16((__attribute__((address_space(3))) v4i16_t*)p)); }
__device__ __forceinline__ float rowmax(const f32x16&p0,const f32x16&p1){
  float a=max3f(p0[0],p0[1],p1[0]),b=max3f(p0[2],p0[3],p1[1]);a=max3f(a,p1[2],p1[3]);
  #pragma unroll
  for(int r=4;r<16;r+=4){a=max3f(a,p0[r],p0[r+1]);b=max3f(b,p0[r+2],p0[r+3]);a=max3f(a,p1[r],p1[r+1]);b=max3f(b,p1[r+2],p1[r+3]);}
  const float m=max2f(a,b);
  auto rr=__builtin_amdgcn_permlane32_swap(__float_as_uint(m),__float_as_uint(m),false,false);
  return max2f(__uint_as_float(rr[0]),__uint_as_float(rr[1]));
}
__device__ __forceinline__ void pv(f32x16*o,int vb,bf16x8 pa0,bf16x8 pa1,bf16x8 pa2,bf16x8 pa3){
  #pragma unroll
  for(int d0=0;d0<2;++d0){s16x4 lo[4],hi[4];
    #pragma unroll
    for(int ks=0;ks<4;++ks){
      asm volatile("ds_read_b64_tr_b16 %0,%1 offset:%c2":"=&v"(lo[ks]):"v"(vb),"i"(d0*4096+ks*1024):"memory");
      asm volatile("ds_read_b64_tr_b16 %0,%1 offset:%c2":"=&v"(hi[ks]):"v"(vb),"i"(d0*4096+ks*1024+512):"memory");}
    asm volatile("s_waitcnt lgkmcnt(0)":::"memory");SBAR();
    #define PK(k) (bf16x8){lo[k][0],lo[k][1],lo[k][2],lo[k][3],hi[k][0],hi[k][1],hi[k][2],hi[k][3]}
    o[d0]=__builtin_amdgcn_mfma_f32_32x32x16_bf16(pa0,PK(0),o[d0],0,0,0);
    o[d0]=__builtin_amdgcn_mfma_f32_32x32x16_bf16(pa1,PK(1),o[d0],0,0,0);
    o[d0]=__builtin_amdgcn_mfma_f32_32x32x16_bf16(pa2,PK(2),o[d0],0,0,0);
    o[d0]=__builtin_amdgcn_mfma_f32_32x32x16_bf16(pa3,PK(3),o[d0],0,0,0);
    #undef PK
  }
}

#ifndef ATTN_STORE16
#define ATTN_STORE16(p,v) (*(u32x4*)(p)=(v))
#endif
template<int THRL> __device__ __forceinline__ void attn_unit(int b,int h,int kvh,int qb,const bf16*Q,const bf16*__restrict__ K,const bf16*__restrict__ V,bf16*O,char*shm){
  const int tid=threadIdx.x,lane=tid&63,r32=lane&31,hi=lane>>5; const int wid=__builtin_amdgcn_readfirstlane(tid>>6);
  const long rowbase=(long)b*NQ; const int q0=qb*QB;
  const bf16*Qw=Q+(rowbase+q0+wid*QBLK)*QP+h*D;
  const bf16*Kh=K+(long)b*NKEYS*KP+kvh*D,*Vh=V+(long)b*NKEYS*KP+kvh*D;
  const unsigned lds0=(unsigned)(uintptr_t)shm;
  float*wsf=(float*)(shm+LDS_WS)+wid*64;
  const bf16*ksrc=Kh+(long)lane*KP+wid*8;
  const bf16*vsrc=Vh+(long)(16*(wid&3)+(lane>>2))*KP+(wid>>2)*32+(lane&3)*8;
  const unsigned kdst=lds0+LDS_K+wid*1024, vdst=lds0+LDS_V+wid*1024;
  #define DMA_K(t,slot) glds16(ksrc+(long)(t)*KVBLK*KP,(unsigned)__builtin_amdgcn_readfirstlane(kdst+(slot)))
  #define DMA_V(t,slot) glds16(vsrc+(long)(t)*KVBLK*KP,(unsigned)__builtin_amdgcn_readfirstlane(vdst+(slot)))
  const int vb0=(int)(lds0+LDS_V)+((lane>>4)&1)*32+(lane&3)*8+(4*hi+((lane&15)>>2))*64;
  const char*Kbase=shm+LDS_K; bf16x8 kf[8];
  const lds_cptr shm3=(lds_cptr)shm; const lds_cptr kp0=shm3+LDS_K+hi*1024+r32*16; const lds_cptr vp0=shm3+LDS_V+((lane>>4)&1)*32+(lane&3)*8+(4*hi+((lane&15)>>2))*64;
  constexpr int NT=NKEYS/KVBLK;
  DMA_K(0,0);DMA_V(0,0);DMA_K(1,SLOTB);
  bf16x8 qr[4];
  #pragma unroll
  for(int d0=0;d0<4;++d0)qr[d0]=*reinterpret_cast<const bf16x8*>(&Qw[(long)r32*QP+d0*16+hi*8]);
  float mhat=0.f,l_reg=0.f;f32x16 o[2];o[0]=f32x16{};o[1]=f32x16{};f32x16 negm=f32x16{};asm volatile("":"+v"(negm));
  #define CMASK(P0,P1,t) do{}while(0)
  bool resc=false;
  #define START(P0,P1) do{ const float rm=rowmax(P0,P1); resc=false; \
    { const float dl=rm; mhat=fadd_s(mhat,dl); \
      _Pragma("unroll") for(int r=0;r<16;++r){P0[r]=fsub_s(P0[r],dl);P1[r]=fsub_s(P1[r],dl);} \
      _Pragma("unroll") for(int r=0;r<16;++r)negm[r]=-mhat; asm volatile("":"+v"(negm)); } \
    _Pragma("unroll") for(int r=0;r<16;++r)P0[r]=__builtin_amdgcn_exp2f(P0[r]); }while(0)
  #define RESC() do{ if(resc){ asm volatile("s_waitcnt lgkmcnt(0)":::"memory"); \
      _Pragma("unroll") for(int d_=0;d_<2;++d_) _Pragma("unroll") for(int r=0;r<16;++r)o[d_][r]*=wsf[crow(r,hi)]; } }while(0)
  f32x16 pA0,pA1,pB0,pB1;
  int sl_prev=0,sl_cur=0,sl_next=SLOTB;
  #define ROT() do{sl_prev=sl_cur;sl_cur=sl_next;sl_next=(sl_next==(NSLOT-1)*SLOTB)?0:sl_next+SLOTB;}while(0)
  DMA_K(2,2*SLOTB);
  WAIT_BAR(3);
  qkt(pA0,pA1,Kbase,qr,negm,r32,hi);asm volatile("s_nop 15\n\ts_nop 7":"+v"(pA0),"+v"(pA1));CMASK(pA0,pA1,0);
  START(pA0,pA1);
  _Pragma("unroll") for(int r=0;r<16;++r)pA1[r]=__builtin_amdgcn_exp2f(pA1[r]);
  WAIT_BAR(0);
  DMA_K(3,0);DMA_V(1,SLOTB);
  ROT();
  kload8(kf,kp0+sl_cur);
  WAIT_BAR(2);
  s16x4 vlo[8],vhi[8]; u32x4 pw0,pw1,pw2,pw3;
  #define PKW(P,B) cvtpk_s(P[B],P[B+1])
  #define PAF(k) __builtin_bit_cast(bf16x8,pw##k)
  #define VFR(i) (bf16x8){vlo[i][0],vlo[i][1],vlo[i][2],vlo[i][3],vhi[i][0],vhi[i][1],vhi[i][2],vhi[i][3]}
  #define PIN(x) asm volatile("":"+v"(x))
  #define MX3(a,b,c) __builtin_fmaxf(__builtin_fmaxf((a),(b)),(c))
  #define GAPA(MF,A0,A1,A2,A3,W0,W1,PW) do{ MF; sacc+=A0; sacc+=A1; sacc+=A2; sacc+=A3; PIN(sacc); W0; W1; PIN(PW); SBAR(); }while(0)
  #define EX(v) __builtin_amdgcn_exp2f(v)
  #define GAPB(MF,X,B) do{ MF; X[B]=EX(X[B]); X[B+1]=EX(X[B+1]); X[B+2]=EX(X[B+2]); X[B+3]=EX(X[B+3]); PIN(X); SBAR(); }while(0)
  #define VRD(i) do{ vlo[i]=vtr(vp_+(((i)>>2)*4096+((i)&3)*1024)); vhi[i]=vtr(vp_+(((i)>>2)*4096+((i)&3)*1024+512)); }while(0)
  #define KRD(G,j) do{ if(G){ kload2(kf,kp0+sl_next,j); SBAR(); } }while(0)
  #define STEP(C0,C1,P0,P1,t,GK,GV,GL) do{ SBAR(); \
    const lds_cptr vp_=vp0+sl_prev; \
    VRD(0); SBAR(); float sacc=(P0[0]+P0[1]); \
    GAPA(C0=__builtin_amdgcn_mfma_f32_32x32x16_bf16(kf[0],qr[0],negm,0,0,0), P0[2],P0[3],P0[4],P0[5],     pw0[0]=PKW(P0,0), pw0[1]=PKW(P0,2), pw0); \
    VRD(4); SBAR(); GAPA(C1=__builtin_amdgcn_mfma_f32_32x32x16_bf16(kf[1],qr[0],negm,0,0,0), P0[6],P0[7],P0[8],P0[9],     pw0[2]=PKW(P0,4), pw0[3]=PKW(P0,6), pw0); \
    VRD(1); SBAR(); GAPA(C0=__builtin_amdgcn_mfma_f32_32x32x16_bf16(kf[2],qr[1],C0,0,0,0),   P0[10],P0[11],P0[12],P0[13], pw1[0]=PKW(P0,8), pw1[1]=PKW(P0,10), pw1); \
    VRD(5); SBAR(); GAPA(C1=__builtin_amdgcn_mfma_f32_32x32x16_bf16(kf[3],qr[1],C1,0,0,0),   P0[14],P0[15],P1[0],P1[1],   pw1[2]=PKW(P0,12),pw1[3]=PKW(P0,14), pw1); \
    VRD(2); SBAR(); GAPA(C0=__builtin_amdgcn_mfma_f32_32x32x16_bf16(kf[4],qr[2],C0,0,0,0),   P1[2],P1[3],P1[4],P1[5],     pw2[0]=PKW(P1,0), pw2[1]=PKW(P1,2), pw2); \
    VRD(6); SBAR(); GAPA(C1=__builtin_amdgcn_mfma_f32_32x32x16_bf16(kf[5],qr[2],C1,0,0,0),   P1[6],P1[7],P1[8],P1[9],     pw2[2]=PKW(P1,4), pw2[3]=PKW(P1,6), pw2); \
    VRD(3); SBAR(); GAPA(C0=__builtin_amdgcn_mfma_f32_32x32x16_bf16(kf[6],qr[3],C0,0,0,0),   P1[10],P1[11],P1[12],P1[13], pw3[0]=PKW(P1,8), pw3[1]=PKW(P1,10), pw3); \
    VRD(7); SBAR(); GAPA(C1=__builtin_amdgcn_mfma_f32_32x32x16_bf16(kf[7],qr[3],C1,0,0,0),   P1[14],P1[15],0.f,0.f,       pw3[2]=PKW(P1,12),pw3[3]=PKW(P1,14), pw3); \
    l_reg+=sacc; \
    if(GK){DMA_K((t)+3,sl_cur);} if(GV){DMA_V((t)+1,sl_next);} \
    CMASK(C0,C1,t); \
    { float a=MX3(C0[0],C0[1],C1[0]),b=MX3(C0[2],C0[3],C1[1]); a=MX3(a,C1[2],C1[3]); \
      _Pragma("unroll") for(int r=4;r<16;r+=4){a=MX3(a,C0[r],C0[r+1]);b=MX3(b,C0[r+2],C0[r+3]);a=MX3(a,C1[r],C1[r+1]);b=MX3(b,C1[r+2],C1[r+3]);} \
      float rm=__builtin_fmaxf(a,b); { auto rr=__builtin_amdgcn_permlane32_swap(__float_as_uint(rm),__float_as_uint(rm),false,false); rm=__builtin_fmaxf(__uint_as_float(rr[0]),__uint_as_float(rr[1])); } \
      resc=false; \
      if(__builtin_expect(__any(rm>(float)THRL),0)){ const float dl=__builtin_fmaxf(rm,0.f); mhat+=dl; \
        _Pragma("unroll") for(int r=0;r<16;++r){C0[r]-=dl;C1[r]-=dl;} \
        _Pragma("unroll") for(int r=0;r<16;++r)negm[r]=-mhat; asm volatile("":"+v"(negm)); \
        const float f=__builtin_amdgcn_exp2f(-dl); l_reg*=f; if(hi==0)wsf[r32]=f; resc=true; } } \
    SBAR(); \
    GAPB(o[0]=__builtin_amdgcn_mfma_f32_32x32x16_bf16(PAF(0),VFR(0),o[0],0,0,0), C0,0); \
    GAPB(o[1]=__builtin_amdgcn_mfma_f32_32x32x16_bf16(PAF(0),VFR(4),o[1],0,0,0), C0,4); \
    KRD(GL,0); GAPB(o[0]=__builtin_amdgcn_mfma_f32_32x32x16_bf16(PAF(1),VFR(1),o[0],0,0,0), C0,8); \
    KRD(GL,1); GAPB(o[1]=__builtin_amdgcn_mfma_f32_32x32x16_bf16(PAF(1),VFR(5),o[1],0,0,0), C0,12); \
    KRD(GL,2); GAPB(o[0]=__builtin_amdgcn_mfma_f32_32x32x16_bf16(PAF(2),VFR(2),o[0],0,0,0), C1,0); \
    KRD(GL,3); GAPB(o[1]=__builtin_amdgcn_mfma_f32_32x32x16_bf16(PAF(2),VFR(6),o[1],0,0,0), C1,4); \
    GAPB(o[0]=__builtin_amdgcn_mfma_f32_32x32x16_bf16(PAF(3),VFR(3),o[0],0,0,0), C1,8); \
    GAPB(o[1]=__builtin_amdgcn_mfma_f32_32x32x16_bf16(PAF(3),VFR(7),o[1],0,0,0), C1,12); \
    }while(0)
  int t=1;
  for(;t+5<NT;t+=2){
    STEP(pB0,pB1,pA0,pA1,t,true,true,true);     WAIT_BAR(2); RESC(); ROT();
    STEP(pA0,pA1,pB0,pB1,t+1,true,true,true);   WAIT_BAR(2); RESC(); ROT();
  }
  #define ENDW(tt) do{ if((tt)+3<NT){WAIT_BAR(2);} else if((tt)+2<NT){WAIT_BAR(1);} else {WAIT_BAR(0);} }while(0)
  for(;t+1<NT;t+=2){
    STEP(pB0,pB1,pA0,pA1,t,(t+3<NT),(t+1<NT),(t+1<NT));       ENDW(t);   RESC(); ROT();
    STEP(pA0,pA1,pB0,pB1,t+1,(t+4<NT),(t+2<NT),(t+2<NT));     ENDW(t+1); RESC(); ROT();
  }
  STEP(pB0,pB1,pA0,pA1,NT-1,false,false,false); RESC();
  { float sacc=pB0[0]+pB0[1]; _Pragma("unroll") for(int r=2;r<16;++r)sacc+=pB0[r]; _Pragma("unroll") for(int r=0;r<16;++r)sacc+=pB1[r]; l_reg+=sacc;
    pw0=(u32x4){PKW(pB0,0),PKW(pB0,2),PKW(pB0,4),PKW(pB0,6)};pw1=(u32x4){PKW(pB0,8),PKW(pB0,10),PKW(pB0,12),PKW(pB0,14)};pw2=(u32x4){PKW(pB1,0),PKW(pB1,2),PKW(pB1,4),PKW(pB1,6)};pw3=(u32x4){PKW(pB1,8),PKW(pB1,10),PKW(pB1,12),PKW(pB1,14)};
    SBAR(); pv(o,vb0+sl_cur,PAF(0),PAF(1),PAF(2),PAF(3)); }
  #undef PKW
  #undef PAF
  #undef VFR
  #undef PIN
  #undef MX3
  #undef GAPA
  #undef GAPB
  #undef EX
  #undef VRD
  #undef KRD
  #undef STEP
  #undef ENDW
  {auto rr=__builtin_amdgcn_permlane32_swap(__float_as_uint(l_reg),__float_as_uint(l_reg),false,false);l_reg=__uint_as_float(rr[0])+__uint_as_float(rr[1]);}
  if(hi==0)wsf[32+r32]=l_reg;asm volatile("s_waitcnt lgkmcnt(0)":::"memory");
  float rli[16];
  #pragma unroll
  for(int r=0;r<16;++r)rli[r]=__builtin_amdgcn_rcpf(wsf[32+crow(r,hi)]);
  bf16*Ow=O+(rowbase+q0+wid*QBLK)*OP+h*D;
  { bf16*stg=(bf16*)(shm+LDS_OST)+wid*2048;
    #pragma unroll
    for(int r=0;r<16;++r){const int orow=crow(r,hi);
      #pragma unroll
      for(int d0=0;d0<2;++d0)stg[orow*64+d0*32+r32]=__float2bfloat16(o[d0][r]*rli[r]);}
    asm volatile("s_waitcnt lgkmcnt(0)":::"memory");
    #pragma unroll
    for(int i=0;i<4;++i){const int row=i*8+(lane>>3),ch=lane&7; const u32x4 v=*(const u32x4*)(stg+row*64+ch*8); ATTN_STORE16(Ow+(long)row*OP+ch*8,v);} }
  asm volatile("s_waitcnt lgkmcnt(0)\n\ts_barrier":::"memory");
  #undef DMA_K
  #undef DMA_V
  #undef CMASK
  #undef START
  #undef RESC
  #undef ROT
}
constexpr int ATTN_LDS_BYTES=LDS_BYTES;
#undef SBAR
#undef WAIT_BAR
}
typedef GAS unsigned gu32;
typedef GAS unsigned long long gu64;
#define RLX_AGENT __ATOMIC_RELAXED, __HIP_MEMORY_SCOPE_AGENT

#define XB_TMO      128
#define XB_XCNT(j)  (256  + 64 * (j))
#define XB_XSUB(j)  (1280 + 64 * (j))
#define XB_XGEN(j)  (2304 + 64 * (j))
#define XB_TOP      3328
#define XB_TOPGEN   3392
#define XCD_BAR_WORDS 3456
#define XB_SPIN_CAP (1u << 18)

__device__ __forceinline__ unsigned xb_ld(unsigned* p)              { return __hip_atomic_load(p, __ATOMIC_RELAXED, __HIP_MEMORY_SCOPE_AGENT); }
__device__ __forceinline__ unsigned xb_add(unsigned* p, unsigned v) { return __hip_atomic_fetch_add(p, v, __ATOMIC_RELAXED, __HIP_MEMORY_SCOPE_AGENT); }
__device__ __forceinline__ unsigned xb_xcc_id() { return (unsigned)__builtin_amdgcn_s_getreg((3 << 11) | 20) & 0xFu; }
#define XB_SPIN(cond, bar) do { unsigned _sp = 0; while (cond) { __builtin_amdgcn_s_sleep(1); \
    if ((++_sp & 255u) == 0u) { if (xb_ld(&(bar)[XB_TMO])) break; if (_sp > XB_SPIN_CAP) { atomicAdd(&(bar)[XB_TMO], 1u); break; } } } } while (0)

struct XcdBarrier {
    unsigned* bar; unsigned x;
    volatile LAS unsigned* st;
};

__device__ __forceinline__ XcdBarrier xcd_barrier_post(unsigned* bar, volatile LAS unsigned* st) {
    XcdBarrier b; b.bar = bar; b.x = xb_xcc_id(); b.st = st;
    if (threadIdx.x == 0) (void)xb_add(&bar[XB_XCNT(b.x)], 1u);
    return b;
}
__device__ __forceinline__ void xcd_barrier_complete(unsigned* bar, unsigned x, unsigned& nloc, unsigned& nx) {
    const unsigned G = gridDim.x * gridDim.y * gridDim.z;
    unsigned sum, cnt, mine, sp = 0u;
    for (;;) {
        sum = 0u; cnt = 0u; mine = 0u;
#pragma unroll
        for (unsigned j = 0; j < 16; ++j) { const unsigned c = xb_ld(&bar[XB_XCNT(j)]); sum += c; cnt += (c > 0u) ? 1u : 0u; mine = (j == x) ? c : mine; }
        if (sum == G) break;
        __builtin_amdgcn_s_sleep(1);
        if ((++sp & 255u) == 0u) { if (xb_ld(&bar[XB_TMO])) break; if (sp > XB_SPIN_CAP) { atomicAdd(&bar[XB_TMO], 1u); break; } }
    }
    nloc = mine > 0u ? mine : 1u; nx = cnt > 0u ? cnt : 1u;
}

__device__ __forceinline__ void xcd_barrier(const XcdBarrier& b) {
    asm volatile("s_waitcnt vmcnt(0)" ::: "memory");
    __syncthreads();
    if (threadIdx.x == 0) {
        unsigned* bar = b.bar;
        __builtin_amdgcn_s_waitcnt(0);
        unsigned nloc = b.st[0], nx = b.st[1];
        if (nloc == 0u) { xcd_barrier_complete(bar, b.x, nloc, nx); b.st[0] = nloc; b.st[1] = nx; }
        const unsigned old = xb_add(&bar[XB_XSUB(b.x)], 1u);
        const unsigned gen = old / nloc;
        if (old + 1u == (gen + 1u) * nloc) {
            __builtin_amdgcn_fence(__ATOMIC_RELEASE, "agent");
            asm volatile("s_waitcnt vmcnt(0)" ::: "memory");
            const unsigned og = xb_add(&bar[XB_TOP], 1u);
            const unsigned tg = og / nx;
            if (og + 1u == (tg + 1u) * nx) xb_add(&bar[XB_TOPGEN], 1u);
            else XB_SPIN(xb_ld(&bar[XB_TOPGEN]) == tg, bar);
            __builtin_amdgcn_fence(__ATOMIC_ACQUIRE, "agent");
            xb_add(&bar[XB_XGEN(b.x)], 1u);
            asm volatile("s_waitcnt vmcnt(0)" ::: "memory");
        } else {
            XB_SPIN(xb_ld(&bar[XB_XGEN(b.x)]) == gen, bar);
            __builtin_amdgcn_fence(__ATOMIC_ACQUIRE, "agent");
            asm volatile("s_waitcnt vmcnt(0)" ::: "memory");
        }
    }
    __syncthreads();
}
struct Ctx {
    LAS unsigned char* lds;
    unsigned char* ws;
    int tid, lane, wave, G, vcu, bx;
    const float* in[22];
    float* out;
};
enum { I_X = 0, I_C, I_CTX, I_CCTX, I_WMOD, I_BMOD, I_N1W, I_N2W, I_WIN, I_QNW, I_KNW, I_DFW, I_DBW, I_WOUT, I_RW, I_RB, I_EWG, I_EWU, I_EWD, I_SWG, I_SWU, I_SWD };

__device__ __forceinline__ float wave_sum(float v) {
#pragma unroll
    for (int o = 1; o < 64; o <<= 1) v += __shfl_xor(v, o);
    return v;
}

__device__ __forceinline__ void p0_transpose_item(const float* W, int K, int N, bf16_t* WT, int kb, int nb, int dst_row0, LAS float* scr, int lane, int mode) {
    const int k0 = 64 * kb, n0 = 32 * nb;
#pragma unroll 8
    for (int i = 0; i < 32; ++i) { const int kk = 2 * i + (lane >> 5); scr[kk * 33 + (lane & 31)] = W[(size_t)(k0 + kk) * N + n0 + (lane & 31)]; }
    LDS_WAIT(); asm volatile("" ::: "memory");
    const int c = lane & 7;
#pragma unroll
    for (int j = 0; j < 4; ++j) { const int n = (lane >> 3) + 8 * j; const LAS float* s = scr + (8 * c) * 33 + n;
        float v[8];
#pragma unroll
        for (int q = 0; q < 8; ++q) v[q] = s[q * 33];
        if (mode == 1) {
#pragma unroll
            for (int q = 0; q < 8; ++q) v[q] = v[q] - bf2f((unsigned short)f2bf(v[q]));
        }
        u32x4 o; o.x = pk2(v[0], v[1]); o.y = pk2(v[2], v[3]); o.z = pk2(v[4], v[5]); o.w = pk2(v[6], v[7]);
        *(GAS u32x4*)(WT + (size_t)(dst_row0 + n) * K + k0 + 8 * c) = o; }
    LDS_WAIT(); asm volatile("" ::: "memory");
}

__device__ __forceinline__ void phase_p0(Ctx& F) {
    float* modv = (float*)(F.ws + WS_MODV);
    if (F.bx < 96) {
        LAS float* sc = (LAS float*)F.lds;
        LAS float* red = sc + 9 * 1024;
        for (int i = F.tid; i < 9 * 1024; i += NTHR) { const int r = i >> 10, k = i & 1023; const float v = r < NB ? F.in[I_C][r * D + k] : F.in[I_CCTX][k]; sc[i] = siluf(v); }
        __syncthreads();
        const int col = F.bx * 64 + F.lane;
        const float* Wm = F.in[I_WMOD] + (size_t)(F.wave * 128) * (6 * D) + col;
        float acc[9];
#pragma unroll
        for (int r = 0; r < 9; ++r) acc[r] = 0.f;
#pragma unroll 16
        for (int k = 0; k < 128; ++k) {
            const float wv = Wm[(size_t)k * (6 * D)];
#pragma unroll
            for (int r = 0; r < 9; ++r) acc[r] += sc[r * 1024 + F.wave * 128 + k] * wv;
        }
#pragma unroll
        for (int r = 0; r < 9; ++r) red[(F.wave * 9 + r) * 64 + F.lane] = acc[r];
        __syncthreads();
        for (int i = F.tid; i < 9 * 64; i += NTHR) { const int r = i >> 6, l = i & 63; float s = 0.f;
#pragma unroll
            for (int w = 0; w < 8; ++w) s += red[(w * 9 + r) * 64 + l];
            modv[(size_t)r * (6 * D) + F.bx * 64 + l] = s + F.in[I_BMOD][F.bx * 64 + l]; }
        __syncthreads();
    }
    {
        LAS float* scr = (LAS float*)(F.lds + 57344 + F.wave * 8704);
        const int gw = ((F.bx + F.G - 96) % F.G) * NWAVES + F.wave, NGW = F.G * NWAVES;
        constexpr int I_IN = 16 * (INC / 32), I_OUT = 16 * (D / 32), I_R = 16 * (NE / 32), I_SG = 16 * (FF / 32), I_SD = 4 * (D / 32);
        constexpr int NITEMS = I_IN + I_OUT + 2 * I_R + 2 * I_SG + I_SD;
        for (int it = gw; it < NITEMS; it += NGW) {
            int r = it;
            if (r < I_IN) { const int nblk = INC / 32; p0_transpose_item(F.in[I_WIN], D, INC, (bf16_t*)(F.ws + WS_WIN), r / nblk, r % nblk, 32 * (r % nblk), scr, F.lane, 0); continue; } r -= I_IN;
            if (r < I_OUT) { const int nblk = D / 32; p0_transpose_item(F.in[I_WOUT], D, D, (bf16_t*)(F.ws + WS_WOUT), r / nblk, r % nblk, 32 * (r % nblk), scr, F.lane, 0); continue; } r -= I_OUT;
            if (r < 2 * I_R) { const int lo = r >= I_R; const int q = r - lo * I_R; const int nblk = NE / 32;
                p0_transpose_item(F.in[I_RW], D, NE, (bf16_t*)(F.ws + WS_WR), q / nblk, q % nblk, lo * 256 + 32 * (q % nblk), scr, F.lane, lo); continue; } r -= 2 * I_R;
            if (r < 2 * I_SG) { const int up = r >= I_SG; const int q = r - up * I_SG; const int nblk = FF / 32, nb = q % nblk;
                p0_transpose_item(F.in[up ? I_SWU : I_SWG], D, FF, (bf16_t*)(F.ws + WS_WSGU), q / nblk, nb, (nb >> 2) * 256 + up * 128 + (nb & 3) * 32, scr, F.lane, 0); continue; } r -= 2 * I_SG;
            { const int nblk = D / 32; p0_transpose_item(F.in[I_SWD], FF, D, (bf16_t*)(F.ws + WS_WSD), r / nblk, r % nblk, 32 * (r % nblk), scr, F.lane, 0); }
        }
    }
    if (F.bx == F.G - 1) {
        float2* tab = (float2*)(F.ws + WS_ROPE);
        for (int i = F.tid; i < 96 * 16; i += NTHR) { const int p = i >> 4, fi = i & 15; const float pos = (float)(p < 32 ? p : p - 32);
            const float ang = pos * powf(10000.f, -(float)fi / 16.f); tab[i] = make_float2(cosf(ang), sinf(ang)); }
    }
}

__device__ __forceinline__ void phase_p0b(Ctx& F) {
    const float* modv = (const float*)(F.ws + WS_MODV);
    bf16_t* HB = (bf16_t*)(F.ws + WS_HB);
    const int gw = F.vcu * NWAVES + F.wave, NGW = F.G * NWAVES;
    f32x4 nw[4];
#pragma unroll
    for (int j = 0; j < 4; ++j) nw[j] = ((const f32x4*)F.in[I_N1W])[F.lane + 64 * j];
    for (int m = gw; m < TALL; m += NGW) {
        const float* xrow = m < T ? F.in[I_X] + (size_t)m * D : F.in[I_CTX] + (size_t)(m - T) * D;
        const int r = m < T ? m / L : 8;
        const f32x4* sh = (const f32x4*)(modv + (size_t)r * (6 * D)); const f32x4* sc = sh + D / 4;
        f32x4 v[4]; float s = 0.f;
#pragma unroll
        for (int j = 0; j < 4; ++j) { v[j] = ((const f32x4*)xrow)[F.lane + 64 * j]; s += (v[j].x * v[j].x + v[j].y * v[j].y) + (v[j].z * v[j].z + v[j].w * v[j].w); }
        const float rinv = rsqrtf(wave_sum(s) * (1.f / D) + EPS);
        unsigned long long* o8 = (unsigned long long*)(HB + (size_t)m * D) + F.lane;
#pragma unroll
        for (int j = 0; j < 4; ++j) { const f32x4 a = sh[F.lane + 64 * j], b = sc[F.lane + 64 * j];
            const f32x4 o = v[j] * rinv * nw[j] * (1.f + b) + a;
            o8[64 * j] = (unsigned long long)pk2(o.x, o.y) | ((unsigned long long)pk2(o.z, o.w) << 32); }
    }
}

struct P1Order {
    int x, j;
    __device__ __forceinline__ bool next(int i, pg8::Unit& u) const {
        const int q = i * 32 + j;
        if (q < 88) { u.pm = x * 8 + q / 11; u.pn = q % 11; return true; }
        if (q < 93) { u.pm = 64 + x; u.pn = q - 88; return true; }
        return false;
    }
    __device__ __forceinline__ void a_ready(const pg8::Unit&) const {}
    __device__ __forceinline__ void done(const pg8::Unit&) const {}
};
struct EpiP1 {
    static constexpr bool PERM = true, HEADPERM = true, AFTER_DRAIN = false;
    unsigned char* ws; const float* qnw; const float* knw;
    __device__ __forceinline__ void operator()(const f32x4 (&acc)[2][2][4][2], const pg8::Unit& u, int wr, int wc, int fr, int fq) const {
        const int G = u.pn * 4 + wc;
        const bool isctx = u.pm >= 64;
        int kind, hh; bf16_t* base; int pitch;
        if (G < 2) { kind = 0; hh = G; base = (bf16_t*)(ws + WS_KB); pitch = 128; }
        else if (G < 4) { kind = 1; hh = G - 2; base = (bf16_t*)(ws + WS_VB); pitch = 128; }
        else if (G < 12) { kind = 2; hh = G - 4; base = (bf16_t*)(ws + WS_RKB); pitch = 512; }
        else if (G < 20) { kind = 1; hh = G - 12; base = (bf16_t*)(ws + WS_RVB); pitch = 512; }
        else if (G < 28) { kind = 0; hh = G - 20; base = (bf16_t*)(ws + WS_QB); pitch = 512; }
        else if (G < 36) { kind = 1; hh = G - 28; base = (bf16_t*)(ws + WS_RQB); pitch = 512; }
        else { kind = 3; hh = G - 36; base = (bf16_t*)(ws + WS_RGB); pitch = 512; }
        const bool isq = G >= 20;
        const bool keyrows = G < 20;
        f32x4 nwv[2][2];
        if (kind == 0) {
            const float* nwp = isq ? qnw : knw; const float sc = isq ? C2 : 1.f;
#pragma unroll
            for (int bj = 0; bj < 2; ++bj)
#pragma unroll
                for (int n = 0; n < 2; ++n) nwv[bj][n] = *(const f32x4*)(nwp + 32 * bj + 8 * fq + 4 * n) * sc;
        }
        const float2* tab = (const float2*)(ws + WS_ROPE);
#pragma unroll
        for (int ai = 0; ai < 2; ++ai)
#pragma unroll
            for (int m = 0; m < 4; ++m) {
                const int r = u.pm * 256 + ai * 128 + wr * 64 + m * 16 + fr;
                int b, t; if (!isctx) { b = r >> 11; t = r & 2047; } else { const int rc = r - T; b = rc >> 8; t = rc & 255; }
                const size_t drow = keyrows ? (size_t)b * LK + (isctx ? L + t : t) : (size_t)r;
                bf16_t* dst = base + drow * pitch + hh * 64 + 8 * fq;
                f32x4 v[2][2];
#pragma unroll
                for (int bj = 0; bj < 2; ++bj)
#pragma unroll
                    for (int n = 0; n < 2; ++n) v[bj][n] = acc[ai][bj][m][n];
                if (kind == 0) {
                    float ss = 0.f;
#pragma unroll
                    for (int bj = 0; bj < 2; ++bj)
#pragma unroll
                        for (int n = 0; n < 2; ++n) ss += (v[bj][n].x * v[bj][n].x + v[bj][n].y * v[bj][n].y) + (v[bj][n].z * v[bj][n].z + v[bj][n].w * v[bj][n].w);
                    ss += __shfl_xor(ss, 16); ss += __shfl_xor(ss, 32);
                    const float rinv = rsqrtf(ss * (1.f / 64.f) + EPS);
#pragma unroll
                    for (int bj = 0; bj < 2; ++bj)
#pragma unroll
                        for (int n = 0; n < 2; ++n) v[bj][n] = v[bj][n] * rinv * nwv[bj][n];
                    if (!isctx) {
                        const float2* tr = tab + (t >> 6) * 16 + 4 * fq; const float2* tc = tab + (32 + (t & 63)) * 16 + 4 * fq;
#pragma unroll
                        for (int n = 0; n < 2; ++n) {
                            const f32x4 cr = *(const f32x4*)(tr + 2 * n), cc = *(const f32x4*)(tc + 2 * n);
                            f32x4 a = v[0][n], o;
                            o.x = a.x * cr.x - a.y * cr.y; o.y = a.x * cr.y + a.y * cr.x; o.z = a.z * cr.z - a.w * cr.w; o.w = a.z * cr.w + a.w * cr.z; v[0][n] = o;
                            a = v[1][n];
                            o.x = a.x * cc.x - a.y * cc.y; o.y = a.x * cc.y + a.y * cc.x; o.z = a.z * cc.z - a.w * cc.w; o.w = a.z * cc.w + a.w * cc.z; v[1][n] = o;
                        }
                    }
                } else if (kind == 2) {
#pragma unroll
                    for (int bj = 0; bj < 2; ++bj)
#pragma unroll
                        for (int n = 0; n < 2; ++n) v[bj][n] = v[bj][n] * 0.125f;
                } else if (kind == 3) {
#pragma unroll
                    for (int bj = 0; bj < 2; ++bj)
#pragma unroll
                        for (int n = 0; n < 2; ++n) { v[bj][n].x = siluf(v[bj][n].x); v[bj][n].y = siluf(v[bj][n].y); v[bj][n].z = siluf(v[bj][n].z); v[bj][n].w = siluf(v[bj][n].w); }
                }
#pragma unroll
                for (int bj = 0; bj < 2; ++bj) { u32x4 w; w.x = pg8::cvt_pk_bf16(v[bj][0].x, v[bj][0].y); w.y = pg8::cvt_pk_bf16(v[bj][0].z, v[bj][0].w);
                    w.z = pg8::cvt_pk_bf16(v[bj][1].x, v[bj][1].y); w.w = pg8::cvt_pk_bf16(v[bj][1].z, v[bj][1].w);
                    *(u32x4*)(dst + 32 * bj) = w; }
            }
    }
};
__device__ __forceinline__ void phase_p1(Ctx& F) {
    pg8::Gemm g{(const bf16_t*)(F.ws + WS_HB), (const bf16_t*)(F.ws + WS_WIN), TALL, INC, D};
    P1Order S{F.bx & 7, F.bx >> 3};
    EpiP1 E{F.ws, F.in[I_QNW], F.in[I_KNW]};
    pg8::gemm_phase<EpiP1, P1Order, true, true>(F.lds, g, S, E);
}

typedef short v4i16_t __attribute__((ext_vector_type(4)));
typedef __attribute__((address_space(3))) const char* ldsc_ptr;
__device__ __forceinline__ v4i16_t tr_read(ldsc_ptr p) { return __builtin_amdgcn_ds_read_tr16_b64_v4i16((__attribute__((address_space(3))) v4i16_t*)p); }
#define MFMA16(a, b, c) __builtin_amdgcn_mfma_f32_16x16x32_bf16(a, b, c, 0, 0, 0)
constexpr int TRS = 136;
__device__ __forceinline__ int rsw(int r, int ch) { return r * 128 + ((ch ^ (r & 7)) << 4); }
__device__ __forceinline__ float log2_sigmoid(float x) { return -log1pf(__expf(-x)) * 1.4426950408889634f; }
__device__ __forceinline__ bf16x8 tr_frag(ldsc_ptr tile, int rb0, int rb1, int c0, int lane) {
    const int q = (lane & 15) >> 2, p = lane & 3;
    const v4i16_t a = tr_read(tile + (rb0 + q) * TRS + (c0 + 4 * p) * 2);
    const v4i16_t b = tr_read(tile + (rb1 + q) * TRS + (c0 + 4 * p) * 2);
    return (bf16x8){a[0], a[1], a[2], a[3], b[0], b[1], b[2], b[3]};
}

__device__ __forceinline__ void phase_r1(Ctx& F) {
    const bf16_t* RKB = (const bf16_t*)(F.ws + WS_RKB); const bf16_t* RVB = (const bf16_t*)(F.ws + WS_RVB);
    float* CST = (float*)(F.ws + WS_CST);
    ldsc_ptr Vt = (ldsc_ptr)F.lds, Kf = Vt + 128 * TRS, Kb = Kf + 128 * TRS;
    const int lane = F.lane, w = F.wave, fr = lane & 15, fq = lane >> 4;
    for (int u = F.vcu; u < NB * RH * NCH; u += F.G) {
        const int c = u % NCH, h = (u / NCH) % RH, b = u / (NCH * RH);
        const float l2f = log2_sigmoid(F.in[I_DFW][h]), l2b = log2_sigmoid(F.in[I_DBW][h]);
        {
            const int s = F.tid >> 2, c16 = (F.tid & 3) * 16;
            const size_t g = ((size_t)b * LK + c * 128 + s) * 512 + h * 64 + c16;
            const u32x4 k0 = *(const u32x4*)(RKB + g), k1 = *(const u32x4*)(RKB + g + 8);
            const u32x4 v0 = *(const u32x4*)(RVB + g), v1 = *(const u32x4*)(RVB + g + 8);
            const float wf = exp2f(l2f * (float)(127 - s)), wb = exp2f(l2b * (float)s);
            LAS u32x2* pv = (LAS u32x2*)((LAS char*)F.lds + s * TRS + c16 * 2);
            pv[0] = (u32x2){v0.x, v0.y}; pv[1] = (u32x2){v0.z, v0.w}; pv[2] = (u32x2){v1.x, v1.y}; pv[3] = (u32x2){v1.z, v1.w};
            LAS u32x2* pf = (LAS u32x2*)((LAS char*)F.lds + 128 * TRS + s * TRS + c16 * 2);
            LAS u32x2* pb = (LAS u32x2*)((LAS char*)F.lds + 256 * TRS + s * TRS + c16 * 2);
            const unsigned kk[8] = {k0.x, k0.y, k0.z, k0.w, k1.x, k1.y, k1.z, k1.w};
#pragma unroll
            for (int i = 0; i < 4; ++i) {
                const float a0 = bflo(kk[2 * i]), a1 = bfhi(kk[2 * i]), a2 = bflo(kk[2 * i + 1]), a3 = bfhi(kk[2 * i + 1]);
                pf[i] = (u32x2){pk2(a0 * wf, a1 * wf), pk2(a2 * wf, a3 * wf)};
                pb[i] = (u32x2){pk2(a0 * wb, a1 * wb), pk2(a2 * wb, a3 * wb)};
            }
        }
        __syncthreads();
        const int dir = w >> 2, et = w & 3;
        ldsc_ptr Kt = dir ? Kb : Kf;
        f32x4 acc[4];
#pragma unroll
        for (int dt = 0; dt < 4; ++dt) acc[dt] = (f32x4){0.f, 0.f, 0.f, 0.f};
#pragma unroll
        for (int ks = 0; ks < 4; ++ks) {
            const int rb0 = 32 * ks + 8 * fq, rb1 = rb0 + 4;
            const bf16x8 a = tr_frag(Vt, rb0, rb1, 16 * et, lane);
#pragma unroll
            for (int dt = 0; dt < 4; ++dt) { const bf16x8 bb = tr_frag(Kt, rb0, rb1, 16 * dt, lane); acc[dt] = MFMA16(a, bb, acc[dt]); }
        }
        float* o = CST + ((((size_t)b * RH + h) * NCH + c) * 2 + dir) * 4096;
#pragma unroll
        for (int dt = 0; dt < 4; ++dt)
#pragma unroll
            for (int r = 0; r < 4; ++r) o[(16 * et + 4 * fq + r) * 64 + 16 * dt + fr] = acc[dt][r];
        __syncthreads();
    }
}

__device__ __forceinline__ void ret_unit(Ctx& F, int b, int h, int n) {
    const bf16_t* RKB = (const bf16_t*)(F.ws + WS_RKB); const bf16_t* RVB = (const bf16_t*)(F.ws + WS_RVB);
    const bf16_t* RQB = (const bf16_t*)(F.ws + WS_RQB); const bf16_t* RGB = (const bf16_t*)(F.ws + WS_RGB);
    const float* CST = (const float*)(F.ws + WS_CST); bf16_t* CAT = (bf16_t*)(F.ws + WS_CAT);
    LAS char* base = (LAS char*)F.lds;
    ldsc_ptr Qt = (ldsc_ptr)base, Kt = Qt + 16384, Vt = Kt + 16384, SfT = Vt + 128 * TRS, SbT = SfT + 8192;
    const int lane = F.lane, w = F.wave, fr = lane & 15, fq = lane >> 4;
    const float l2f = log2_sigmoid(F.in[I_DFW][h]), l2b = log2_sigmoid(F.in[I_DBW][h]);
    {
        const int s = F.tid >> 2, c2 = (F.tid & 3) * 2;
        const size_t gq = ((size_t)b * L + n * 128 + s) * 512 + h * 64 + c2 * 8;
        const size_t gk = ((size_t)b * LK + n * 128 + s) * 512 + h * 64 + c2 * 8;
        const u32x4 q0 = *(const u32x4*)(RQB + gq), q1 = *(const u32x4*)(RQB + gq + 8);
        const u32x4 k0 = *(const u32x4*)(RKB + gk), k1 = *(const u32x4*)(RKB + gk + 8);
        const u32x4 v0 = *(const u32x4*)(RVB + gk), v1 = *(const u32x4*)(RVB + gk + 8);
        *(LAS u32x4*)(base + rsw(s, c2)) = q0; *(LAS u32x4*)(base + rsw(s, c2 + 1)) = q1;
        *(LAS u32x4*)(base + 16384 + rsw(s, c2)) = k0; *(LAS u32x4*)(base + 16384 + rsw(s, c2 + 1)) = k1;
        LAS u32x2* pv = (LAS u32x2*)(base + 32768 + s * TRS + c2 * 16);
        pv[0] = (u32x2){v0.x, v0.y}; pv[1] = (u32x2){v0.z, v0.w}; pv[2] = (u32x2){v1.x, v1.y}; pv[3] = (u32x2){v1.z, v1.w};
        const int e = F.tid >> 3, ch = F.tid & 7;
        const float* cb = CST + (((size_t)b * RH + h) * NCH) * 2 * 4096 + e * 64 + ch * 8;
        const float gcf = exp2f(l2f * 128.f), gcb = exp2f(l2b * 128.f);
        f32x4 sf0 = {0.f, 0.f, 0.f, 0.f}, sf1 = sf0, sb0 = sf0, sb1 = sf0;
        for (int v = -2; v < n; ++v) { const int cc = v < 0 ? 18 + v : v; const float* p = cb + (size_t)(cc * 2 + 0) * 4096;
            sf0 = sf0 * gcf + *(const f32x4*)p; sf1 = sf1 * gcf + *(const f32x4*)(p + 4); }
        for (int v = 17; v > n; --v) { const float* p = cb + (size_t)(v * 2 + 1) * 4096;
            sb0 = sb0 * gcb + *(const f32x4*)p; sb1 = sb1 * gcb + *(const f32x4*)(p + 4); }
        *(LAS u32x4*)(base + 32768 + 128 * TRS + rsw(e, ch)) = (u32x4){pk2(sf0.x, sf0.y), pk2(sf0.z, sf0.w), pk2(sf1.x, sf1.y), pk2(sf1.z, sf1.w)};
        *(LAS u32x4*)(base + 32768 + 128 * TRS + 8192 + rsw(e, ch)) = (u32x4){pk2(sb0.x, sb0.y), pk2(sb0.z, sb0.w), pk2(sb1.x, sb1.y), pk2(sb1.z, sb1.w)};
    }
    __syncthreads();
    bf16x8 qf[2];
#pragma unroll
    for (int kk = 0; kk < 2; ++kk) qf[kk] = *(const LAS bf16x8*)(Qt + rsw(16 * w + fr, 4 * kk + fq));
    f32x4 sc[8];
#pragma unroll
    for (int nt = 0; nt < 8; ++nt) { sc[nt] = (f32x4){0.f, 0.f, 0.f, 0.f};
#pragma unroll
        for (int kk = 0; kk < 2; ++kk) { const bf16x8 kf = *(const LAS bf16x8*)(Kt + rsw(16 * nt + fr, 4 * kk + fq)); sc[nt] = MFMA16(kf, qf[kk], sc[nt]); } }
    const int cpos = 16 * w + fr;
#pragma unroll
    for (int nt = 0; nt < 8; ++nt)
#pragma unroll
        for (int r = 0; r < 4; ++r) { const int s = 16 * nt + 4 * fq + r; const int df = cpos - s;
            float wgt = 0.f; if (df >= 0) wgt += exp2f(l2f * (float)df); if (df <= 0) wgt += exp2f(l2b * (float)(-df));
            sc[nt][r] *= wgt; }
    f32x4 acc[4], af[4], ab[4];
#pragma unroll
    for (int et = 0; et < 4; ++et) { acc[et] = (f32x4){0.f, 0.f, 0.f, 0.f}; af[et] = acc[et]; ab[et] = acc[et]; }
#pragma unroll
    for (int kk = 0; kk < 4; ++kk) {
        u32x4 pw; pw.x = pk2(sc[2 * kk][0], sc[2 * kk][1]); pw.y = pk2(sc[2 * kk][2], sc[2 * kk][3]); pw.z = pk2(sc[2 * kk + 1][0], sc[2 * kk + 1][1]); pw.w = pk2(sc[2 * kk + 1][2], sc[2 * kk + 1][3]);
        const bf16x8 pb = __builtin_bit_cast(bf16x8, pw);
#pragma unroll
        for (int et = 0; et < 4; ++et) { const bf16x8 va = tr_frag(Vt, 32 * kk + 4 * fq, 32 * kk + 16 + 4 * fq, 16 * et, lane); acc[et] = MFMA16(va, pb, acc[et]); }
    }
#pragma unroll
    for (int et = 0; et < 4; ++et)
#pragma unroll
        for (int kk = 0; kk < 2; ++kk) {
            const bf16x8 sfa = *(const LAS bf16x8*)(SfT + rsw(16 * et + fr, 4 * kk + fq)); af[et] = MFMA16(sfa, qf[kk], af[et]);
            const bf16x8 sba = *(const LAS bf16x8*)(SbT + rsw(16 * et + fr, 4 * kk + fq)); ab[et] = MFMA16(sba, qf[kk], ab[et]);
        }
    const float xif = exp2f(l2f * (float)(cpos + 1)), xib = exp2f(l2b * (float)(128 - cpos));
    float ss = 0.f;
#pragma unroll
    for (int et = 0; et < 4; ++et) { acc[et] = acc[et] + af[et] * xif + ab[et] * xib; ss += (acc[et].x * acc[et].x + acc[et].y * acc[et].y) + (acc[et].z * acc[et].z + acc[et].w * acc[et].w); }
    ss += __shfl_xor(ss, 16); ss += __shfl_xor(ss, 32);
    const float rinv = rsqrtf(ss * (1.f / 64.f) + EPS);
    const size_t row = (size_t)b * L + n * 128 + cpos;
#pragma unroll
    for (int et = 0; et < 4; ++et) {
        const u32x2 gg = *(const u32x2*)(RGB + row * 512 + h * 64 + 16 * et + 4 * fq);
        const f32x4 y = acc[et] * rinv;
        u32x2 o; o.x = pk2(y.x * bflo(gg.x), y.y * bfhi(gg.x)); o.y = pk2(y.z * bflo(gg.y), y.w * bfhi(gg.y));
        *(u32x2*)(CAT + row * D + 512 + h * 64 + 16 * et + 4 * fq) = o;
    }
    __syncthreads();
}

__device__ __forceinline__ void phase_mix(Ctx& F) {
    for (int u = F.vcu; u < NB * AH * (L / 256); u += F.G) {
        const int pair = u >> 5, j = u & 31, b = pair >> 1, kvh = pair & 1, hq = kvh * 4 + (j >> 3), qb = j & 7;
        attn_body::attn_unit<8>(b, hq, kvh, qb, (const attn_body::bf16*)(F.ws + WS_QB), (const attn_body::bf16*)(F.ws + WS_KB), (const attn_body::bf16*)(F.ws + WS_VB),
                                (attn_body::bf16*)(F.ws + WS_CAT), (char*)F.lds);
    }
    __syncthreads();
    for (int u = F.vcu; u < NB * RH * (L / 128); u += F.G) { const int n = u & 15, h = (u >> 4) & 7, b = u >> 7; ret_unit(F, b, h, n); }
}

struct EpiX1 {
    static constexpr bool PERM = true, HEADPERM = false, AFTER_DRAIN = false;
    const float* x; const float* modv; float* x1;
    __device__ __forceinline__ void operator()(const f32x4 (&acc)[2][2][4][2], const pg8::Unit& u, int wr, int wc, int fr, int fq) const {
        const int col0 = u.pn * 256 + wc * 32 + 8 * fq;
#pragma unroll
        for (int ai = 0; ai < 2; ++ai)
#pragma unroll
            for (int m = 0; m < 4; ++m) {
                const int r = u.pm * 256 + ai * 128 + wr * 64 + m * 16 + fr; const int b = r >> 11;
                const float* g1 = modv + (size_t)b * (6 * D) + 2 * D;
#pragma unroll
                for (int bj = 0; bj < 2; ++bj)
#pragma unroll
                    for (int n = 0; n < 2; ++n) { const int c = col0 + bj * 128 + 4 * n; const size_t off = (size_t)r * D + c;
                        *(f32x4*)(x1 + off) = *(const f32x4*)(x + off) + *(const f32x4*)(g1 + c) * acc[ai][bj][m][n]; }
            }
    }
};
__device__ __forceinline__ void phase_p4(Ctx& F) {
    pg8::Gemm g{(const bf16_t*)(F.ws + WS_CAT), (const bf16_t*)(F.ws + WS_WOUT), T, D, D};
    pg8::StaticOrder S; S.init(T, D, F.G, F.bx);
    EpiX1 E{F.in[I_X], (const float*)(F.ws + WS_MODV), (float*)(F.ws + WS_X1)};
    pg8::gemm_phase<EpiX1, pg8::StaticOrder, true, true>(F.lds, g, S, E);
}

__device__ __forceinline__ void phase_p5(Ctx& F) {
    const float* modv = (const float*)(F.ws + WS_MODV); const float* X1 = (const float*)(F.ws + WS_X1);
    bf16_t* H2 = (bf16_t*)(F.ws + WS_H2B);
    const int gw = F.vcu * NWAVES + F.wave, NGW = F.G * NWAVES;
    f32x4 nw[4];
#pragma unroll
    for (int j = 0; j < 4; ++j) nw[j] = ((const f32x4*)F.in[I_N2W])[F.lane + 64 * j];
    for (int m = gw; m < T; m += NGW) {
        const f32x4* sh = (const f32x4*)(modv + (size_t)(m / L) * (6 * D) + 3 * D); const f32x4* sc = sh + D / 4;
        f32x4 v[4]; float s = 0.f;
#pragma unroll
        for (int j = 0; j < 4; ++j) { v[j] = ((const f32x4*)(X1 + (size_t)m * D))[F.lane + 64 * j]; s += (v[j].x * v[j].x + v[j].y * v[j].y) + (v[j].z * v[j].z + v[j].w * v[j].w); }
        const float rinv = rsqrtf(wave_sum(s) * (1.f / D) + EPS);
        unsigned long long* oh = (unsigned long long*)(H2 + (size_t)m * D) + F.lane; unsigned long long* ol = (unsigned long long*)(H2 + (size_t)(T + m) * D) + F.lane;
#pragma unroll
        for (int j = 0; j < 4; ++j) { const f32x4 a = sh[F.lane + 64 * j], b = sc[F.lane + 64 * j];
            const f32x4 o = v[j] * rinv * nw[j] * (1.f + b) + a;
            const unsigned h0 = pk2(o.x, o.y), h1 = pk2(o.z, o.w);
            oh[64 * j] = (unsigned long long)h0 | ((unsigned long long)h1 << 32);
            const unsigned l0 = pk2(o.x - bflo(h0), o.y - bfhi(h0)), l1 = pk2(o.z - bflo(h1), o.w - bfhi(h1));
            ol[64 * j] = (unsigned long long)l0 | ((unsigned long long)l1 << 32); }
    }
}

struct P6Order {
    int c, G;
    __device__ __forceinline__ bool next(int i, pg8::Unit& u) const {
        const int q = i * G + c; if (q >= 320) return false;
        const int t = q >> 6, m = q & 63;
        u.pm = (t == 1) ? 64 + m : m; u.pn = (t <= 1) ? 0 : t - 1; return true;
    }
    __device__ __forceinline__ void a_ready(const pg8::Unit&) const {}
    __device__ __forceinline__ void done(const pg8::Unit&) const {}
};
struct EpiP6 {
    static constexpr bool PERM = true, HEADPERM = false, AFTER_DRAIN = false;
    float* logp; bf16_t* acts;
    __device__ __forceinline__ void operator()(const f32x4 (&acc)[2][2][4][2], const pg8::Unit& u, int wr, int wc, int fr, int fq) const {
        if (u.pn < 2) {
            const int part = u.pn == 1 ? 2 : (u.pm >= 64 ? 1 : 0); const int pm = u.pm & 63;
            float* o = logp + (size_t)part * T * NE;
#pragma unroll
            for (int ai = 0; ai < 2; ++ai)
#pragma unroll
                for (int m = 0; m < 4; ++m) { const int r = pm * 256 + ai * 128 + wr * 64 + m * 16 + fr;
#pragma unroll
                    for (int bj = 0; bj < 2; ++bj)
#pragma unroll
                        for (int n = 0; n < 2; ++n) *(f32x4*)(o + (size_t)r * NE + bj * 128 + wc * 32 + 8 * fq + 4 * n) = acc[ai][bj][m][n]; }
        } else {
            const int f0 = (u.pn - 2) * 128 + wc * 32 + 8 * fq;
#pragma unroll
            for (int ai = 0; ai < 2; ++ai)
#pragma unroll
                for (int m = 0; m < 4; ++m) { const int r = u.pm * 256 + ai * 128 + wr * 64 + m * 16 + fr;
                    const f32x4 g0 = acc[ai][0][m][0], g1 = acc[ai][0][m][1], u0 = acc[ai][1][m][0], u1 = acc[ai][1][m][1];
                    u32x4 w; w.x = pg8::cvt_pk_bf16(siluf(g0.x) * u0.x, siluf(g0.y) * u0.y); w.y = pg8::cvt_pk_bf16(siluf(g0.z) * u0.z, siluf(g0.w) * u0.w);
                    w.z = pg8::cvt_pk_bf16(siluf(g1.x) * u1.x, siluf(g1.y) * u1.y); w.w = pg8::cvt_pk_bf16(siluf(g1.z) * u1.z, siluf(g1.w) * u1.w);
                    *(u32x4*)(acts + (size_t)r * FF + f0) = w; }
        }
    }
};
__device__ __forceinline__ void phase_p6(Ctx& F) {
    pg8::Gemm g{(const bf16_t*)(F.ws + WS_H2B), (const bf16_t*)(F.ws + WS_WR), 2 * T, 1024, D};
    P6Order S{F.vcu, F.G};
    EpiP6 E{(float*)(F.ws + WS_LOGP), (bf16_t*)(F.ws + WS_ACTS)};
    pg8::gemm_phase<EpiP6, P6Order, true, true>(F.lds, g, S, E);
}

__device__ __forceinline__ void phase_p7(Ctx& F) {
    const float* LOGP = (const float*)(F.ws + WS_LOGP); const float* rbias = F.in[I_RB];
    int* RIDX = (int*)(F.ws + WS_RIDX); float* RWT = (float*)(F.ws + WS_RWT);
    int* SDST = (int*)(F.ws + WS_SDST); float* SW = (float*)(F.ws + WS_SW);
    unsigned* ecnt = (unsigned*)(F.ws + WS_CTL) + CW_ECNT;
    const int gw = F.vcu * NWAVES + F.wave, NGW = F.G * NWAVES, lane = F.lane;
    const f32x4 bi = ((const f32x4*)rbias)[lane];
    for (int tok = gw; tok < T; tok += NGW) {
        const f32x4 lg = ((const f32x4*)(LOGP + (size_t)tok * NE))[lane] + ((const f32x4*)(LOGP + (size_t)(T + tok) * NE))[lane] + ((const f32x4*)(LOGP + (size_t)(2 * T + tok) * NE))[lane];
        const float s0 = sigmoidf_(lg.x), s1 = sigmoidf_(lg.y), s2 = sigmoidf_(lg.z), s3 = sigmoidf_(lg.w);
        float v0 = s0 + bi.x, v1 = s1 + bi.y, v2 = s2 + bi.z, v3 = s3 + bi.w;
        float gs = 0.f;
        {
            float a0 = v0, a1 = v1, a2 = v2, a3 = v3;
#pragma unroll
            for (int r = 0; r < 2; ++r) {
                float mv = a0; int mi = lane * 4;
                if (a1 > mv) { mv = a1; mi = lane * 4 + 1; }
                if (a2 > mv) { mv = a2; mi = lane * 4 + 2; }
                if (a3 > mv) { mv = a3; mi = lane * 4 + 3; }
#pragma unroll
                for (int o = 1; o < 8; o <<= 1) { const float ov = __shfl_xor(mv, o); const int oi = __shfl_xor(mi, o); if (ov > mv || (ov == mv && oi < mi)) { mv = ov; mi = oi; } }
                gs += mv;
                if (mi == lane * 4) a0 = -INFINITY; if (mi == lane * 4 + 1) a1 = -INFINITY; if (mi == lane * 4 + 2) a2 = -INFINITY; if (mi == lane * 4 + 3) a3 = -INFINITY;
            }
        }
        const int g = lane >> 3; int rank = 0;
#pragma unroll
        for (int g2 = 0; g2 < 8; ++g2) { const float o = __shfl(gs, g2 * 8); if (o > gs || (o == gs && g2 < g)) ++rank; }
        if (rank >= 4) { v0 = v1 = v2 = v3 = -INFINITY; }
        float wsum = 0.f, myw = 0.f; int myi = 0;
#pragma unroll
        for (int r = 0; r < TOPK; ++r) {
            float mv = v0; int mi = lane * 4;
            if (v1 > mv) { mv = v1; mi = lane * 4 + 1; }
            if (v2 > mv) { mv = v2; mi = lane * 4 + 2; }
            if (v3 > mv) { mv = v3; mi = lane * 4 + 3; }
#pragma unroll
            for (int o = 1; o < 64; o <<= 1) { const float ov = __shfl_xor(mv, o); const int oi = __shfl_xor(mi, o); if (ov > mv || (ov == mv && oi < mi)) { mv = ov; mi = oi; } }
            const int own = mi >> 2, sub = mi & 3;
            float sv = sub == 0 ? s0 : sub == 1 ? s1 : sub == 2 ? s2 : s3;
            sv = __shfl(sv, own);
            wsum += sv;
            if (lane == r) { myw = sv; myi = mi; }
            if (lane == own) { if (sub == 0) v0 = -INFINITY; if (sub == 1) v1 = -INFINITY; if (sub == 2) v2 = -INFINITY; if (sub == 3) v3 = -INFINITY; }
        }
        if (lane < TOPK) {
            const float wt = myw / wsum * 2.5f;
            RIDX[(size_t)tok * TOPK + lane] = myi; RWT[(size_t)tok * TOPK + lane] = wt;
            const unsigned pos = __hip_atomic_fetch_add(ecnt + myi, 1u, __ATOMIC_RELAXED, __HIP_MEMORY_SCOPE_AGENT);
            SDST[(size_t)myi * CAP + pos] = tok * TOPK + lane; SW[(size_t)myi * CAP + pos] = wt;
        }
    }
}

struct EpiSD {
    static constexpr bool PERM = true, HEADPERM = false, AFTER_DRAIN = false;
    const float* x1; const float* modv; float* out;
    __device__ __forceinline__ void operator()(const f32x4 (&acc)[2][2][4][2], const pg8::Unit& u, int wr, int wc, int fr, int fq) const {
        const int col0 = u.pn * 256 + wc * 32 + 8 * fq;
#pragma unroll
        for (int ai = 0; ai < 2; ++ai)
#pragma unroll
            for (int m = 0; m < 4; ++m) {
                const int r = u.pm * 256 + ai * 128 + wr * 64 + m * 16 + fr; const int b = r >> 11;
                const float* g2 = modv + (size_t)b * (6 * D) + 5 * D;
#pragma unroll
                for (int bj = 0; bj < 2; ++bj)
#pragma unroll
                    for (int n = 0; n < 2; ++n) { const int c = col0 + bj * 128 + 4 * n; const size_t off = (size_t)r * D + c;
                        *(f32x4*)(out + off) = *(const f32x4*)(x1 + off) + *(const f32x4*)(g2 + c) * acc[ai][bj][m][n]; }
            }
    }
};

constexpr int TAB_OFF = LDSCTL_OFF + 1024;
constexpr int MOE_ACT1 = 0, MOE_ACT0 = 49152, MOE_AST = 0, MOE_BST = 98304, MOE_BM = 192;
__device__ __forceinline__ int sw64(int row, int ch) { return row * 64 + ((ch ^ ((row >> 1) & 3)) << 4); }

__device__ __forceinline__ void moe_unit(Ctx& F, int e, int row0, int nrows) {
    const bf16_t* H2 = (const bf16_t*)(F.ws + WS_H2B);
    const int* SDST = (const int*)(F.ws + WS_SDST) + (size_t)e * CAP + row0; const float* SW = (const float*)(F.ws + WS_SW) + (size_t)e * CAP + row0;
    bf16_t* YEXP = (bf16_t*)(F.ws + WS_YEXP);
    const float* Wg = F.in[I_EWG] + (size_t)e * D * FF; const float* Wu = F.in[I_EWU] + (size_t)e * D * FF; const float* Wd = F.in[I_EWD] + (size_t)e * FF * D;
    LAS char* lds = (LAS char*)F.lds;
    int tid = F.tid; asm volatile("" : "+v"(tid));
    const int lane = tid & 63, w = __builtin_amdgcn_readfirstlane(tid >> 6), wr = w >> 1, wc = w & 1, fr = lane & 15, fq = lane >> 4;
    const int mc = (nrows + 63) >> 6;
    const char* H2c = (const char*)H2;
    unsigned asrc0, asrc1; int aw0, aw1;
    { const int r0 = tid >> 2, r1 = (tid + 512) >> 2, ch = tid & 3;
      asrc0 = (unsigned)(((SDST[r0 < nrows ? r0 : 0] >> 3) * D + ch * 8) * 2); asrc1 = (unsigned)(((SDST[(r1 < nrows) ? r1 : 0] >> 3) * D + ch * 8) * 2);
      aw0 = MOE_AST + sw64(r0, ch); aw1 = MOE_AST + sw64(r1, ch); }
    const bool a2 = tid < 256;
    const int kc = w & 3, whi = w >> 2;
    int p0_gu; { const int ffl = 2 * lane; p0_gu = 128 * (ffl >> 6) + 64 * whi + (ffl & 63); }
    const int p0_d = 2 * (lane + 64 * whi);
    const int bw_gu = MOE_BST + sw64(p0_gu, kc), bw_d = MOE_BST + sw64(p0_d, kc);
    const int fsw = ((fq ^ ((fr >> 1) & 3)) << 4);
    const int ab = MOE_AST + (wr * 16 * mc + fr) * 64 + fsw;
    const int bb = MOE_BST + (128 * wc + fr) * 64 + fsw;
    const int trow = wr * 16 * mc + fr;
    f32x4 acc[3][8];
    u32x4 ar0a, ar0b, ar1a, ar1b; float2 br0[8], br1[8];
#define MOE_ZERO() do { _Pragma("unroll") for (int m = 0; m < 3; ++m) _Pragma("unroll") for (int n = 0; n < 8; ++n) acc[m][n] = (f32x4){0.f, 0.f, 0.f, 0.f}; } while (0)
#define MOE_MMA(AFR, m) do { _Pragma("unroll") for (int n = 0; n < 8; ++n) acc[m][n] = MFMA16(bfr[n], AFR, acc[m][n]); } while (0)
#define MOE_LDB(BUF) bf16x8 bfr[8]; _Pragma("unroll") for (int n = 0; n < 8; ++n) bfr[n] = *(const LAS bf16x8*)(lds + bb + ((BUF) * 16384 + n * 1024))
#define MOE_BWRITE(BUF, R, o0) do { u32x4 c0, c1; \
        c0.x = pg8::cvt_pk_bf16(R[0].x, R[1].x); c0.y = pg8::cvt_pk_bf16(R[2].x, R[3].x); c0.z = pg8::cvt_pk_bf16(R[4].x, R[5].x); c0.w = pg8::cvt_pk_bf16(R[6].x, R[7].x); \
        c1.x = pg8::cvt_pk_bf16(R[0].y, R[1].y); c1.y = pg8::cvt_pk_bf16(R[2].y, R[3].y); c1.z = pg8::cvt_pk_bf16(R[4].y, R[5].y); c1.w = pg8::cvt_pk_bf16(R[6].y, R[7].y); \
        *(LAS u32x4*)(lds + (o0) + (BUF) * 16384) = c0; *(LAS u32x4*)(lds + (o0) + ((BUF) * 16384 + 64)) = c1; } while (0)
    {
        const float* bsrc = (whi ? Wu : Wg) + (size_t)(8 * kc) * FF + 2 * lane;
#define GU_LOAD(s, RA, RB, RBR) do { const int kk_ = (s) & 31, nt_ = (s) >> 5; \
        RA = *(const u32x4*)(H2c + (size_t)(asrc0 + (unsigned)(kk_ * 64))); RB = *(const u32x4*)(H2c + (size_t)(asrc1 + (unsigned)(kk_ * 64))); \
        const float* bp_ = bsrc + (size_t)(kk_ * 32) * FF + nt_ * 128; \
        _Pragma("unroll") for (int j = 0; j < 8; ++j) RBR[j] = *(const float2*)(bp_ + (size_t)j * FF); } while (0)
#define GU_AWRITE(BUF, RA, RB) do { *(LAS u32x4*)(lds + aw0 + (BUF) * 12288) = RA; if (a2) *(LAS u32x4*)(lds + aw1 + (BUF) * 12288) = RB; } while (0)
#define GU_COMPUTE(BUF) do { MOE_LDB(BUF); \
        _Pragma("unroll") for (int m = 0; m < 3; ++m) if (m < mc) { const bf16x8 afr = *(const LAS bf16x8*)(lds + ab + ((BUF) * 12288 + m * 1024)); MOE_MMA(afr, m); } } while (0)
#define GU_EPI(nt) do { \
        _Pragma("unroll") for (int m = 0; m < 3; ++m) if (m < mc) { const int tr = trow + 16 * m; \
            _Pragma("unroll") for (int n = 0; n < 4; ++n) { const f32x4 g = acc[m][n], u = acc[m][n + 4]; \
                u32x2 o; o.x = pg8::cvt_pk_bf16(siluf(g.x) * u.x * wsl[m], siluf(g.y) * u.y * wsl[m]); o.y = pg8::cvt_pk_bf16(siluf(g.z) * u.z * wsl[m], siluf(g.w) * u.w * wsl[m]); \
                const int c = 8 * wc + 2 * n + (fq >> 1); \
                *(LAS u32x2*)(lds + ((nt) ? MOE_ACT1 : MOE_ACT0) + tr * 256 + ((c ^ (tr & 15)) << 4) + (fq & 1) * 8) = o; } } \
        MOE_ZERO(); } while (0)
        float wsl[3];
#pragma unroll
        for (int m = 0; m < 3; ++m) { const int tr = trow + 16 * m; wsl[m] = (m < mc && tr < nrows) ? SW[tr] : 0.f; }
        MOE_ZERO();
        GU_LOAD(0, ar0a, ar0b, br0); GU_LOAD(1, ar1a, ar1b, br1);
        GU_AWRITE(0, ar0a, ar0b); MOE_BWRITE(0, br0, bw_gu);
        __syncthreads();
#pragma unroll 1
        for (int nt = 0; nt < 2; ++nt) {
#pragma unroll 1
            for (int s = 32 * nt; s < 32 * nt + 32; s += 2) {
                { const int sl = min(s + 2, 63); GU_LOAD(sl, ar0a, ar0b, br0); }
                GU_COMPUTE(0);
                GU_AWRITE(1, ar1a, ar1b); MOE_BWRITE(1, br1, bw_gu);
                __syncthreads();
                { const int sl = min(s + 3, 63); GU_LOAD(sl, ar1a, ar1b, br1); }
                GU_COMPUTE(1);
                GU_AWRITE(0, ar0a, ar0b); MOE_BWRITE(0, br0, bw_gu);
                __syncthreads();
            }
            if (nt == 0) { GU_EPI(0); } else { GU_EPI(1); }
        }
#undef GU_LOAD
#undef GU_AWRITE
#undef GU_COMPUTE
#undef GU_EPI
    }
    {
        const float* bsrc = Wd + (size_t)(8 * kc) * D + p0_d;
#define DN_LOAD(s, RBR) do { const int kk_ = (s) & 7, nt_ = (s) >> 3; const float* bp_ = bsrc + (size_t)(kk_ * 32) * D + nt_ * 256; \
        _Pragma("unroll") for (int j = 0; j < 8; ++j) RBR[j] = *(const float2*)(bp_ + (size_t)j * D); } while (0)
#define DN_COMPUTE(BUF, s) do { MOE_LDB(BUF); const int kk_ = (s) & 7; const int abase_ = ((kk_ >> 2) ? MOE_ACT1 : MOE_ACT0) + (((4 * (kk_ & 3) + fq) ^ fr) << 4) + trow * 256; \
        _Pragma("unroll") for (int m = 0; m < 3; ++m) if (m < mc) { const bf16x8 afr = *(const LAS bf16x8*)(lds + abase_ + m * 4096); MOE_MMA(afr, m); } } while (0)
#define DN_EPI(nt) do { \
        _Pragma("unroll") for (int m = 0; m < 3; ++m) if (dst[m] >= 0) { \
            _Pragma("unroll") for (int n = 0; n < 8; ++n) { const f32x4 v = acc[m][n]; u32x2 o; o.x = pg8::cvt_pk_bf16(v.x, v.y); o.y = pg8::cvt_pk_bf16(v.z, v.w); \
                *(u32x2*)(YEXP + (size_t)dst[m] * D + (nt) * 256 + 128 * wc + 16 * n + 4 * fq) = o; } } \
        MOE_ZERO(); } while (0)
        int dst[3];
#pragma unroll
        for (int m = 0; m < 3; ++m) { const int tr = trow + 16 * m; dst[m] = (m < mc && tr < nrows) ? SDST[tr] : -1; }
        DN_LOAD(0, br0); DN_LOAD(1, br1);
        __syncthreads();
        MOE_BWRITE(0, br0, bw_d);
        __syncthreads();
#pragma unroll 1
        for (int nt = 0; nt < 4; ++nt) {
#pragma unroll 1
            for (int s = 8 * nt; s < 8 * nt + 8; s += 2) {
                { const int sl = min(s + 2, 31); DN_LOAD(sl, br0); }
                DN_COMPUTE(0, s);
                MOE_BWRITE(1, br1, bw_d);
                __syncthreads();
                { const int sl = min(s + 3, 31); DN_LOAD(sl, br1); }
                DN_COMPUTE(1, s + 1);
                MOE_BWRITE(0, br0, bw_d);
                __syncthreads();
            }
            DN_EPI(nt);
        }
#undef DN_LOAD
#undef DN_COMPUTE
#undef DN_EPI
    }
#undef MOE_ZERO
#undef MOE_MMA
#undef MOE_LDB
#undef MOE_BWRITE
}

__device__ __forceinline__ void phase_moe(Ctx& F) {
    {
        pg8::Gemm g{(const bf16_t*)(F.ws + WS_ACTS), (const bf16_t*)(F.ws + WS_WSD), T, D, FF};
        pg8::StaticOrder S; S.init(T, D, F.G, F.bx);
        EpiSD E{(const float*)(F.ws + WS_X1), (const float*)(F.ws + WS_MODV), F.out};
        pg8::gemm_phase<EpiSD, pg8::StaticOrder, true, true>(F.lds, g, S, E);
    }
    __syncthreads();
    LAS int* cnt = (LAS int*)(F.lds + TAB_OFF); LAS int* pstart = cnt + 256; LAS int* tstart = pstart + 257;
    const unsigned* ecnt = (const unsigned*)(F.ws + WS_CTL) + CW_ECNT;
    if (F.tid < NE) cnt[F.tid] = (int)__hip_atomic_load(ecnt + F.tid, __ATOMIC_RELAXED, __HIP_MEMORY_SCOPE_AGENT);
    __syncthreads();
    if (F.tid == 0) { int a = 0, t = 0; for (int e = 0; e < NE; ++e) { pstart[e] = a; tstart[e] = t; a += cnt[e]; t += (cnt[e] + MOE_BM - 1) / MOE_BM; } pstart[NE] = a; tstart[NE] = t; }
    __syncthreads();
    const int ntot = tstart[NE];
    for (int u = F.vcu; u < ntot; u += F.G) {
        int lo = 0, hi = NE;
        while (hi - lo > 1) { const int mid = (lo + hi) >> 1; if (tstart[mid] <= u) lo = mid; else hi = mid; }
        const int e = lo, c = cnt[e], nt = (c + MOE_BM - 1) / MOE_BM, mt = u - tstart[e];
        const int rpt = (c + nt - 1) / nt, row0 = mt * rpt, nrows = min(rpt, c - row0);
        if (nrows > 0) moe_unit(F, e, row0, nrows);
    }
}

__device__ __forceinline__ void phase_final(Ctx& F) {
    const float* modv = (const float*)(F.ws + WS_MODV); const bf16_t* YEXP = (const bf16_t*)(F.ws + WS_YEXP);
    const int gw = F.vcu * NWAVES + F.wave, NGW = F.G * NWAVES;
    for (int m = gw; m < T; m += NGW) {
        const float* g2 = modv + (size_t)(m / L) * (6 * D) + 5 * D;
#pragma unroll
        for (int j = 0; j < 2; ++j) {
            const int c = 8 * (F.lane + 64 * j);
            f32x4 s0 = {0.f, 0.f, 0.f, 0.f}, s1 = s0;
#pragma unroll
            for (int k = 0; k < TOPK; ++k) { const u32x4 y = *(const u32x4*)(YEXP + ((size_t)m * TOPK + k) * D + c);
                s0.x += bflo(y.x); s0.y += bfhi(y.x); s0.z += bflo(y.y); s0.w += bfhi(y.y); s1.x += bflo(y.z); s1.y += bfhi(y.z); s1.z += bflo(y.w); s1.w += bfhi(y.w); }
            float* o = F.out + (size_t)m * D + c;
            *(f32x4*)o = *(const f32x4*)o + *(const f32x4*)(g2 + c) * s0; *(f32x4*)(o + 4) = *(const f32x4*)(o + 4) + *(const f32x4*)(g2 + c + 4) * s1;
        }
    }
}
#if DBG
constexpr int GBLK = 64;
constexpr int NSLOT_G = NASSIGN + NE * GBLK;
constexpr int NBLK_G = NSLOT_G / GBLK;
__global__ void __launch_bounds__(256) g_mod(const float* __restrict__ c, const float* __restrict__ cctx, const float* __restrict__ Wm,
                                             const float* __restrict__ bm, float* __restrict__ modv) {
    const int col = blockIdx.x * 256 + threadIdx.x, r = blockIdx.y;
    const float* cv = (r < NB) ? c + (size_t)r * D : cctx;
    float acc = 0.f;
    for (int k = 0; k < D; ++k) acc += siluf(cv[k]) * Wm[(size_t)k * (6 * D) + col];
    modv[(size_t)r * (6 * D) + col] = acc + bm[col];
}

__global__ void __launch_bounds__(256) g_norm_mod(const float* __restrict__ x, const float* __restrict__ w, const float* __restrict__ modv,
                                                  int shift_off, int scale_off, int rows_per_b, int fixed_r, float* __restrict__ out) {
    __shared__ float red[4];
    const int row = blockIdx.x, tid = threadIdx.x;
    const float4 v = ((const float4*)(x + (size_t)row * D))[tid];
    float s = v.x * v.x + v.y * v.y + v.z * v.z + v.w * v.w;
    for (int o = 32; o > 0; o >>= 1) s += __shfl_xor(s, o);
    if ((tid & 63) == 0) red[tid >> 6] = s;
    __syncthreads();
    s = red[0] + red[1] + red[2] + red[3];
    const float rinv = rsqrtf(s * (1.f / D) + EPS);
    const int r = fixed_r >= 0 ? fixed_r : row / rows_per_b;
    const float* mv = modv + (size_t)r * (6 * D);
    const float4 ww = ((const float4*)w)[tid], sh = ((const float4*)(mv + shift_off))[tid], sc = ((const float4*)(mv + scale_off))[tid];
    float4 o;
    o.x = v.x * rinv * ww.x * (1.f + sc.x) + sh.x; o.y = v.y * rinv * ww.y * (1.f + sc.y) + sh.y;
    o.z = v.z * rinv * ww.z * (1.f + sc.z) + sh.z; o.w = v.w * rinv * ww.w * (1.f + sc.w) + sh.w;
    ((float4*)(out + (size_t)row * D))[tid] = o;
}

template <int MODE>
__global__ void __launch_bounds__(256) g_sgemm(const float* __restrict__ A, int lda, const float* __restrict__ B, int ldb, size_t bstride,
                                               float* __restrict__ C, int ldc, int K, const int* __restrict__ slot_tok,
                                               const float* __restrict__ slot_w, const int* __restrict__ blk_e, int ntok) {
    __shared__ float As[16][68];
    __shared__ float Bs[16][68];
    const int bm = blockIdx.y * 64, bn = blockIdx.x * 64, tid = threadIdx.x;
    const float* Bp = B;
    if (MODE == 1 || MODE == 2) { const int e = blk_e[blockIdx.y]; if (e < 0) return; Bp += (size_t)e * bstride; }
    const int tx = tid & 15, ty = tid >> 4;
    float acc[4][4];
#pragma unroll
    for (int i = 0; i < 4; ++i)
#pragma unroll
        for (int j = 0; j < 4; ++j) acc[i][j] = 0.f;
    const int arow = tid >> 2, ak = (tid & 3) * 4;
    bool avalid = true; const float* aptr;
    if (MODE == 1) { const int tok = slot_tok[bm + arow]; avalid = tok < ntok; aptr = A + (size_t)(avalid ? tok : 0) * lda; }
    else aptr = A + (size_t)(bm + arow) * lda;
    const int bk = tid >> 4, bnn = (tid & 15) * 4;
    for (int k0 = 0; k0 < K; k0 += 16) {
        float4 av = make_float4(0.f, 0.f, 0.f, 0.f);
        if (avalid) av = *(const float4*)(aptr + k0 + ak);
        const float4 bv = *(const float4*)(Bp + (size_t)(k0 + bk) * ldb + bn + bnn);
        As[ak + 0][arow] = av.x; As[ak + 1][arow] = av.y; As[ak + 2][arow] = av.z; As[ak + 3][arow] = av.w;
        *(float4*)&Bs[bk][bnn] = bv;
        __syncthreads();
#pragma unroll
        for (int kk = 0; kk < 16; ++kk) {
            const float4 a = *(const float4*)&As[kk][ty * 4];
            const float4 b = *(const float4*)&Bs[kk][tx * 4];
            acc[0][0] += a.x * b.x; acc[0][1] += a.x * b.y; acc[0][2] += a.x * b.z; acc[0][3] += a.x * b.w;
            acc[1][0] += a.y * b.x; acc[1][1] += a.y * b.y; acc[1][2] += a.y * b.z; acc[1][3] += a.y * b.w;
            acc[2][0] += a.z * b.x; acc[2][1] += a.z * b.y; acc[2][2] += a.z * b.z; acc[2][3] += a.z * b.w;
            acc[3][0] += a.w * b.x; acc[3][1] += a.w * b.y; acc[3][2] += a.w * b.z; acc[3][3] += a.w * b.w;
        }
        __syncthreads();
    }
#pragma unroll
    for (int i = 0; i < 4; ++i) {
        const int r = bm + ty * 4 + i;
        if (MODE == 2) {
            const int tok = slot_tok[r];
            if (tok < ntok) {
                const float w = slot_w[r];
#pragma unroll
                for (int j = 0; j < 4; ++j) atomicAdd(C + (size_t)tok * ldc + bn + tx * 4 + j, w * acc[i][j]);
            }
        } else if (MODE == 3) {
            float4* cp = (float4*)(C + (size_t)r * ldc + bn + tx * 4); const float4 o = *cp;
            *cp = make_float4(o.x + acc[i][0], o.y + acc[i][1], o.z + acc[i][2], o.w + acc[i][3]);
        } else {
            *(float4*)(C + (size_t)r * ldc + bn + tx * 4) = make_float4(acc[i][0], acc[i][1], acc[i][2], acc[i][3]);
        }
    }
}

__global__ void __launch_bounds__(256) g_qk_prep(const float* __restrict__ Z, const float* __restrict__ ZC, const float* __restrict__ qw,
                                                 const float* __restrict__ kw, float* __restrict__ AQ, float* __restrict__ AK, float* __restrict__ AV) {
    const int gid = blockIdx.x * 256 + threadIdx.x;
    const int NLAT = T * 12;
    const float* src; float* dst; const float* nw = nullptr; bool rope = false; int pos = 0;
    if (gid < NLAT) {
        const int row = gid / 12, it = gid % 12, b = row / L, t = row % L; pos = t;
        if (it < 8) { src = Z + (size_t)row * INC + OFF_AQ + it * 64; dst = AQ + (size_t)row * 512 + it * 64; nw = qw; rope = true; }
        else if (it < 10) { src = Z + (size_t)row * INC + OFF_AK + (it - 8) * 64; dst = AK + ((size_t)b * LK + t) * 128 + (it - 8) * 64; nw = kw; rope = true; }
        else { src = Z + (size_t)row * INC + OFF_AV + (it - 10) * 64; dst = AV + ((size_t)b * LK + t) * 128 + (it - 10) * 64; }
    } else {
        const int g2 = gid - NLAT; if (g2 >= TC * 4) return;
        const int row = g2 / 4, it = g2 % 4, b = row / LC, t = row % LC;
        if (it < 2) { src = ZC + (size_t)row * CTXC + OFF_AK + it * 64; dst = AK + ((size_t)b * LK + L + t) * 128 + it * 64; nw = kw; }
        else { src = ZC + (size_t)row * CTXC + OFF_AV + (it - 2) * 64; dst = AV + ((size_t)b * LK + L + t) * 128 + (it - 2) * 64; }
    }
    if (!nw) { for (int d = 0; d < 64; ++d) dst[d] = src[d]; return; }
    float s = 0.f;
    for (int d = 0; d < 64; ++d) s += src[d] * src[d];
    const float rinv = rsqrtf(s * (1.f / 64.f) + EPS);
    const float fr = (float)(pos / 64), fc = (float)(pos % 64);
    for (int i = 0; i < 32; ++i) {
        float a = src[2 * i] * rinv * nw[2 * i], bb = src[2 * i + 1] * rinv * nw[2 * i + 1];
        if (rope) {
            const float freq = powf(10000.f, -(float)(i & 15) / 16.f);
            const float ang = (i < 16 ? fr : fc) * freq;
            const float cs = cosf(ang), sn = sinf(ang);
            const float oa = a * cs - bb * sn, ob = a * sn + bb * cs; a = oa; bb = ob;
        }
        dst[2 * i] = a; dst[2 * i + 1] = bb;
    }
}

__global__ void __launch_bounds__(256) g_attn(const float* __restrict__ AQ, const float* __restrict__ AK, const float* __restrict__ AV, float* __restrict__ CAT) {
    const int gid = blockIdx.x * 256 + threadIdx.x;
    const int part = gid & 3, qi = gid >> 2;
    const int t = qi % L, hq = (qi / L) % AH, b = qi / (L * AH), kvh = hq / 4;
    const size_t row = (size_t)b * L + t;
    float q[16], acc[16];
#pragma unroll
    for (int d = 0; d < 16; ++d) { q[d] = AQ[row * 512 + hq * 64 + part * 16 + d] * 0.125f; acc[d] = 0.f; }
    float m = -1e30f, l = 0.f;
    const float* kp = AK + (size_t)b * LK * 128 + kvh * 64 + part * 16;
    const float* vp = AV + (size_t)b * LK * 128 + kvh * 64 + part * 16;
    for (int j = 0; j < LK; ++j) {
        float s = 0.f;
#pragma unroll
        for (int d = 0; d < 16; ++d) s += q[d] * kp[(size_t)j * 128 + d];
        s += __shfl_xor(s, 1); s += __shfl_xor(s, 2);
        const float mn = fmaxf(m, s), corr = __expf(m - mn), p = __expf(s - mn);
        l = l * corr + p; m = mn;
#pragma unroll
        for (int d = 0; d < 16; ++d) acc[d] = acc[d] * corr + p * vp[(size_t)j * 128 + d];
    }
    const float il = 1.f / l;
#pragma unroll
    for (int d = 0; d < 16; ++d) CAT[row * D + hq * 64 + part * 16 + d] = acc[d] * il;
}

__global__ void __launch_bounds__(256) g_ret(const float* __restrict__ Z, const float* __restrict__ ZC, const float* __restrict__ dfw,
                                             const float* __restrict__ dbw, float* __restrict__ CAT) {
    const int gid = blockIdx.x * 256 + threadIdx.x;
    const int part = gid & 3, qi = gid >> 2;
    const int t = qi % L, h = (qi / L) % RH, b = qi / (L * RH);
    const size_t row = (size_t)b * L + t;
    const float l2f = -log1pf(__expf(-dfw[h])) * 1.4426950408889634f, l2b = -log1pf(__expf(-dbw[h])) * 1.4426950408889634f;
    float q[16], acc[16];
#pragma unroll
    for (int d = 0; d < 16; ++d) { q[d] = Z[row * INC + OFF_RQ + h * 64 + part * 16 + d] * 0.125f; acc[d] = 0.f; }
    const float* kp = Z + (size_t)b * L * INC + OFF_RK + h * 64 + part * 16;
    const float* vp = Z + (size_t)b * L * INC + OFF_RV + h * 64 + part * 16;
    for (int j = 0; j < L; ++j) {
        float s = 0.f;
#pragma unroll
        for (int d = 0; d < 16; ++d) s += q[d] * kp[(size_t)j * INC + d];
        s += __shfl_xor(s, 1); s += __shfl_xor(s, 2);
        const int df = t - j;
        float w = 0.f;
        if (df >= 0) w += exp2f((float)df * l2f);
        if (df <= 0) w += exp2f((float)(-df) * l2b);
        const float p = s * w;
#pragma unroll
        for (int d = 0; d < 16; ++d) acc[d] += p * vp[(size_t)j * INC + d];
    }
    const float* kc = ZC + (size_t)b * LC * CTXC + OFF_RK + h * 64 + part * 16;
    const float* vc = ZC + (size_t)b * LC * CTXC + OFF_RV + h * 64 + part * 16;
    for (int j = 0; j < LC; ++j) {
        float s = 0.f;
#pragma unroll
        for (int d = 0; d < 16; ++d) s += q[d] * kc[(size_t)j * CTXC + d];
        s += __shfl_xor(s, 1); s += __shfl_xor(s, 2);
        const float w = exp2f((float)(t + LC - j) * l2f) + exp2f((float)(L - t + j) * l2b);
        const float p = s * w;
#pragma unroll
        for (int d = 0; d < 16; ++d) acc[d] += p * vc[(size_t)j * CTXC + d];
    }
    float ss = 0.f;
#pragma unroll
    for (int d = 0; d < 16; ++d) ss += acc[d] * acc[d];
    ss += __shfl_xor(ss, 1); ss += __shfl_xor(ss, 2);
    const float rinv = rsqrtf(ss * (1.f / 64.f) + EPS);
#pragma unroll
    for (int d = 0; d < 16; ++d) {
        const float g = Z[row * INC + OFF_RG + h * 64 + part * 16 + d];
        CAT[row * D + 512 + h * 64 + part * 16 + d] = acc[d] * rinv * siluf(g);
    }
}

__global__ void __launch_bounds__(256) g_resid(const float* __restrict__ x, const float* __restrict__ y, const float* __restrict__ y2,
                                               const float* __restrict__ modv, int goff, float* __restrict__ out) {
    const size_t i = (size_t)blockIdx.x * 256 + threadIdx.x;
    const size_t e = i * 4; const int col = (int)(e % D), b = (int)(e / ((size_t)L * D));
    const float4 xv = ((const float4*)x)[i]; float4 yv = ((const float4*)y)[i];
    if (y2) { const float4 z = ((const float4*)y2)[i]; yv.x += z.x; yv.y += z.y; yv.z += z.z; yv.w += z.w; }
    const float4 g = *(const float4*)(modv + (size_t)b * (6 * D) + goff + col);
    ((float4*)out)[i] = make_float4(xv.x + g.x * yv.x, xv.y + g.y * yv.y, xv.z + g.z * yv.z, xv.w + g.w * yv.w);
}

__global__ void __launch_bounds__(256) g_route(const float* __restrict__ logits, const float* __restrict__ rbias, int* __restrict__ idx, float* __restrict__ wout) {
    const int tok = blockIdx.x * 4 + (threadIdx.x >> 6), lane = threadIdx.x & 63;
    const float4 lg = ((const float4*)(logits + (size_t)tok * NE))[lane];
    const float4 bi = ((const float4*)rbias)[lane];
    float s0 = sigmoidf_(lg.x), s1 = sigmoidf_(lg.y), s2 = sigmoidf_(lg.z), s3 = sigmoidf_(lg.w);
    float v0 = s0 + bi.x, v1 = s1 + bi.y, v2 = s2 + bi.z, v3 = s3 + bi.w;
    float gs = 0.f;
    {
        float a0 = v0, a1 = v1, a2 = v2, a3 = v3;
        for (int r = 0; r < 2; ++r) {
            float mv = a0; int mi = lane * 4;
            if (a1 > mv) { mv = a1; mi = lane * 4 + 1; }
            if (a2 > mv) { mv = a2; mi = lane * 4 + 2; }
            if (a3 > mv) { mv = a3; mi = lane * 4 + 3; }
            for (int o = 1; o < 8; o <<= 1) {
                const float ov = __shfl_xor(mv, o); const int oi = __shfl_xor(mi, o);
                if (ov > mv || (ov == mv && oi < mi)) { mv = ov; mi = oi; }
            }
            gs += mv;
            if (mi == lane * 4) a0 = -INFINITY; if (mi == lane * 4 + 1) a1 = -INFINITY;
            if (mi == lane * 4 + 2) a2 = -INFINITY; if (mi == lane * 4 + 3) a3 = -INFINITY;
        }
    }
    const int g = lane >> 3; int rank = 0;
    for (int g2 = 0; g2 < 8; ++g2) { const float o = __shfl(gs, g2 * 8); if (o > gs || (o == gs && g2 < g)) ++rank; }
    if (rank >= 4) { v0 = v1 = v2 = v3 = -INFINITY; }
    float wsum = 0.f, myw = 0.f; int myi = 0;
    for (int r = 0; r < TOPK; ++r) {
        float mv = v0; int mi = lane * 4;
        if (v1 > mv) { mv = v1; mi = lane * 4 + 1; }
        if (v2 > mv) { mv = v2; mi = lane * 4 + 2; }
        if (v3 > mv) { mv = v3; mi = lane * 4 + 3; }
        for (int o = 1; o < 64; o <<= 1) {
            const float ov = __shfl_xor(mv, o); const int oi = __shfl_xor(mi, o);
            if (ov > mv || (ov == mv && oi < mi)) { mv = ov; mi = oi; }
        }
        const int own = mi >> 2, sub = mi & 3;
        float sv = sub == 0 ? s0 : sub == 1 ? s1 : sub == 2 ? s2 : s3;
        sv = __shfl(sv, own);
        wsum += sv;
        if (lane == r) { myw = sv; myi = mi; }
        if (lane == own) { if (sub == 0) v0 = -INFINITY; if (sub == 1) v1 = -INFINITY; if (sub == 2) v2 = -INFINITY; if (sub == 3) v3 = -INFINITY; }
    }
    if (lane < TOPK) { idx[(size_t)tok * TOPK + lane] = myi; wout[(size_t)tok * TOPK + lane] = myw / wsum * 2.5f; }
}

__global__ void __launch_bounds__(256) g_count(const int* __restrict__ idx, int* __restrict__ cnt) {
    const int i = blockIdx.x * 256 + threadIdx.x; atomicAdd(&cnt[idx[i]], 1);
}
__global__ void __launch_bounds__(256) g_offsets(const int* __restrict__ cnt, int* __restrict__ pstart, int* __restrict__ blk_e) {
    __shared__ int ps[NE + 1];
    if (threadIdx.x == 0) { int a = 0; for (int e = 0; e < NE; ++e) { ps[e] = a; a += (cnt[e] + GBLK - 1) / GBLK * GBLK; } ps[NE] = a; }
    __syncthreads();
    pstart[threadIdx.x] = ps[threadIdx.x];
    for (int bI = threadIdx.x; bI < NBLK_G; bI += 256) blk_e[bI] = -1;
    __syncthreads();
    const int e = threadIdx.x;
    for (int s = ps[e]; s < ps[e + 1]; s += GBLK) blk_e[s / GBLK] = e;
}
__global__ void __launch_bounds__(256) g_slot_init(int* __restrict__ slot_tok, float* __restrict__ slot_w) {
    const int i = blockIdx.x * 256 + threadIdx.x; if (i < NSLOT_G) { slot_tok[i] = T; slot_w[i] = 0.f; }
}
__global__ void __launch_bounds__(256) g_fill(const int* __restrict__ idx, const float* __restrict__ w, const int* __restrict__ pstart,
                                              int* __restrict__ fillc, int* __restrict__ slot_tok, float* __restrict__ slot_w) {
    const int i = blockIdx.x * 256 + threadIdx.x; const int e = idx[i];
    const int pos = atomicAdd(&fillc[e], 1); const int s = pstart[e] + pos;
    slot_tok[s] = i / TOPK; slot_w[s] = w[i];
}
__global__ void __launch_bounds__(256) g_act(const float* __restrict__ G, const float* __restrict__ U, float* __restrict__ A, size_t n4) {
    const size_t i = (size_t)blockIdx.x * 256 + threadIdx.x; if (i >= n4) return;
    const float4 g = ((const float4*)G)[i], u = ((const float4*)U)[i];
    ((float4*)A)[i] = make_float4(siluf(g.x) * u.x, siluf(g.y) * u.y, siluf(g.z) * u.z, siluf(g.w) * u.w);
}

#endif
constexpr int N_PHASES = 11;
__global__ void __launch_bounds__(NTHR, 2) mega_fwd(Params p) {
    extern __shared__ __attribute__((aligned(16))) unsigned char lds_raw[];
    Ctx F;
    F.lds = (LAS unsigned char*)lds_raw;
    F.ws = p.ws; F.out = p.out;
#pragma unroll
    for (int i = 0; i < 22; ++i) F.in[i] = p.in[i];
    F.tid = threadIdx.x; F.lane = F.tid & 63; F.wave = __builtin_amdgcn_readfirstlane(F.tid >> 6);
    F.G = gridDim.x; F.bx = blockIdx.x; F.vcu = (F.G % 8 == 0) ? (F.bx % 8) * (F.G / 8) + F.bx / 8 : F.bx;
    for (int u = F.tid; u < (LDS_BYTES - LDSCTL_OFF) / 4; u += NTHR) ((LAS unsigned*)(F.lds + LDSCTL_OFF))[u] = 0u;
    __syncthreads();
    volatile LAS unsigned* MISC = (volatile LAS unsigned*)(F.lds + MISC_OFF);
    XcdBarrier bar = xcd_barrier_post((unsigned*)(F.ws + WS_CTL) + CW_BAR + p.li * XCD_BAR_WORDS, MISC + 8);
    const int lo = p.ph_lo, hi = p.ph_hi;
#ifndef PH_MASK
#define PH_MASK 0xFFFF
#endif
#define IN(k) (((PH_MASK >> (k)) & 1) && lo <= (k) && (k) < hi)
#ifndef REP_MASK
#define REP_MASK 0
#endif
#define REP(k) ((REP_MASK >> (k)) & 1)
#define SEAM(k) do { if (IN(k) && IN((k) + 1)) xcd_barrier(bar); } while (0)
    if (IN(0)) { phase_p0(F); }   SEAM(0);
    if (IN(1)) { phase_p0b(F); }  SEAM(1);
    if (IN(2)) { phase_p1(F); }   SEAM(2);
    if (IN(3)) { phase_r1(F); }   SEAM(3);
    if (IN(4)) { phase_mix(F); }  SEAM(4);
    if (IN(5)) { phase_p4(F); }   SEAM(5);
    if (IN(6)) { phase_p5(F); }   SEAM(6);
    if (IN(7)) { phase_p6(F); }   SEAM(7);
    if (IN(8)) { phase_p7(F); }   SEAM(8);
    if (IN(9)) { phase_moe(F); }  SEAM(9);
    if (IN(10)) { phase_final(F); }
#undef IN
#undef SEAM
}

#if DBG
struct CmpArgs { const void* mptr; const void* mptr2; int mbf16; int rpb; int bstride; int roff; int mpitch; int mcoff; const float* gptr; int gpitch; int gcoff; float gscale; int gsilu; int rows; int cols; };
__global__ void __launch_bounds__(256) dbg_compare(CmpArgs a, double* accum) {
    const size_t n = (size_t)a.rows * a.cols; double d2 = 0.0, r2 = 0.0;
    for (size_t i = (size_t)blockIdx.x * 256 + threadIdx.x; i < n; i += (size_t)gridDim.x * 256) {
        const int r = (int)(i / a.cols), c = (int)(i % a.cols);
        const size_t mi = ((size_t)(r / a.rpb) * a.bstride + (r % a.rpb) + a.roff) * a.mpitch + a.mcoff + c;
        float mv = a.mbf16 ? bf2f(((const bf16_t*)a.mptr)[mi]) : ((const float*)a.mptr)[mi];
        if (a.mptr2) mv += a.mbf16 ? bf2f(((const bf16_t*)a.mptr2)[mi]) : ((const float*)a.mptr2)[mi];
        float gv = a.gptr[(size_t)r * a.gpitch + a.gcoff + c] * a.gscale; if (a.gsilu) gv = siluf(gv);
        const double d = (double)mv - (double)gv; d2 += d * d; r2 += (double)gv * gv;
    }
    for (int o = 32; o > 0; o >>= 1) { d2 += __shfl_xor(d2, o); r2 += __shfl_xor(r2, o); }
    if ((threadIdx.x & 63) == 0) { atomicAdd(accum, d2); atomicAdd(accum + 1, r2); }
}
__global__ void __launch_bounds__(256) dbg_encode(float* out, const double* accum, size_t n4) {
    const double d2 = accum[0], r2 = accum[1];
    float f = 0.f;
    if (r2 > 0.0 && d2 == d2 && d2 < 1e300) { double e = sqrt(d2 / r2); if (e > 1.0) e = 1.0; f = 1.f + (float)sqrt(e); }
    for (size_t i = (size_t)blockIdx.x * 256 + threadIdx.x; i < n4; i += (size_t)gridDim.x * 256) { float4 v = ((float4*)out)[i]; v.x *= f; v.y *= f; v.z *= f; v.w *= f; ((float4*)out)[i] = v; }
}
struct WsG {
    float *modv, *H, *Z, *ZC, *AQ, *AK, *AV, *CAT, *Y, *X1, *H2, *LOG, *rw, *G, *U, *ACT, *MOE, *SG, *SU, *SA, *SD, *slot_w;
    int *ridx, *cnt, *fillc, *pstart, *blk_e, *slot_tok; double* accum;
};
static WsG carve_g(void* d_ws, size_t ws_size, size_t start) {
    char* p = (char*)d_ws + start; WsG w;
    auto take = [&](size_t bytes) { char* r = p; p += (bytes + 255) / 256 * 256; return r; };
    w.accum = (double*)take(256);
    w.cnt = (int*)take(NE * 4); w.fillc = (int*)take(NE * 4); w.pstart = (int*)take((NE + 1) * 4); w.blk_e = (int*)take(NBLK_G * 4);
    w.modv = (float*)take((size_t)9 * 6 * D * 4);
    w.H = (float*)take((size_t)(T + TC) * D * 4);
    w.Z = (float*)take((size_t)T * INC * 4); w.ZC = (float*)take((size_t)TC * CTXC * 4);
    w.AQ = (float*)take((size_t)T * 512 * 4); w.AK = (float*)take((size_t)NB * LK * 128 * 4); w.AV = (float*)take((size_t)NB * LK * 128 * 4);
    w.CAT = (float*)take((size_t)T * D * 4);
    w.Y = (float*)take((size_t)T * D * 4); w.X1 = (float*)take((size_t)T * D * 4);
    w.LOG = (float*)take((size_t)T * NE * 4); w.rw = (float*)take((size_t)NASSIGN * 4); w.ridx = (int*)take((size_t)NASSIGN * 4);
    w.slot_tok = (int*)take((size_t)NSLOT_G * 4); w.slot_w = (float*)take((size_t)NSLOT_G * 4);
    w.SD = nullptr; w.SG = (float*)take((size_t)T * FF * 4); w.SU = (float*)take((size_t)T * FF * 4); w.SA = w.SG;
    w.H2 = w.H; w.MOE = w.Y;
    w.G = w.Z; w.U = w.Z + (size_t)NSLOT_G * FF; w.ACT = w.G;
    if ((size_t)(p - (char*)d_ws) > ws_size || (char*)(w.U + (size_t)NSLOT_G * FF) > (char*)w.Y) { fprintf(stderr, "kernel_launch(DBG): workspace too small: need %zu have %zu\n", (size_t)(p - (char*)d_ws), ws_size); w.accum = nullptr; }
    return w;
}
static void run_golden(void* const* d_in, float* out, const WsG& w, hipStream_t stream) {
    const float* x = (const float*)d_in[0]; const float* c = (const float*)d_in[1]; const float* ctx = (const float*)d_in[2]; const float* cctx = (const float*)d_in[3];
    const float* w_mod = (const float*)d_in[4]; const float* b_mod = (const float*)d_in[5]; const float* n1w = (const float*)d_in[6]; const float* n2w = (const float*)d_in[7];
    const float* w_in = (const float*)d_in[8]; const float* qnw = (const float*)d_in[9]; const float* knw = (const float*)d_in[10];
    const float* dfw = (const float*)d_in[11]; const float* dbw = (const float*)d_in[12]; const float* w_out = (const float*)d_in[13];
    const float* rw = (const float*)d_in[14]; const float* rb = (const float*)d_in[15];
    const float* ewg = (const float*)d_in[16]; const float* ewu = (const float*)d_in[17]; const float* ewd = (const float*)d_in[18];
    const float* swg = (const float*)d_in[19]; const float* swu = (const float*)d_in[20]; const float* swd = (const float*)d_in[21];
    (void)hipMemsetAsync(w.cnt, 0, NE * 4, stream); (void)hipMemsetAsync(w.fillc, 0, NE * 4, stream);
    g_mod<<<dim3(6 * D / 256, 9), 256, 0, stream>>>(c, cctx, w_mod, b_mod, w.modv);
    g_norm_mod<<<T, 256, 0, stream>>>(x, n1w, w.modv, 0, D, L, -1, w.H);
    g_norm_mod<<<TC, 256, 0, stream>>>(ctx, n1w, w.modv, 0, D, LC, 8, w.H + (size_t)T * D);
    g_sgemm<0><<<dim3(INC / 64, T / 64), 256, 0, stream>>>(w.H, D, w_in, INC, 0, w.Z, INC, D, nullptr, nullptr, nullptr, 0);
    g_sgemm<0><<<dim3(CTXC / 64, TC / 64), 256, 0, stream>>>(w.H + (size_t)T * D, D, w_in, INC, 0, w.ZC, CTXC, D, nullptr, nullptr, nullptr, 0);
    g_qk_prep<<<(T * 12 + TC * 4 + 255) / 256, 256, 0, stream>>>(w.Z, w.ZC, qnw, knw, w.AQ, w.AK, w.AV);
    g_attn<<<NB * AH * L * 4 / 256, 256, 0, stream>>>(w.AQ, w.AK, w.AV, w.CAT);
    g_ret<<<NB * RH * L * 4 / 256, 256, 0, stream>>>(w.Z, w.ZC, dfw, dbw, w.CAT);
    g_sgemm<0><<<dim3(D / 64, T / 64), 256, 0, stream>>>(w.CAT, D, w_out, D, 0, w.Y, D, D, nullptr, nullptr, nullptr, 0);
    g_resid<<<T * D / 4 / 256, 256, 0, stream>>>(x, w.Y, nullptr, w.modv, 2 * D, w.X1);
}
static void run_golden_tail(void* const* d_in, float* out, const WsG& w, hipStream_t stream) {
    const float* n2w = (const float*)d_in[7]; const float* rw = (const float*)d_in[14]; const float* rb = (const float*)d_in[15];
    const float* ewg = (const float*)d_in[16]; const float* ewu = (const float*)d_in[17]; const float* ewd = (const float*)d_in[18];
    const float* swg = (const float*)d_in[19]; const float* swu = (const float*)d_in[20]; const float* swd = (const float*)d_in[21];
    g_norm_mod<<<T, 256, 0, stream>>>(w.X1, n2w, w.modv, 3 * D, 4 * D, L, -1, w.H2);
    g_sgemm<0><<<dim3(NE / 64, T / 64), 256, 0, stream>>>(w.H2, D, rw, NE, 0, w.LOG, NE, D, nullptr, nullptr, nullptr, 0);
    g_route<<<T / 4, 256, 0, stream>>>(w.LOG, rb, w.ridx, w.rw);
    g_count<<<NASSIGN / 256, 256, 0, stream>>>(w.ridx, w.cnt);
    g_offsets<<<1, 256, 0, stream>>>(w.cnt, w.pstart, w.blk_e);
    g_slot_init<<<(NSLOT_G + 255) / 256, 256, 0, stream>>>(w.slot_tok, w.slot_w);
    g_fill<<<NASSIGN / 256, 256, 0, stream>>>(w.ridx, w.rw, w.pstart, w.fillc, w.slot_tok, w.slot_w);
}
static void run_golden_tail2(void* const* d_in, float* out, const WsG& w, hipStream_t stream) {
    const float* ewg = (const float*)d_in[16]; const float* ewu = (const float*)d_in[17]; const float* ewd = (const float*)d_in[18];
    const float* swg = (const float*)d_in[19]; const float* swu = (const float*)d_in[20]; const float* swd = (const float*)d_in[21];
    g_sgemm<1><<<dim3(FF / 64, NBLK_G), 256, 0, stream>>>(w.H2, D, ewg, FF, (size_t)D * FF, w.G, FF, D, w.slot_tok, w.slot_w, w.blk_e, T);
    g_sgemm<1><<<dim3(FF / 64, NBLK_G), 256, 0, stream>>>(w.H2, D, ewu, FF, (size_t)D * FF, w.U, FF, D, w.slot_tok, w.slot_w, w.blk_e, T);
    g_act<<<(unsigned)(((size_t)NSLOT_G * FF / 4 + 255) / 256), 256, 0, stream>>>(w.G, w.U, w.ACT, (size_t)NSLOT_G * FF / 4);
    (void)hipMemsetAsync(w.MOE, 0, (size_t)T * D * 4, stream);
    g_sgemm<2><<<dim3(D / 64, NBLK_G), 256, 0, stream>>>(w.ACT, FF, ewd, D, (size_t)FF * D, w.MOE, D, FF, w.slot_tok, w.slot_w, w.blk_e, T);
    g_sgemm<0><<<dim3(FF / 64, T / 64), 256, 0, stream>>>(w.H2, D, swg, FF, 0, w.SG, FF, D, nullptr, nullptr, nullptr, 0);
    g_sgemm<0><<<dim3(FF / 64, T / 64), 256, 0, stream>>>(w.H2, D, swu, FF, 0, w.SU, FF, D, nullptr, nullptr, nullptr, 0);
    g_act<<<(unsigned)(((size_t)T * FF / 4 + 255) / 256), 256, 0, stream>>>(w.SG, w.SU, w.SA, (size_t)T * FF / 4);
    g_sgemm<3><<<dim3(D / 64, T / 64), 256, 0, stream>>>(w.SA, FF, swd, D, 0, w.MOE, D, FF, nullptr, nullptr, nullptr, 0);
    g_resid<<<T * D / 4 / 256, 256, 0, stream>>>(w.X1, w.MOE, nullptr, w.modv, 5 * D, out);
}
#endif

extern "C" void kernel_launch(void* const* d_in, const int* in_sizes, int n_in, void* d_out, int out_size, void* d_ws, size_t ws_size, hipStream_t stream) {
    static int grid = 0;
    if (grid == 0) {
        int dev = 0, cus = 0, per_cu = 0;
        if (hipGetDevice(&dev) != hipSuccess || hipDeviceGetAttribute(&cus, hipDeviceAttributeMultiprocessorCount, dev) != hipSuccess) { fprintf(stderr, "kernel_launch: device query failed\n"); grid = -1; return; }
        if (hipFuncSetAttribute((const void*)mega_fwd, hipFuncAttributeMaxDynamicSharedMemorySize, LDS_BYTES) != hipSuccess) { fprintf(stderr, "kernel_launch: hipFuncSetAttribute failed\n"); grid = -1; return; }
        if (hipOccupancyMaxActiveBlocksPerMultiprocessor(&per_cu, (const void*)mega_fwd, NTHR, LDS_BYTES) != hipSuccess || per_cu < 1) { fprintf(stderr, "kernel_launch: occupancy query says %d blocks/CU\n", per_cu); per_cu = 1; }
        (void)hipGetLastError();
        grid = cus;
        if (grid != 256) fprintf(stderr, "kernel_launch: built for 256 CUs, device has %d\n", cus);
        if (ws_size < WS_END_B) { fprintf(stderr, "kernel_launch: workspace too small\n"); grid = -1; return; }
    }
    if (grid < 0) return;
    (void)hipMemsetAsync((char*)d_ws + WS_CTL, 0, CTL_ZERO_BYTES, stream);
    Params p{};
    for (int i = 0; i < 22; ++i) p.in[i] = (const float*)d_in[i];
    p.out = (float*)d_out; p.ws = (unsigned char*)d_ws;
#if DBG
    WsG w = carve_g(d_ws, ws_size, WS_END_A);
    if (!w.accum) { (void)hipMemsetAsync(d_out, 0, (size_t)T * D * 4, stream); return; }
    run_golden(d_in, (float*)d_out, w, stream);
    p.ph_lo = 0; p.ph_hi = DBG_PH_HI;
    { void* args[] = {&p}; hipError_t e = hipLaunchCooperativeKernel((const void*)mega_fwd, dim3(grid), dim3(NTHR), args, LDS_BYTES, stream);
      if (e != hipSuccess) fprintf(stderr, "cooperative launch failed: %s\n", hipGetErrorString(e)); }
    (void)hipMemsetAsync(w.accum, 0, 16, stream);
    unsigned char* ws = (unsigned char*)d_ws;
    auto cmp = [&](const void* mp, const void* mp2, int mbf16, int rpb, int bstride, int roff, int mpitch, int mcoff, const float* gp, int gpitch, int gcoff, float gscale, int gsilu, int rows, int cols) {
        CmpArgs a{mp, mp2, mbf16, rpb, bstride, roff, mpitch, mcoff, gp, gpitch, gcoff, gscale, gsilu, rows, cols};
        dbg_compare<<<1024, 256, 0, stream>>>(a, w.accum); };
#if DBG == 1
    cmp(ws + WS_HB, nullptr, 1, TALL, 0, 0, D, 0, w.H, D, 0, 1.f, 0, TALL, D);
#elif DBG == 2
    cmp(ws + WS_QB, nullptr, 1, T, 0, 0, 512, 0, w.AQ, 512, 0, C2, 0, T, 512);
#elif DBG == 3
    cmp(ws + WS_KB, nullptr, 1, NB * LK, 0, 0, 128, 0, w.AK, 128, 0, 1.f, 0, NB * LK, 128);
    cmp(ws + WS_VB, nullptr, 1, NB * LK, 0, 0, 128, 0, w.AV, 128, 0, 1.f, 0, NB * LK, 128);
#elif DBG == 4
    cmp(ws + WS_RKB, nullptr, 1, L, LK, 0, 512, 0, w.Z, INC, OFF_RK, 0.125f, 0, T, 512);
    cmp(ws + WS_RKB, nullptr, 1, LC, LK, L, 512, 0, w.ZC, CTXC, OFF_RK, 0.125f, 0, TC, 512);
    cmp(ws + WS_RVB, nullptr, 1, L, LK, 0, 512, 0, w.Z, INC, OFF_RV, 1.f, 0, T, 512);
    cmp(ws + WS_RVB, nullptr, 1, LC, LK, L, 512, 0, w.ZC, CTXC, OFF_RV, 1.f, 0, TC, 512);
#elif DBG == 5
    cmp(ws + WS_RQB, nullptr, 1, T, 0, 0, 512, 0, w.Z, INC, OFF_RQ, 1.f, 0, T, 512);
    cmp(ws + WS_RGB, nullptr, 1, T, 0, 0, 512, 0, w.Z, INC, OFF_RG, 1.f, 1, T, 512);
#elif DBG == 9
    cmp(ws + WS_CAT, nullptr, 1, T, 0, 0, D, 0, w.CAT, D, 0, 1.f, 0, T, 512);
#elif DBG == 10
    cmp(ws + WS_CAT, nullptr, 1, T, 0, 0, D, 512, w.CAT, D, 512, 1.f, 0, T, 512);
#elif DBG == 11
    cmp(ws + WS_X1, nullptr, 0, T, 0, 0, D, 0, w.X1, D, 0, 1.f, 0, T, D);
#elif DBG == 6
    cmp(ws + WS_QB, nullptr, 1, T, 0, 0, 512, 0, w.AQ, 512, 0, C2, 0, T, 512);
    cmp(ws + WS_KB, nullptr, 1, NB * LK, 0, 0, 128, 0, w.AK, 128, 0, 1.f, 0, NB * LK, 128);
    cmp(ws + WS_VB, nullptr, 1, NB * LK, 0, 0, 128, 0, w.AV, 128, 0, 1.f, 0, NB * LK, 128);
    cmp(ws + WS_RKB, nullptr, 1, L, LK, 0, 512, 0, w.Z, INC, OFF_RK, 0.125f, 0, T, 512);
    cmp(ws + WS_RKB, nullptr, 1, LC, LK, L, 512, 0, w.ZC, CTXC, OFF_RK, 0.125f, 0, TC, 512);
    cmp(ws + WS_RVB, nullptr, 1, L, LK, 0, 512, 0, w.Z, INC, OFF_RV, 1.f, 0, T, 512);
    cmp(ws + WS_RVB, nullptr, 1, LC, LK, L, 512, 0, w.ZC, CTXC, OFF_RV, 1.f, 0, TC, 512);
    cmp(ws + WS_RQB, nullptr, 1, T, 0, 0, 512, 0, w.Z, INC, OFF_RQ, 1.f, 0, T, 512);
    cmp(ws + WS_RGB, nullptr, 1, T, 0, 0, 512, 0, w.Z, INC, OFF_RG, 1.f, 1, T, 512);
#endif
    run_golden_tail(d_in, (float*)d_out, w, stream);
#if DBG == 12
    cmp(ws + WS_H2B, ws + WS_H2B + (size_t)T * D * 2, 1, T, 0, 0, D, 0, w.H2, D, 0, 1.f, 0, T, D);
#elif DBG == 13
    cmp(ws + WS_RWT, nullptr, 0, T, 0, 0, TOPK, 0, w.rw, TOPK, 0, 1.f, 0, T, TOPK);
#endif
    run_golden_tail2(d_in, (float*)d_out, w, stream);
    dbg_encode<<<1024, 256, 0, stream>>>((float*)d_out, w.accum, (size_t)T * D / 4);
#else
    p.ph_lo = 0; p.ph_hi = N_PHASES;
    void* args[] = {&p};
    hipError_t e = hipLaunchCooperativeKernel((const void*)mega_fwd, dim3(grid), dim3(NTHR), args, LDS_BYTES, stream);
    if (e != hipSuccess) fprintf(stderr, "cooperative launch failed: %s (grid %d)\n", hipGetErrorString(e), grid);
#if defined(PROBE_LO)
    for (int r = 0; r < PROBE_N; ++r) { p.ph_lo = PROBE_LO; p.ph_hi = PROBE_HI; p.li = 1 + r;
        (void)hipLaunchCooperativeKernel((const void*)mega_fwd, dim3(grid), dim3(NTHR), args, LDS_BYTES, stream); }
#endif
#endif
}
```

```cpp
#define DBG 0
#define DBG_PH_HI 11
#include <hip/hip_runtime.h>
#include <hip/hip_bf16.h>
#include <cstdio>
#include <cstdint>
#include <cmath>

#ifndef DBG
#define DBG 0
#endif

constexpr int D = 1024, NB = 8, L = 2048, LC = 256, T = NB * L, TC = NB * LC, TALL = T + TC;
constexpr int HD = 64, AH = 8, KVH = 2, RH = 8;
constexpr int OFF_AK = 0, OFF_AV = 128, OFF_RK = 256, OFF_RV = 768, CTXC = 1280, OFF_AQ = 1280, OFF_RQ = 1792, OFF_RG = 2304, INC = 2816;
constexpr int NE = 256, TOPK = 8, FF = 256;
constexpr int LK = L + LC;
constexpr int NCH = LK / 128;
constexpr int NASSIGN = T * TOPK;
constexpr int CAP = 16384;
constexpr float EPS = 1e-6f;
constexpr float C2 = 0.125f * 1.4426950408889634f;

typedef unsigned short bf16_t;
typedef float f32x4 __attribute__((ext_vector_type(4)));
typedef unsigned u32x4 __attribute__((ext_vector_type(4)));
typedef unsigned u32x2 __attribute__((ext_vector_type(2)));
typedef short bf16x8 __attribute__((ext_vector_type(8)));

__device__ __forceinline__ float siluf(float v) { return v / (1.f + __expf(-v)); }
__device__ __forceinline__ float sigmoidf_(float v) { return 1.f / (1.f + __expf(-v)); }
__device__ __forceinline__ unsigned f2bf(float f) { unsigned u = __builtin_bit_cast(unsigned, f); return (u + 0x7fffu + ((u >> 16) & 1u)) >> 16; }
__device__ __forceinline__ unsigned pk2(float lo, float hi) { return f2bf(lo) | (f2bf(hi) << 16); }
__device__ __forceinline__ float bf2f(unsigned short h) { return __builtin_bit_cast(float, (unsigned)h << 16); }
__device__ __forceinline__ float bflo(unsigned w) { return __builtin_bit_cast(float, w << 16); }
__device__ __forceinline__ float bfhi(unsigned w) { return __builtin_bit_cast(float, w & 0xffff0000u); }

constexpr size_t MiB = 1u << 20;
constexpr size_t al256(size_t x) { return (x + 255) / 256 * 256; }
constexpr size_t WS_CTL = 0, CTL_ZERO_BYTES = 1 * MiB;
constexpr size_t WS_MODV = WS_CTL + CTL_ZERO_BYTES;
constexpr size_t WS_ROPE = WS_MODV + al256((size_t)9 * 6 * D * 4);
constexpr size_t WS_WIN = WS_ROPE + al256((size_t)(32 + 64) * 16 * 8);
constexpr size_t WS_WOUT = WS_WIN + al256((size_t)INC * D * 2);
constexpr size_t WS_WR = WS_WOUT + al256((size_t)D * D * 2);
constexpr size_t WS_WSGU = WS_WR + al256((size_t)512 * D * 2);
constexpr size_t WS_WSD = WS_WSGU + al256((size_t)512 * D * 2);
constexpr size_t WS_HB = WS_WSD + al256((size_t)D * FF * 2);
constexpr size_t WS_QB = WS_HB + al256((size_t)TALL * D * 2);
constexpr size_t WS_KB = WS_QB + al256((size_t)T * 512 * 2);
constexpr size_t WS_VB = WS_KB + al256((size_t)NB * LK * 128 * 2);
constexpr size_t WS_RKB = WS_VB + al256((size_t)NB * LK * 128 * 2);
constexpr size_t WS_RVB = WS_RKB + al256((size_t)NB * LK * 512 * 2);
constexpr size_t WS_RQB = WS_RVB + al256((size_t)NB * LK * 512 * 2);
constexpr size_t WS_RGB = WS_RQB + al256((size_t)T * 512 * 2);
constexpr size_t WS_CST = WS_RGB + al256((size_t)T * 512 * 2);
constexpr size_t WS_CAT = WS_CST + al256((size_t)NB * RH * NCH * 2 * 4096 * 4);
constexpr size_t WS_X1 = WS_CAT + al256((size_t)T * D * 2);
constexpr size_t WS_H2B = WS_X1 + al256((size_t)T * D * 4);
constexpr size_t WS_LOGP = WS_H2B + al256((size_t)2 * T * D * 2);
constexpr size_t WS_ACTS = WS_LOGP + al256((size_t)3 * T * NE * 4);
constexpr size_t WS_RIDX = WS_ACTS + al256((size_t)T * FF * 2);
constexpr size_t WS_RWT = WS_RIDX + al256((size_t)NASSIGN * 4);
constexpr size_t WS_SDST = WS_RWT + al256((size_t)NASSIGN * 4);
constexpr size_t WS_SW = WS_SDST + al256((size_t)NE * 16384 * 4);
constexpr size_t WS_END_A = WS_SW + al256((size_t)NE * 16384 * 4);
constexpr size_t WS_ACT = WS_END_A;
constexpr size_t WS_YEXP = WS_ACT + al256((size_t)NASSIGN * FF * 2);
constexpr size_t WS_END_B = WS_YEXP + al256((size_t)NASSIGN * D * 2);
constexpr int CW_BAR = 4096;
constexpr int CW_ECNT = 16384;

#define GAS __attribute__((address_space(1)))
#define LAS __attribute__((address_space(3)))
#define LDS_WAIT() asm volatile("s_waitcnt lgkmcnt(0)" ::: "memory")
#define VM_WAIT() asm volatile("s_waitcnt vmcnt(0)" ::: "memory")
constexpr int NWAVES = 8, NTHR = NWAVES * 64;
constexpr int RING_BYTES = 131072, LDSCTL_OFF = 147456, MISC_OFF = LDSCTL_OFF + 320, LDS_BYTES = 163840;

struct Params {
    const float* in[22];
    float* out;
    unsigned char* ws;
    int ph_lo, ph_hi, li, pad;
};
namespace pg8 {
#define PG8_LAS __attribute__((address_space(3)))
typedef unsigned short bf16_t;
typedef short bf16x8 __attribute__((ext_vector_type(8)));
typedef float f32x4 __attribute__((ext_vector_type(4)));
typedef unsigned u32x4 __attribute__((ext_vector_type(4)));
constexpr int BM = 256, BK = 64, HALF = 128, HTB = HALF * BK * 2  , STAGE_BYTES = 8 * HTB, NXCD = 8, WGM = 8;

__host__ __device__ __forceinline__ int lds_byte(int r, int c) { const int st = (r >> 4) * 2 + (c >> 5), rr = r & 15, cc = c & 31, ob = rr * 64 + cc * 2; return st * 1024 + (ob ^ (((ob >> 9) & 1) << 5)); }
__host__ __device__ __forceinline__ void stage_rc(int b, int& R, int& C) { const int st = b / 1024, sb = b % 1024, swz = sb ^ (((sb >> 9) & 1) << 5); R = (st >> 1) * 16 + swz / 64; C = (st & 1) * 32 + (swz % 64) / 2; }
__host__ __device__ __forceinline__ int perm32(int rho) { const int n = rho >> 4, i = rho & 15; return 8 * (i >> 2) + 4 * n + (i & 3); }

struct Unit { int pm, pn; };
struct Gemm { const bf16_t* A; const bf16_t* Bt; int M, N, K; };

struct StaticOrder {
    int nM, nN, nwg, G, c;
    __host__ __device__ void init(int M, int N, int G_, int c_) { nM = M / BM; nN = N / BM; nwg = nM * nN; G = G_; c = c_; }
    __host__ __device__ bool next(int i, Unit& u) const {
        const long L = (long)i * G + c; if (L >= nwg) return false;
        int wgid = (int)L; { const int q = nwg / NXCD, r = nwg % NXCD, xcd = wgid % NXCD, off = wgid / NXCD; wgid = (xcd < r ? xcd * (q + 1) : r * (q + 1) + (xcd - r) * q) + off; }
        const int nig = WGM * nN, gid = wgid / nig, fm = gid * WGM, gsz = (nM - fm) < WGM ? (nM - fm) : WGM;
        u.pm = fm + ((wgid % nig) % gsz); u.pn = (wgid % nig) / gsz; return true;
    }
    __device__ __forceinline__ void a_ready(const Unit&) const {}
    __device__ __forceinline__ void done(const Unit&) const {}
};

__device__ __forceinline__ unsigned cvt_pk_bf16(float lo, float hi) { unsigned r; asm volatile("v_cvt_pk_bf16_f32 %0, %1, %2" : "=v"(r) : "v"(lo), "v"(hi)); return r; }
typedef float f32x2 __attribute__((ext_vector_type(2)));

template <class Epi, class Sched, bool ALIGN_EPI = false, bool SP2 = false>
__device__ __forceinline__ void gemm_phase(PG8_LAS unsigned char* lds, const Gemm g, const Sched& S, const Epi& E) {
    const int tid = threadIdx.x, wid = __builtin_amdgcn_readfirstlane(tid >> 6), lane = tid & 63, wr = wid >> 2, wc = wid & 3, fr = lane & 15, fq = lane >> 4;
    const int K = g.K, nt = K / BK;
    unsigned voffA[2], voffB[2];
#pragma unroll
    for (int i = 0; i < 2; ++i) { int R, C; stage_rc(tid * 16 + i * 8192, R, C); const int Rb = Epi::HEADPERM ? (64 * (R >> 5) + perm32(R & 31)) : (Epi::PERM ? ((R & ~31) + perm32(R & 31)) : R);
        voffA[i] = (unsigned)(R * K + C) * 2u; voffB[i] = (unsigned)(Rb * K + C) * 2u; }
    const size_t kstep = (size_t)(BK * 2);
    const size_t hstep = (size_t)HALF * K * 2;
    const size_t tstep = 2 * hstep; const size_t bhstep = Epi::HEADPERM ? (size_t)32 * K * 2 : hstep;
    const unsigned ldsw = (unsigned)wid * 1024u;
    const int aoff = lds_byte(wr * 64 + fr, fq * 8), boff = lds_byte(wc * 32 + fr, fq * 8);
#define PG8_SA(b, h) (((b) * 2 + (h)) * HTB)
#define PG8_SB(b, h) ((4 + (b) * 2 + (h)) * HTB)
#define PG8_STAGE(bufoff, gbase, voff) do { _Pragma("unroll") for (int _i = 0; _i < 2; ++_i) \
        __builtin_amdgcn_global_load_lds((const unsigned*)((const char*)(gbase) + (voff)[_i]), (PG8_LAS unsigned*)(lds + (bufoff) + ldsw + _i * 8192), 16, 0, 0); } while (0)
#define PG8_LDA(dst, b, h) do { _Pragma("unroll") for (int m = 0; m < 4; ++m) _Pragma("unroll") for (int k = 0; k < 2; ++k) dst[m][k] = *(const PG8_LAS bf16x8*)(lds + PG8_SA(b, h) + aoff + m * 2048 + k * 1024); } while (0)
#define PG8_LDB(dst, b, h) do { _Pragma("unroll") for (int n = 0; n < 2; ++n) _Pragma("unroll") for (int k = 0; k < 2; ++k) dst[n][k] = *(const PG8_LAS bf16x8*)(lds + PG8_SB(b, h) + boff + n * 2048 + k * 1024); } while (0)
#define PG8_MMA(ai, bj, At, Bt) do { __builtin_amdgcn_s_setprio(1); _Pragma("unroll") for (int m = 0; m < 4; ++m) _Pragma("unroll") for (int n = 0; n < 2; ++n) _Pragma("unroll") for (int k = 0; k < 2; ++k) \
        acc[ai][bj][m][n] = __builtin_amdgcn_mfma_f32_16x16x32_bf16(Bt[n][k], At[m][k], acc[ai][bj][m][n], 0, 0, 0); __builtin_amdgcn_s_setprio(0); } while (0)
#define PG8_WAIT_V(n) asm volatile("s_waitcnt vmcnt(" #n ")" ::: "memory")
#define PG8_WAIT_L(n) asm volatile("s_waitcnt lgkmcnt(" #n ")" ::: "memory")
#define PG8_BAR __builtin_amdgcn_s_barrier()
#define PG8_SCHED __builtin_amdgcn_sched_barrier(0)
    Unit cur, nxt; int ui = 0;
    if (!S.next(0, cur)) return;
    f32x4 acc[2][2][4][2];
#pragma unroll
    for (int a = 0; a < 2; ++a)
#pragma unroll
        for (int b = 0; b < 2; ++b)
#pragma unroll
            for (int m = 0; m < 4; ++m)
#pragma unroll
                for (int n = 0; n < 2; ++n) acc[a][b][m][n] = (f32x4){0.f, 0.f, 0.f, 0.f};
    bf16x8 At[4][2], B0[2][2], B1[2][2];
    const char* cA = (const char*)g.A + (size_t)cur.pm * tstep; const char* cB = (const char*)g.Bt + (size_t)cur.pn * tstep;
    S.a_ready(cur);
    if constexpr (SP2) {
        PG8_STAGE(PG8_SB(0, 0), cB, voffB); PG8_STAGE(PG8_SB(0, 1), cB + bhstep, voffB); PG8_STAGE(PG8_SA(0, 0), cA, voffA); PG8_STAGE(PG8_SA(0, 1), cA + hstep, voffA);
        if (wr == 1) PG8_BAR;
        PG8_WAIT_V(2); PG8_BAR;
        PG8_STAGE(PG8_SB(1, 0), cB + kstep, voffB); PG8_STAGE(PG8_SA(1, 0), cA + kstep, voffA); PG8_STAGE(PG8_SB(1, 1), cB + bhstep + kstep, voffB);
        PG8_WAIT_V(6); PG8_BAR;
    } else {
        PG8_STAGE(PG8_SB(0, 0), cB, voffB); PG8_STAGE(PG8_SA(0, 0), cA, voffA); PG8_STAGE(PG8_SB(0, 1), cB + bhstep, voffB); PG8_STAGE(PG8_SA(0, 1), cA + hstep, voffA);
        if (wr == 1) PG8_BAR;
        PG8_WAIT_V(4); PG8_BAR;
        PG8_STAGE(PG8_SB(1, 0), cB + kstep, voffB); PG8_STAGE(PG8_SA(1, 0), cA + kstep, voffA); PG8_STAGE(PG8_SB(1, 1), cB + bhstep + kstep, voffB);
        PG8_WAIT_V(6); PG8_BAR;
    }
    for (;;) {
        const bool has_next = S.next(ui + 1, nxt);
        const char* nA = has_next ? (const char*)g.A + (size_t)nxt.pm * tstep : cA; const char* nB = has_next ? (const char*)g.Bt + (size_t)nxt.pn * tstep : cB;
        for (int t = 0; t < nt; t += 2) {
            const bool last = (t == nt - 2);
            const char* a1 = cA + (size_t)(t + 1) * kstep;
            const char* a2 = last ? nA : cA + (size_t)(t + 2) * kstep; const char* b2 = last ? nB : cB + (size_t)(t + 2) * kstep;
            const char* a3 = a2 + kstep; const char* b3 = b2 + kstep;
            if (last && has_next) S.a_ready(nxt);
            if constexpr (SP2) {
            PG8_LDB(B0, 0, 0); PG8_LDB(B1, 0, 1); PG8_SCHED; PG8_LDA(At, 0, 0); PG8_STAGE(PG8_SA(1, 1), a1 + hstep, voffA);
            PG8_WAIT_V(8); PG8_WAIT_L(0); PG8_BAR; PG8_MMA(0, 0, At, B0); PG8_MMA(0, 1, At, B1); PG8_BAR; PG8_SCHED;
            PG8_LDA(At, 0, 1); PG8_STAGE(PG8_SB(0, 0), b2, voffB); PG8_STAGE(PG8_SB(0, 1), b2 + bhstep, voffB); PG8_STAGE(PG8_SA(0, 0), a2, voffA);
            PG8_WAIT_V(8); PG8_WAIT_L(0); PG8_BAR; PG8_MMA(1, 0, At, B0); PG8_MMA(1, 1, At, B1); PG8_BAR; PG8_SCHED;
            PG8_LDB(B0, 1, 0); PG8_LDB(B1, 1, 1); PG8_SCHED; PG8_LDA(At, 1, 0); PG8_STAGE(PG8_SA(0, 1), a2 + hstep, voffA);
            PG8_WAIT_V(8); PG8_WAIT_L(0); PG8_BAR; PG8_MMA(0, 0, At, B0); PG8_MMA(0, 1, At, B1); PG8_BAR; PG8_SCHED;
            PG8_LDA(At, 1, 1); PG8_STAGE(PG8_SB(1, 0), b3, voffB); PG8_STAGE(PG8_SB(1, 1), b3 + bhstep, voffB); PG8_STAGE(PG8_SA(1, 0), a3, voffA);
            PG8_WAIT_V(8); PG8_WAIT_L(0); PG8_BAR; PG8_MMA(1, 0, At, B0); PG8_MMA(1, 1, At, B1); PG8_BAR; PG8_SCHED;
            } else {
            PG8_LDB(B0, 0, 0); PG8_SCHED; PG8_LDA(At, 0, 0); PG8_STAGE(PG8_SA(1, 1), a1 + hstep, voffA);
            PG8_WAIT_L(8); PG8_BAR; PG8_WAIT_L(0); PG8_MMA(0, 0, At, B0); PG8_BAR; PG8_SCHED;
            PG8_LDB(B1, 0, 1); PG8_STAGE(PG8_SB(0, 0), b2, voffB);
            PG8_BAR; PG8_WAIT_L(0); PG8_MMA(0, 1, At, B1); PG8_BAR;
            PG8_LDA(At, 0, 1); PG8_STAGE(PG8_SA(0, 0), a2, voffA);
            PG8_BAR; PG8_WAIT_L(0); PG8_MMA(1, 0, At, B0); PG8_BAR; PG8_SCHED;
            PG8_STAGE(PG8_SB(0, 1), b2 + bhstep, voffB);
            PG8_WAIT_V(6); PG8_BAR; PG8_MMA(1, 1, At, B1); PG8_BAR;
            PG8_LDB(B0, 1, 0); PG8_SCHED; PG8_LDA(At, 1, 0); PG8_STAGE(PG8_SA(0, 1), a2 + hstep, voffA);
            PG8_WAIT_L(8); PG8_BAR; PG8_WAIT_L(0); PG8_MMA(0, 0, At, B0); PG8_BAR; PG8_SCHED;
            PG8_LDB(B1, 1, 1); PG8_STAGE(PG8_SB(1, 0), b3, voffB);
            PG8_BAR; PG8_WAIT_L(0); PG8_MMA(0, 1, At, B1); PG8_BAR;
            PG8_LDA(At, 1, 1); PG8_STAGE(PG8_SA(1, 0), a3, voffA);
            PG8_BAR; PG8_WAIT_L(0); PG8_MMA(1, 0, At, B0); PG8_BAR; PG8_SCHED;
            PG8_STAGE(PG8_SB(1, 1), b3 + bhstep, voffB);
            PG8_WAIT_V(6); PG8_BAR; PG8_MMA(1, 1, At, B1); PG8_BAR;
            }
        }
        if constexpr (ALIGN_EPI) { if (wr == 0) PG8_BAR; }
        if constexpr (!Epi::AFTER_DRAIN) { E(acc, cur, wr, wc, fr, fq); S.done(cur); }
        if (!has_next) break;
#pragma unroll
        for (int a = 0; a < 2; ++a)
#pragma unroll
            for (int b = 0; b < 2; ++b)
#pragma unroll
                for (int m = 0; m < 4; ++m)
#pragma unroll
                    for (int n = 0; n < 2; ++n) acc[a][b][m][n] = (f32x4){0.f, 0.f, 0.f, 0.f};
        cur = nxt; cA = nA; cB = nB; ++ui;
        if constexpr (ALIGN_EPI) { if (wr == 1) PG8_BAR; }
    }
    PG8_WAIT_V(0);
    if constexpr (!ALIGN_EPI) { if (wr == 0) PG8_BAR; }
    PG8_BAR;
    if constexpr (Epi::AFTER_DRAIN) { E.fused(acc, cur, wr, wc, fr, fq, lds, wid, lane); S.done(cur); }
#undef PG8_SA
#undef PG8_SB
#undef PG8_STAGE
#undef PG8_LDA
#undef PG8_LDB
#undef PG8_MMA
#undef PG8_WAIT_V
#undef PG8_WAIT_L
#undef PG8_BAR
#undef PG8_SCHED
}
}
namespace attn_body {
using bf16=__hip_bfloat16;
using bf16x8=__attribute__((ext_vector_type(8)))short;
using s16x4=__attribute__((ext_vector_type(4)))short;
using f32x16=__attribute__((ext_vector_type(16)))float;
using u32x4=__attribute__((ext_vector_type(4)))unsigned;
constexpr int D=64, QP=512, KP=128, OP=1024, NKEYS=2304, NQ=2048;
constexpr int NW=8,QBLK=32,QB=QBLK*NW,KVBLK=64,NQB=NQ/QB;
constexpr int ATTN_UNIT_ROWS=QB;
__device__ __forceinline__ int crow(int r,int hi){return (r&3)+8*(r>>2)+4*hi;}
#define SBAR() __builtin_amdgcn_sched_barrier(0)
constexpr int NSLOT=3, SLOTB=8192;
constexpr int LDS_K=0, LDS_V=NSLOT*SLOTB, LDS_WS=2*NSLOT*SLOTB, LDS_OST=LDS_WS+NW*64*4, LDS_BYTES=LDS_OST+NW*4096;
constexpr float C2=0.125f*1.4426950408889634f;
__device__ __forceinline__ void glds16(const void*gsrc,unsigned lds_dst){unsigned keep;
  asm volatile("s_mov_b32 %0, m0\n\ts_mov_b32 m0, %2\n\ts_nop 0\n\tglobal_load_lds_dwordx4 %1, off\n\ts_mov_b32 m0, %0":"=&s"(keep):"v"(gsrc),"s"(lds_dst):"memory");}
__device__ __forceinline__ float max3f(float a,float b,float c){float r;asm("v_max3_f32 %0, %1, %2, %3":"=v"(r):"v"(a),"v"(b),"v"(c));return r;}
__device__ __forceinline__ float max2f(float a,float b){float r;asm("v_max_f32_e32 %0, %1, %2":"=v"(r):"v"(a),"v"(b));return r;}
__device__ __forceinline__ float fadd_s(float a,float b){float r;asm("v_add_f32_e32 %0, %1, %2":"=v"(r):"v"(a),"v"(b));return r;}
__device__ __forceinline__ float fsub_s(float a,float b){float r;asm("v_sub_f32_e32 %0, %1, %2":"=v"(r):"v"(a),"v"(b));return r;}
typedef float f32x2_t __attribute__((ext_vector_type(2))); typedef __bf16 bf16x2_t __attribute__((ext_vector_type(2)));
__device__ __forceinline__ unsigned cvtpk_s(float lo,float hi){f32x2_t v={lo,hi};bf16x2_t b=__builtin_convertvector(v,bf16x2_t);return __builtin_bit_cast(unsigned,b);}
#define WAIT_BAR(N) asm volatile("s_waitcnt vmcnt(" #N ") lgkmcnt(0)\n\ts_barrier":::"memory")

__device__ __forceinline__ void qkt(f32x16&p0,f32x16&p1,const char*Kslot,const bf16x8*qr,const f32x16&negm,int r32,int hi){
  const char*kb=Kslot+hi*1024+r32*16;
  #pragma unroll
  for(int d0=0;d0<4;++d0){
    const bf16x8 b0=*reinterpret_cast<const bf16x8*>(kb+d0*2048);
    const bf16x8 b1=*reinterpret_cast<const bf16x8*>(kb+d0*2048+512);
    if(d0==0){p0=__builtin_amdgcn_mfma_f32_32x32x16_bf16(b0,qr[0],negm,0,0,0);p1=__builtin_amdgcn_mfma_f32_32x32x16_bf16(b1,qr[0],negm,0,0,0);}
    else{p0=__builtin_amdgcn_mfma_f32_32x32x16_bf16(b0,qr[d0],p0,0,0,0);p1=__builtin_amdgcn_mfma_f32_32x32x16_bf16(b1,qr[d0],p1,0,0,0);}}
}
typedef __attribute__((address_space(3))) const char* lds_cptr;
typedef short v4i16_t __attribute__((ext_vector_type(4)));
__device__ __forceinline__ void kload8(bf16x8*kf,lds_cptr kp){
  kf[0]=*(const __attribute__((address_space(3))) bf16x8*)(kp);      kf[1]=*(const __attribute__((address_space(3))) bf16x8*)(kp+512);
  kf[2]=*(const __attribute__((address_space(3))) bf16x8*)(kp+2048); kf[3]=*(const __attribute__((address_space(3))) bf16x8*)(kp+2560);
  kf[4]=*(const __attribute__((address_space(3))) bf16x8*)(kp+4096); kf[5]=*(const __attribute__((address_space(3))) bf16x8*)(kp+4608);
  kf[6]=*(const __attribute__((address_space(3))) bf16x8*)(kp+6144); kf[7]=*(const __attribute__((address_space(3))) bf16x8*)(kp+6656);
}
__device__ __forceinline__ void kload2(bf16x8*kf,lds_cptr kp,int j){ kf[2*j]=*(const __attribute__((address_space(3))) bf16x8*)(kp+j*2048); kf[2*j+1]=*(const __attribute__((address_space(3))) bf16x8*)(kp+j*2048+512); }
__device__ __forceinline__ s16x4 vtr(lds_cptr p){ return __builtin_bit_cast(s16x4,__builtin_amdgcn_ds_read_tr16_b64_v4i16((__attribute__((address_space(3))) v4i16_t*)p)); }
__device__ __forceinline__ float rowmax(const f32x16&p0,const f32x16&p1){
  float a=max3f(p0[0],p0[1],p1[0]),b=max3f(p0[2],p0[3],p1[1]);a=max3f(a,p1[2],p1[3]);
  #pragma unroll
  for(int r=4;r<16;r+=4){a=max3f(a,p0[r],p0[r+1]);b=max3f(b,p0[r+2],p0[r+3]);a=max3f(a,p1[r],p1[r+1]);b=max3f(b,p1[r+2],p1[r+3]);}
  const float m=max2f(a,b);
  auto rr=__builtin_amdgcn_permlane32_swap(__float_as_uint(m),__float_as_uint(m),false,false);
  return max2f(__uint_as_float(rr[0]),__uint_as_float(rr[1]));
}
__device__ __forceinline__ void pv(f32x16*o,int vb,bf16x8 pa0,bf16x8 pa1,bf16x8 pa2,bf16x8 pa3){
  #pragma unroll
  for(int d0=0;d0<2;++d0){s16x4 lo[4],hi[4];
    #pragma unroll
    for(int ks=0;ks<4;++ks){
      asm volatile("ds_read_b64_tr_b16 %0,%1 offset:%c2":"=&v"(lo[ks]):"v"(vb),"i"(d0*4096+ks*1024):"memory");
      asm volatile("ds_read_b64_tr_b16 %0,%1 offset:%c2":"=&v"(hi[ks]):"v"(vb),"i"(d0*4096+ks*1024+512):"memory");}
    asm volatile("s_waitcnt lgkmcnt(0)":::"memory");SBAR();
    #define PK(k) (bf16x8){lo[k][0],lo[k][1],lo[k][2],lo[k][3],hi[k][0],hi[k][1],hi[k][2],hi[k][3]}
    o[d0]=__builtin_amdgcn_mfma_f32_32x32x16_bf16(pa0,PK(0),o[d0],0,0,0);
    o[d0]=__builtin_amdgcn_mfma_f32_32x32x16_bf16(pa1,PK(1),o[d0],0,0,0);
    o[d0]=__builtin_amdgcn_mfma_f32_32x32x16_bf16(pa2,PK(2),o[d0],0,0,0);
    o[d0]=__builtin_amdgcn_mfma_f32_32x32x16_bf16(pa3,PK(3),o[d0],0,0,0);
    #undef PK
  }
}

#ifndef ATTN_STORE16
#define ATTN_STORE16(p,v) (*(u32x4*)(p)=(v))
#endif
template<int THRL> __device__ __forceinline__ void attn_unit(int b,int h,int kvh,int qb,const bf16*Q,const bf16*__restrict__ K,const bf16*__restrict__ V,bf16*O,char*shm){
  const int tid=threadIdx.x,lane=tid&63,r32=lane&31,hi=lane>>5; const int wid=__builtin_amdgcn_readfirstlane(tid>>6);
  const long rowbase=(long)b*NQ; const int q0=qb*QB;
  const bf16*Qw=Q+(rowbase+q0+wid*QBLK)*QP+h*D;
  const bf16*Kh=K+(long)b*NKEYS*KP+kvh*D,*Vh=V+(long)b*NKEYS*KP+kvh*D;
  const unsigned lds0=(unsigned)(uintptr_t)shm;
  float*wsf=(float*)(shm+LDS_WS)+wid*64;
  const bf16*ksrc=Kh+(long)lane*KP+wid*8;
  const bf16*vsrc=Vh+(long)(16*(wid&3)+(lane>>2))*KP+(wid>>2)*32+(lane&3)*8;
  const unsigned kdst=lds0+LDS_K+wid*1024, vdst=lds0+LDS_V+wid*1024;
  #define DMA_K(t,slot) glds16(ksrc+(long)(t)*KVBLK*KP,(unsigned)__builtin_amdgcn_readfirstlane(kdst+(slot)))
  #define DMA_V(t,slot) glds16(vsrc+(long)(t)*KVBLK*KP,(unsigned)__builtin_amdgcn_readfirstlane(vdst+(slot)))
  const int vb0=(int)(lds0+LDS_V)+((lane>>4)&1)*32+(lane&3)*8+(4*hi+((lane&15)>>2))*64;
  const char*Kbase=shm+LDS_K; bf16x8 kf[8];
  const lds_cptr shm3=(lds_cptr)shm; const lds_cptr kp0=shm3+LDS_K+hi*1024+r32*16; const lds_cptr vp0=shm3+LDS_V+((lane>>4)&1)*32+(lane&3)*8+(4*hi+((lane&15)>>2))*64;
  constexpr int NT=NKEYS/KVBLK;
  DMA_K(0,0);DMA_V(0,0);DMA_K(1,SLOTB);
  bf16x8 qr[4];
  #pragma unroll
  for(int d0=0;d0<4;++d0)qr[d0]=*reinterpret_cast<const bf16x8*>(&Qw[(long)r32*QP+d0*16+hi*8]);
  float mhat=0.f,l_reg=0.f;f32x16 o[2];o[0]=f32x16{};o[1]=f32x16{};f32x16 negm=f32x16{};asm volatile("":"+v"(negm));
  #define CMASK(P0,P1,t) do{}while(0)
  bool resc=false;
  #define START(P0,P1) do{ const float rm=rowmax(P0,P1); resc=false; \
    { const float dl=rm; mhat=fadd_s(mhat,dl); \
      _Pragma("unroll") for(int r=0;r<16;++r){P0[r]=fsub_s(P0[r],dl);P1[r]=fsub_s(P1[r],dl);} \
      _Pragma("unroll") for(int r=0;r<16;++r)negm[r]=-mhat; asm volatile("":"+v"(negm)); } \
    _Pragma("unroll") for(int r=0;r<16;++r)P0[r]=__builtin_amdgcn_exp2f(P0[r]); }while(0)
  #define RESC() do{ if(resc){ asm volatile("s_waitcnt lgkmcnt(0)":::"memory"); \
      _Pragma("unroll") for(int d_=0;d_<2;++d_) _Pragma("unroll") for(int r=0;r<16;++r)o[d_][r]*=wsf[crow(r,hi)]; } }while(0)
  f32x16 pA0,pA1,pB0,pB1;
  int sl_prev=0,sl_cur=0,sl_next=SLOTB;
  #define ROT() do{sl_prev=sl_cur;sl_cur=sl_next;sl_next=(sl_next==(NSLOT-1)*SLOTB)?0:sl_next+SLOTB;}while(0)
  DMA_K(2,2*SLOTB);
  WAIT_BAR(3);
  qkt(pA0,pA1,Kbase,qr,negm,r32,hi);asm volatile("s_nop 15\n\ts_nop 7":"+v"(pA0),"+v"(pA1));CMASK(pA0,pA1,0);
  START(pA0,pA1);
  _Pragma("unroll") for(int r=0;r<16;++r)pA1[r]=__builtin_amdgcn_exp2f(pA1[r]);
  WAIT_BAR(0);
  DMA_K(3,0);DMA_V(1,SLOTB);
  ROT();
  kload8(kf,kp0+sl_cur);
  WAIT_BAR(2);
  s16x4 vlo[8],vhi[8]; u32x4 pw0,pw1,pw2,pw3;
  #define PKW(P,B) cvtpk_s(P[B],P[B+1])
  #define PAF(k) __builtin_bit_cast(bf16x8,pw##k)
  #define VFR(i) (bf16x8){vlo[i][0],vlo[i][1],vlo[i][2],vlo[i][3],vhi[i][0],vhi[i][1],vhi[i][2],vhi[i][3]}
  #define PIN(x) asm volatile("":"+v"(x))
  #define MX3(a,b,c) __builtin_fmaxf(__builtin_fmaxf((a),(b)),(c))
  #define GAPA(MF,A0,A1,A2,A3,W0,W1,PW) do{ MF; sacc+=A0; sacc+=A1; sacc+=A2; sacc+=A3; PIN(sacc); W0; W1; PIN(PW); SBAR(); }while(0)
  #define EX(v) __builtin_amdgcn_exp2f(v)
  #define GAPB(MF,X,B) do{ MF; X[B]=EX(X[B]); X[B+1]=EX(X[B+1]); X[B+2]=EX(X[B+2]); X[B+3]=EX(X[B+3]); PIN(X); SBAR(); }while(0)
  #define VRD(i) do{ vlo[i]=vtr(vp_+(((i)>>2)*4096+((i)&3)*1024)); vhi[i]=vtr(vp_+(((i)>>2)*4096+((i)&3)*1024+512)); }while(0)
  #define KRD(G,j) do{ if(G){ kload2(kf,kp0+sl_next,j); SBAR(); } }while(0)
  #define STEP(C0,C1,P0,P1,t,GK,GV,GL) do{ SBAR(); \
    const lds_cptr vp_=vp0+sl_prev; \
    VRD(0); SBAR(); float sacc=(P0[0]+P0[1]); \
    GAPA(C0=__builtin_amdgcn_mfma_f32_32x32x16_bf16(kf[0],qr[0],negm,0,0,0), P0[2],P0[3],P0[4],P0[5],     pw0[0]=PKW(P0,0), pw0[1]=PKW(P0,2), pw0); \
    VRD(4); SBAR(); GAPA(C1=__builtin_amdgcn_mfma_f32_32x32x16_bf16(kf[1],qr[0],negm,0,0,0), P0[6],P0[7],P0[8],P0[9],     pw0[2]=PKW(P0,4), pw0[3]=PKW(P0,6), pw0); \
    VRD(1); SBAR(); GAPA(C0=__builtin_amdgcn_mfma_f32_32x32x16_bf16(kf[2],qr[1],C0,0,0,0),   P0[10],P0[11],P0[12],P0[13], pw1[0]=PKW(P0,8), pw1[1]=PKW(P0,10), pw1); \
    VRD(5); SBAR(); GAPA(C1=__builtin_amdgcn_mfma_f32_32x32x16_bf16(kf[3],qr[1],C1,0,0,0),   P0[14],P0[15],P1[0],P1[1],   pw1[2]=PKW(P0,12),pw1[3]=PKW(P0,14), pw1); \
    VRD(2); SBAR(); GAPA(C0=__builtin_amdgcn_mfma_f32_32x32x16_bf16(kf[4],qr[2],C0,0,0,0),   P1[2],P1[3],P1[4],P1[5],     pw2[0]=PKW(P1,0), pw2[1]=PKW(P1,2), pw2); \
    VRD(6); SBAR(); GAPA(C1=__builtin_amdgcn_mfma_f32_32x32x16_bf16(kf[5],qr[2],C1,0,0,0),   P1[6],P1[7],P1[8],P1[9],     pw2[2]=PKW(P1,4), pw2[3]=PKW(P1,6), pw2); \
    VRD(3); SBAR(); GAPA(C0=__builtin_amdgcn_mfma_f32_32x32x16_bf16(kf[6],qr[3],C0,0,0,0),   P1[10],P1[11],P1[12],P1[13], pw3[0]=PKW(P1,8), pw3[1]=PKW(P1,10), pw3); \
    VRD(7); SBAR(); GAPA(C1=__builtin_amdgcn_mfma_f32_32x32x16_bf16(kf[7],qr[3],C1,0,0,0),   P1[14],P1[15],0.f,0.f,       pw3[2]=PKW(P1,12),pw3[3]=PKW(P1,14), pw3); \
    l_reg+=sacc; \
    if(GK){DMA_K((t)+3,sl_cur);} if(GV){DMA_V((t)+1,sl_next);} \
    CMASK(C0,C1,t); \
    { float a=MX3(C0[0],C0[1],C1[0]),b=MX3(C0[2],C0[3],C1[1]); a=MX3(a,C1[2],C1[3]); \
      _Pragma("unroll") for(int r=4;r<16;r+=4){a=MX3(a,C0[r],C0[r+1]);b=MX3(b,C0[r+2],C0[r+3]);a=MX3(a,C1[r],C1[r+1]);b=MX3(b,C1[r+2],C1[r+3]);} \
      float rm=__builtin_fmaxf(a,b); { auto rr=__builtin_amdgcn_permlane32_swap(__float_as_uint(rm),__float_as_uint(rm),false,false); rm=__builtin_fmaxf(__uint_as_float(rr[0]),__uint_as_float(rr[1])); } \
      resc=false; \
      if(__builtin_expect(__any(rm>(float)THRL),0)){ const float dl=__builtin_fmaxf(rm,0.f); mhat+=dl; \
        _Pragma("unroll") for(int r=0;r<16;++r){C0[r]-=dl;C1[r]-=dl;} \
        _Pragma("unroll") for(int r=0;r<16;++r)negm[r]=-mhat; asm volatile("":"+v"(negm)); \
        const float f=__builtin_amdgcn_exp2f(-dl); l_reg*=f; if(hi==0)wsf[r32]=f; resc=true; } } \
    SBAR(); \
    GAPB(o[0]=__builtin_amdgcn_mfma_f32_32x32x16_bf16(PAF(0),VFR(0),o[0],0,0,0), C0,0); \
    GAPB(o[1]=__builtin_amdgcn_mfma_f32_32x32x16_bf16(PAF(0),VFR(4),o[1],0,0,0), C0,4); \
    KRD(GL,0); GAPB(o[0]=__builtin_amdgcn_mfma_f32_32x32x16_bf16(PAF(1),VFR(1),o[0],0,0,0), C0,8); \
    KRD(GL,1); GAPB(o[1]=__builtin_amdgcn_mfma_f32_32x32x16_bf16(PAF(1),VFR(5),o[1],0,0,0), C0,12); \
    KRD(GL,2); GAPB(o[0]=__builtin_amdgcn_mfma_f32_32x32x16_bf16(PAF(2),VFR(2),o[0],0,0,0), C1,0); \
    KRD(GL,3); GAPB(o[1]=__builtin_amdgcn_mfma_f32_32x32x16_bf16(PAF(2),VFR(6),o[1],0,0,0), C1,4); \
    GAPB(o[0]=__builtin_amdgcn_mfma_f32_32x32x16_bf16(PAF(3),VFR(3),o[0],0,0,0), C1,8); \
    GAPB(o[1]=__builtin_amdgcn_mfma_f32_32x32x16_bf16(PAF(3),VFR(7),o[1],0,0,0), C1,12); \
    }while(0)
  int t=1;
  for(;t+5<NT;t+=2){
    STEP(pB0,pB1,pA0,pA1,t,true,true,true);     WAIT_BAR(2); RESC(); ROT();
    STEP(pA0,pA1,pB0,pB1,t+1,true,true,true);   WAIT_BAR(2); RESC(); ROT();
  }
  #define ENDW(tt) do{ if((tt)+3<NT){WAIT_BAR(2);} else if((tt)+2<NT){WAIT_BAR(1);} else {WAIT_BAR(0);} }while(0)
  for(;t+1<NT;t+=2){
    STEP(pB0,pB1,pA0,pA1,t,(t+3<NT),(t+1<NT),(t+1<NT));       ENDW(t);   RESC(); ROT();
    STEP(pA0,pA1,pB0,pB1,t+1,(t+4<NT),(t+2<NT),(t+2<NT));     ENDW(t+1); RESC(); ROT();
  }
  STEP(pB0,pB1,pA0,pA1,NT-1,false,false,false); RESC();
  { float sacc=pB0[0]+pB0[1]; _Pragma("unroll") for(int r=2;r<16;++r)sacc+=pB0[r]; _Pragma("unroll") for(int r=0;r<16;++r)sacc+=pB1[r]; l_reg+=sacc;
    pw0=(u32x4){PKW(pB0,0),PKW(pB0,2),PKW(pB0,4),PKW(pB0,6)};pw1=(u32x4){PKW(pB0,8),PKW(pB0,10),PKW(pB0,12),PKW(pB0,14)};pw2=(u32x4){PKW(pB1,0),PKW(pB1,2),PKW(pB1,4),PKW(pB1,6)};pw3=(u32x4){PKW(pB1,8),PKW(pB1,10),PKW(pB1,12),PKW(pB1,14)};
    SBAR(); pv(o,vb0+sl_cur,PAF(0),PAF(1),PAF(2),PAF(3)); }
  #undef PKW
  #undef PAF
  #undef VFR
  #undef PIN
  #undef MX3
  #undef GAPA
  #undef GAPB
  #undef EX
  #undef VRD
  #undef KRD
  #undef STEP
  #undef ENDW
  {auto rr=__builtin_amdgcn_permlane32_swap(__float_as_uint(l_reg),__float_as_uint(l_reg),false,false);l_reg=__uint_as_float(rr[0])+__uint_as_float(rr[1]);}
  if(hi==0)wsf[32+r32]=l_reg;asm volatile("s_waitcnt lgkmcnt(0)":::"memory");
  float rli[16];
  #pragma unroll
  for(int r=0;r<16;++r)rli[r]=__builtin_amdgcn_rcpf(wsf[32+crow(r,hi)]);
  bf16*Ow=O+(rowbase+q0+wid*QBLK)*OP+h*D;
  { bf16*stg=(bf16*)(shm+LDS_OST)+wid*2048;
    #pragma unroll
    for(int r=0;r<16;++r){const int orow=crow(r,hi);
      #pragma unroll
      for(int d0=0;d0<2;++d0)stg[orow*64+d0*32+r32]=__float2bfloat16(o[d0][r]*rli[r]);}
    asm volatile("s_waitcnt lgkmcnt(0)":::"memory");
    #pragma unroll
    for(int i=0;i<4;++i){const int row=i*8+(lane>>3),ch=lane&7; const u32x4 v=*(const u32x4*)(stg+row*64+ch*8); ATTN_STORE16(Ow+(long)row*OP+ch*8,v);} }
  asm volatile("s_waitcnt lgkmcnt(0)\n\ts_barrier":::"memory");
  #undef DMA_K
  #undef DMA_V
  #undef CMASK
  #undef START
  #undef RESC
  #undef ROT
}
constexpr int ATTN_LDS_BYTES=LDS_BYTES;
#undef SBAR
#undef WAIT_BAR
}
typedef GAS unsigned gu32;
typedef GAS unsigned long long gu64;
#define RLX_AGENT __ATOMIC_RELAXED, __HIP_MEMORY_SCOPE_AGENT

#define XB_TMO      128
#define XB_XCNT(j)  (256  + 64 * (j))
#define XB_XSUB(j)  (1280 + 64 * (j))
#define XB_XGEN(j)  (2304 + 64 * (j))
#define XB_TOP      3328
#define XB_TOPGEN   3392
#define XCD_BAR_WORDS 3456
#define XB_SPIN_CAP (1u << 18)

__device__ __forceinline__ unsigned xb_ld(unsigned* p)              { return __hip_atomic_load(p, __ATOMIC_RELAXED, __HIP_MEMORY_SCOPE_AGENT); }
__device__ __forceinline__ unsigned xb_add(unsigned* p, unsigned v) { return __hip_atomic_fetch_add(p, v, __ATOMIC_RELAXED, __HIP_MEMORY_SCOPE_AGENT); }
__device__ __forceinline__ unsigned xb_xcc_id() { return (unsigned)__builtin_amdgcn_s_getreg((3 << 11) | 20) & 0xFu; }
#define XB_SPIN(cond, bar) do { unsigned _sp = 0; while (cond) { __builtin_amdgcn_s_sleep(1); \
    if ((++_sp & 255u) == 0u) { if (xb_ld(&(bar)[XB_TMO])) break; if (_sp > XB_SPIN_CAP) { atomicAdd(&(bar)[XB_TMO], 1u); break; } } } } while (0)

struct XcdBarrier {
    unsigned* bar; unsigned x;
    volatile LAS unsigned* st;
};

__device__ __forceinline__ XcdBarrier xcd_barrier_post(unsigned* bar, volatile LAS unsigned* st) {
    XcdBarrier b; b.bar = bar; b.x = xb_xcc_id(); b.st = st;
    if (threadIdx.x == 0) (void)xb_add(&bar[XB_XCNT(b.x)], 1u);
    return b;
}
__device__ __forceinline__ void xcd_barrier_complete(unsigned* bar, unsigned x, unsigned& nloc, unsigned& nx) {
    const unsigned G = gridDim.x * gridDim.y * gridDim.z;
    unsigned sum, cnt, mine, sp = 0u;
    for (;;) {
        sum = 0u; cnt = 0u; mine = 0u;
#pragma unroll
        for (unsigned j = 0; j < 16; ++j) { const unsigned c = xb_ld(&bar[XB_XCNT(j)]); sum += c; cnt += (c > 0u) ? 1u : 0u; mine = (j == x) ? c : mine; }
        if (sum == G) break;
        __builtin_amdgcn_s_sleep(1);
        if ((++sp & 255u) == 0u) { if (xb_ld(&bar[XB_TMO])) break; if (sp > XB_SPIN_CAP) { atomicAdd(&bar[XB_TMO], 1u); break; } }
    }
    nloc = mine > 0u ? mine : 1u; nx = cnt > 0u ? cnt : 1u;
}

__device__ __forceinline__ void xcd_barrier(const XcdBarrier& b) {
    asm volatile("s_waitcnt vmcnt(0)" ::: "memory");
    __syncthreads();
    if (threadIdx.x == 0) {
        unsigned* bar = b.bar;
        __builtin_amdgcn_s_waitcnt(0);
        unsigned nloc = b.st[0], nx = b.st[1];
        if (nloc == 0u) { xcd_barrier_complete(bar, b.x, nloc, nx); b.st[0] = nloc; b.st[1] = nx; }
        const unsigned old = xb_add(&bar[XB_XSUB(b.x)], 1u);
        const unsigned gen = old / nloc;
        if (old + 1u == (gen + 1u) * nloc) {
            __builtin_amdgcn_fence(__ATOMIC_RELEASE, "agent");
            asm volatile("s_waitcnt vmcnt(0)" ::: "memory");
            const unsigned og = xb_add(&bar[XB_TOP], 1u);
            const unsigned tg = og / nx;
            if (og + 1u == (tg + 1u) * nx) xb_add(&bar[XB_TOPGEN], 1u);
            else XB_SPIN(xb_ld(&bar[XB_TOPGEN]) == tg, bar);
            __builtin_amdgcn_fence(__ATOMIC_ACQUIRE, "agent");
            xb_add(&bar[XB_XGEN(b.x)], 1u);
            asm volatile("s_waitcnt vmcnt(0)" ::: "memory");
        } else {
            XB_SPIN(xb_ld(&bar[XB_XGEN(b.x)]) == gen, bar);
            __builtin_amdgcn_fence(__ATOMIC_ACQUIRE, "agent");
            asm volatile("s_waitcnt vmcnt(0)" ::: "memory");
        }
    }
    __syncthreads();
}
struct Ctx {
    LAS unsigned char* lds;
    unsigned char* ws;
    int tid, lane, wave, G, vcu, bx;
    const float* in[22];
    float* out;
};
enum { I_X = 0, I_C, I_CTX, I_CCTX, I_WMOD, I_BMOD, I_N1W, I_N2W, I_WIN, I_QNW, I_KNW, I_DFW, I_DBW, I_WOUT, I_RW, I_RB, I_EWG, I_EWU, I_EWD, I_SWG, I_SWU, I_SWD };

__device__ __forceinline__ float wave_sum(float v) {
#pragma unroll
    for (int o = 1; o < 64; o <<= 1) v += __shfl_xor(v, o);
    return v;
}

__device__ __forceinline__ void p0_transpose_item(const float* W, int K, int N, bf16_t* WT, int kb, int nb, int dst_row0, LAS float* scr, int lane, int mode) {
    const int k0 = 64 * kb, n0 = 32 * nb;
#pragma unroll 8
    for (int i = 0; i < 32; ++i) { const int kk = 2 * i + (lane >> 5); scr[kk * 33 + (lane & 31)] = W[(size_t)(k0 + kk) * N + n0 + (lane & 31)]; }
    LDS_WAIT(); asm volatile("" ::: "memory");
    const int c = lane & 7;
#pragma unroll
    for (int j = 0; j < 4; ++j) { const int n = (lane >> 3) + 8 * j; const LAS float* s = scr + (8 * c) * 33 + n;
        float v[8];
#pragma unroll
        for (int q = 0; q < 8; ++q) v[q] = s[q * 33];
        if (mode == 1) {
#pragma unroll
            for (int q = 0; q < 8; ++q) v[q] = v[q] - bf2f((unsigned short)f2bf(v[q]));
        }
        u32x4 o; o.x = pk2(v[0], v[1]); o.y = pk2(v[2], v[3]); o.z = pk2(v[4], v[5]); o.w = pk2(v[6], v[7]);
        *(GAS u32x4*)(WT + (size_t)(dst_row0 + n) * K + k0 + 8 * c) = o; }
    LDS_WAIT(); asm volatile("" ::: "memory");
}

__device__ __forceinline__ void phase_p0(Ctx& F) {
    float* modv = (float*)(F.ws + WS_MODV);
    if (F.bx < 96) {
        LAS float* sc = (LAS float*)F.lds;
        LAS float* red = sc + 9 * 1024;
        for (int i = F.tid; i < 9 * 1024; i += NTHR) { const int r = i >> 10, k = i & 1023; const float v = r < NB ? F.in[I_C][r * D + k] : F.in[I_CCTX][k]; sc[i] = siluf(v); }
        __syncthreads();
        const int col = F.bx * 64 + F.lane;
        const float* Wm = F.in[I_WMOD] + (size_t)(F.wave * 128) * (6 * D) + col;
        float acc[9];
#pragma unroll
        for (int r = 0; r < 9; ++r) acc[r] = 0.f;
#pragma unroll 16
        for (int k = 0; k < 128; ++k) {
            const float wv = Wm[(size_t)k * (6 * D)];
#pragma unroll
            for (int r = 0; r < 9; ++r) acc[r] += sc[r * 1024 + F.wave * 128 + k] * wv;
        }
#pragma unroll
        for (int r = 0; r < 9; ++r) red[(F.wave * 9 + r) * 64 + F.lane] = acc[r];
        __syncthreads();
        for (int i = F.tid; i < 9 * 64; i += NTHR) { const int r = i >> 6, l = i & 63; float s = 0.f;
#pragma unroll
            for (int w = 0; w < 8; ++w) s += red[(w * 9 + r) * 64 + l];
            modv[(size_t)r * (6 * D) + F.bx * 64 + l] = s + F.in[I_BMOD][F.bx * 64 + l]; }
        __syncthreads();
    }
    {
        LAS float* scr = (LAS float*)(F.lds + 57344 + F.wave * 8704);
        const int gw = ((F.bx + F.G - 96) % F.G) * NWAVES + F.wave, NGW = F.G * NWAVES;
        constexpr int I_IN = 16 * (INC / 32), I_OUT = 16 * (D / 32), I_R = 16 * (NE / 32), I_SG = 16 * (FF / 32), I_SD = 4 * (D / 32);
        constexpr int NITEMS = I_IN + I_OUT + 2 * I_R + 2 * I_SG + I_SD;
        for (int it = gw; it < NITEMS; it += NGW) {
            int r = it;
            if (r < I_IN) { const int nblk = INC / 32; p0_transpose_item(F.in[I_WIN], D, INC, (bf16_t*)(F.ws + WS_WIN), r / nblk, r % nblk, 32 * (r % nblk), scr, F.lane, 0); continue; } r -= I_IN;
            if (r < I_OUT) { const int nblk = D / 32; p0_transpose_item(F.in[I_WOUT], D, D, (bf16_t*)(F.ws + WS_WOUT), r / nblk, r % nblk, 32 * (r % nblk), scr, F.lane, 0); continue; } r -= I_OUT;
            if (r < 2 * I_R) { const int lo = r >= I_R; const int q = r - lo * I_R; const int nblk = NE / 32;
                p0_transpose_item(F.in[I_RW], D, NE, (bf16_t*)(F.ws + WS_WR), q / nblk, q % nblk, lo * 256 + 32 * (q % nblk), scr, F.lane, lo); continue; } r -= 2 * I_R;
            if (r < 2 * I_SG) { const int up = r >= I_SG; const int q = r - up * I_SG; const int nblk = FF / 32, nb = q % nblk;
                p0_transpose_item(F.in[up ? I_SWU : I_SWG], D, FF, (bf16_t*)(F.ws + WS_WSGU), q / nblk, nb, (nb >> 2) * 256 + up * 128 + (nb & 3) * 32, scr, F.lane, 0); continue; } r -= 2 * I_SG;
            { const int nblk = D / 32; p0_transpose_item(F.in[I_SWD], FF, D, (bf16_t*)(F.ws + WS_WSD), r / nblk, r % nblk, 32 * (r % nblk), scr, F.lane, 0); }
        }
    }
    if (F.bx == F.G - 1) {
        float2* tab = (float2*)(F.ws + WS_ROPE);
        for (int i = F.tid; i < 96 * 16; i += NTHR) { const int p = i >> 4, fi = i & 15; const float pos = (float)(p < 32 ? p : p - 32);
            const float ang = pos * powf(10000.f, -(float)fi / 16.f); tab[i] = make_float2(cosf(ang), sinf(ang)); }
    }
}

__device__ __forceinline__ void phase_p0b(Ctx& F) {
    const float* modv = (const float*)(F.ws + WS_MODV);
    bf16_t* HB = (bf16_t*)(F.ws + WS_HB);
    const int gw = F.vcu * NWAVES + F.wave, NGW = F.G * NWAVES;
    f32x4 nw[4];
#pragma unroll
    for (int j = 0; j < 4; ++j) nw[j] = ((const f32x4*)F.in[I_N1W])[F.lane + 64 * j];
    for (int m = gw; m < TALL; m += NGW) {
        const float* xrow = m < T ? F.in[I_X] + (size_t)m * D : F.in[I_CTX] + (size_t)(m - T) * D;
        const int r = m < T ? m / L : 8;
        const f32x4* sh = (const f32x4*)(modv + (size_t)r * (6 * D)); const f32x4* sc = sh + D / 4;
        f32x4 v[4]; float s = 0.f;
#pragma unroll
        for (int j = 0; j < 4; ++j) { v[j] = ((const f32x4*)xrow)[F.lane + 64 * j]; s += (v[j].x * v[j].x + v[j].y * v[j].y) + (v[j].z * v[j].z + v[j].w * v[j].w); }
        const float rinv = rsqrtf(wave_sum(s) * (1.f / D) + EPS);
        unsigned long long* o8 = (unsigned long long*)(HB + (size_t)m * D) + F.lane;
#pragma unroll
        for (int j = 0; j < 4; ++j) { const f32x4 a = sh[F.lane + 64 * j], b = sc[F.lane + 64 * j];
            const f32x4 o = v[j] * rinv * nw[j] * (1.f + b) + a;
            o8[64 * j] = (unsigned long long)pk2(o.x, o.y) | ((unsigned long long)pk2(o.z, o.w) << 32); }
    }
}

struct P1Order {
    int x, j;
    __device__ __forceinline__ bool next(int i, pg8::Unit& u) const {
        const int q = i * 32 + j;
        if (q < 88) { u.pm = x * 8 + q / 11; u.pn = q % 11; return true; }
        if (q < 93) { u.pm = 64 + x; u.pn = q - 88; return true; }
        return false;
    }
    __device__ __forceinline__ void a_ready(const pg8::Unit&) const {}
    __device__ __forceinline__ void done(const pg8::Unit&) const {}
};
struct EpiP1 {
    static constexpr bool PERM = true, HEADPERM = true, AFTER_DRAIN = false;
    unsigned char* ws; const float* qnw; const float* knw;
    __device__ __forceinline__ void operator()(const f32x4 (&acc)[2][2][4][2], const pg8::Unit& u, int wr, int wc, int fr, int fq) const {
        const int G = u.pn * 4 + wc;
        const bool isctx = u.pm >= 64;
        int kind, hh; bf16_t* base; int pitch;
        if (G < 2) { kind = 0; hh = G; base = (bf16_t*)(ws + WS_KB); pitch = 128; }
        else if (G < 4) { kind = 1; hh = G - 2; base = (bf16_t*)(ws + WS_VB); pitch = 128; }
        else if (G < 12) { kind = 2; hh = G - 4; base = (bf16_t*)(ws + WS_RKB); pitch = 512; }
        else if (G < 20) { kind = 1; hh = G - 12; base = (bf16_t*)(ws + WS_RVB); pitch = 512; }
        else if (G < 28) { kind = 0; hh = G - 20; base = (bf16_t*)(ws + WS_QB); pitch = 512; }
        else if (G < 36) { kind = 1; hh = G - 28; base = (bf16_t*)(ws + WS_RQB); pitch = 512; }
        else { kind = 3; hh = G - 36; base = (bf16_t*)(ws + WS_RGB); pitch = 512; }
        const bool isq = G >= 20;
        const bool keyrows = G < 20;
        f32x4 nwv[2][2];
        if (kind == 0) {
            const float* nwp = isq ? qnw : knw; const float sc = isq ? C2 : 1.f;
#pragma unroll
            for (int bj = 0; bj < 2; ++bj)
#pragma unroll
                for (int n = 0; n < 2; ++n) nwv[bj][n] = *(const f32x4*)(nwp + 32 * bj + 8 * fq + 4 * n) * sc;
        }
        const float2* tab = (const float2*)(ws + WS_ROPE);
#pragma unroll
        for (int ai = 0; ai < 2; ++ai)
#pragma unroll
            for (int m = 0; m < 4; ++m) {
                const int r = u.pm * 256 + ai * 128 + wr * 64 + m * 16 + fr;
                int b, t; if (!isctx) { b = r >> 11; t = r & 2047; } else { const int rc = r - T; b = rc >> 8; t = rc & 255; }
                const size_t drow = keyrows ? (size_t)b * LK + (isctx ? L + t : t) : (size_t)r;
                bf16_t* dst = base + drow * pitch + hh * 64 + 8 * fq;
                f32x4 v[2][2];
#pragma unroll
                for (int bj = 0; bj < 2; ++bj)
#pragma unroll
                    for (int n = 0; n < 2; ++n) v[bj][n] = acc[ai][bj][m][n];
                if (kind == 0) {
                    float ss = 0.f;
#pragma unroll
                    for (int bj = 0; bj < 2; ++bj)
#pragma unroll
                        for (int n = 0; n < 2; ++n) ss += (v[bj][n].x * v[bj][n].x + v[bj][n].y * v[bj][n].y) + (v[bj][n].z * v[bj][n].z + v[bj][n].w * v[bj][n].w);
                    ss += __shfl_xor(ss, 16); ss += __shfl_xor(ss, 32);
                    const float rinv = rsqrtf(ss * (1.f / 64.f) + EPS);
#pragma unroll
                    for (int bj = 0; bj < 2; ++bj)
#pragma unroll
                        for (int n = 0; n < 2; ++n) v[bj][n] = v[bj][n] * rinv * nwv[bj][n];
                    if (!isctx) {
                        const float2* tr = tab + (t >> 6) * 16 + 4 * fq; const float2* tc = tab + (32 + (t & 63)) * 16 + 4 * fq;
#pragma unroll
                        for (int n = 0; n < 2; ++n) {
                            const f32x4 cr = *(const f32x4*)(tr + 2 * n), cc = *(const f32x4*)(tc + 2 * n);
                            f32x4 a = v[0][n], o;
                            o.x = a.x * cr.x - a.y * cr.y; o.y = a.x * cr.y + a.y * cr.x; o.z = a.z * cr.z - a.w * cr.w; o.w = a.z * cr.w + a.w * cr.z; v[0][n] = o;
                            a = v[1][n];
                            o.x = a.x * cc.x - a.y * cc.y; o.y = a.x * cc.y + a.y * cc.x; o.z = a.z * cc.z - a.w * cc.w; o.w = a.z * cc.w + a.w * cc.z; v[1][n] = o;
                        }
                    }
                } else if (kind == 2) {
#pragma unroll
                    for (int bj = 0; bj < 2; ++bj)
#pragma unroll
                        for (int n = 0; n < 2; ++n) v[bj][n] = v[bj][n] * 0.125f;
                } else if (kind == 3) {
#pragma unroll
                    for (int bj = 0; bj < 2; ++bj)
#pragma unroll
                        for (int n = 0; n < 2; ++n) { v[bj][n].x = siluf(v[bj][n].x); v[bj][n].y = siluf(v[bj][n].y); v[bj][n].z = siluf(v[bj][n].z); v[bj][n].w = siluf(v[bj][n].w); }
                }
#pragma unroll
                for (int bj = 0; bj < 2; ++bj) { u32x4 w; w.x = pg8::cvt_pk_bf16(v[bj][0].x, v[bj][0].y); w.y = pg8::cvt_pk_bf16(v[bj][0].z, v[bj][0].w);
                    w.z = pg8::cvt_pk_bf16(v[bj][1].x, v[bj][1].y); w.w = pg8::cvt_pk_bf16(v[bj][1].z, v[bj][1].w);
                    *(u32x4*)(dst + 32 * bj) = w; }
            }
    }
};
__device__ __forceinline__ void phase_p1(Ctx& F) {
    pg8::Gemm g{(const bf16_t*)(F.ws + WS_HB), (const bf16_t*)(F.ws + WS_WIN), TALL, INC, D};
    P1Order S{F.bx & 7, F.bx >> 3};
    EpiP1 E{F.ws, F.in[I_QNW], F.in[I_KNW]};
    pg8::gemm_phase<EpiP1, P1Order, true, true>(F.lds, g, S, E);
}

typedef short v4i16_t __attribute__((ext_vector_type(4)));
typedef __attribute__((address_space(3))) const char* ldsc_ptr;
__device__ __forceinline__ v4i16_t tr_read(ldsc_ptr p) { return __builtin_amdgcn_ds_read_tr16_b64_v4i16((__attribute__((address_space(3))) v4i16_t*)p); }
#define MFMA16(a, b, c) __builtin_amdgcn_mfma_f32_16x16x32_bf16(a, b, c, 0, 0, 0)
constexpr int TRS = 136;
__device__ __forceinline__ int rsw(int r, int ch) { return r * 128 + ((ch ^ (r & 7)) << 4); }
__device__ __forceinline__ float log2_sigmoid(float x) { return -log1pf(__expf(-x)) * 1.4426950408889634f; }
__device__ __forceinline__ bf16x8 tr_frag(ldsc_ptr tile, int rb0, int rb1, int c0, int lane) {
    const int q = (lane & 15) >> 2, p = lane & 3;
    const v4i16_t a = tr_read(tile + (rb0 + q) * TRS + (c0 + 4 * p) * 2);
    const v4i16_t b = tr_read(tile + (rb1 + q) * TRS + (c0 + 4 * p) * 2);
    return (bf16x8){a[0], a[1], a[2], a[3], b[0], b[1], b[2], b[3]};
}

__device__ __forceinline__ void phase_r1(Ctx& F) {
    const bf16_t* RKB = (const bf16_t*)(F.ws + WS_RKB); const bf16_t* RVB = (const bf16_t*)(F.ws + WS_RVB);
    float* CST = (float*)(F.ws + WS_CST);
    ldsc_ptr Vt = (ldsc_ptr)F.lds, Kf = Vt + 128 * TRS, Kb = Kf + 128 * TRS;
    const int lane = F.lane, w = F.wave, fr = lane & 15, fq = lane >> 4;
    for (int u = F.vcu; u < NB * RH * NCH; u += F.G) {
        const int c = u % NCH, h = (u / NCH) % RH, b = u / (NCH * RH);
        const float l2f = log2_sigmoid(F.in[I_DFW][h]), l2b = log2_sigmoid(F.in[I_DBW][h]);
        {
            const int s = F.tid >> 2, c16 = (F.tid & 3) * 16;
            const size_t g = ((size_t)b * LK + c * 128 + s) * 512 + h * 64 + c16;
            const u32x4 k0 = *(const u32x4*)(RKB + g), k1 = *(const u32x4*)(RKB + g + 8);
            const u32x4 v0 = *(const u32x4*)(RVB + g), v1 = *(const u32x4*)(RVB + g + 8);
            const float wf = exp2f(l2f * (float)(127 - s)), wb = exp2f(l2b * (float)s);
            LAS u32x2* pv = (LAS u32x2*)((LAS char*)F.lds + s * TRS + c16 * 2);
            pv[0] = (u32x2){v0.x, v0.y}; pv[1] = (u32x2){v0.z, v0.w}; pv[2] = (u32x2){v1.x, v1.y}; pv[3] = (u32x2){v1.z, v1.w};
            LAS u32x2* pf = (LAS u32x2*)((LAS char*)F.lds + 128 * TRS + s * TRS + c16 * 2);
            LAS u32x2* pb = (LAS u32x2*)((LAS char*)F.lds + 256 * TRS + s * TRS + c16 * 2);
            const unsigned kk[8] = {k0.x, k0.y, k0.z, k0.w, k1.x, k1.y, k1.z, k1.w};
#pragma unroll
            for (int i = 0; i < 4; ++i) {
                const float a0 = bflo(kk[2 * i]), a1 = bfhi(kk[2 * i]), a2 = bflo(kk[2 * i + 1]), a3 = bfhi(kk[2 * i + 1]);
                pf[i] = (u32x2){pk2(a0 * wf, a1 * wf), pk2(a2 * wf, a3 * wf)};
                pb[i] = (u32x2){pk2(a0 * wb, a1 * wb), pk2(a2 * wb, a3 * wb)};
            }
        }
        __syncthreads();
        const int dir = w >> 2, et = w & 3;
        ldsc_ptr Kt = dir ? Kb : Kf;
        f32x4 acc[4];
#pragma unroll
        for (int dt = 0; dt < 4; ++dt) acc[dt] = (f32x4){0.f, 0.f, 0.f, 0.f};
#pragma unroll
        for (int ks = 0; ks < 4; ++ks) {
            const int rb0 = 32 * ks + 8 * fq, rb1 = rb0 + 4;
            const bf16x8 a = tr_frag(Vt, rb0, rb1, 16 * et, lane);
#pragma unroll
            for (int dt = 0; dt < 4; ++dt) { const bf16x8 bb = tr_frag(Kt, rb0, rb1, 16 * dt, lane); acc[dt] = MFMA16(a, bb, acc[dt]); }
        }
        float* o = CST + ((((size_t)b * RH + h) * NCH + c) * 2 + dir) * 4096;
#pragma unroll
        for (int dt = 0; dt < 4; ++dt)
#pragma unroll
            for (int r = 0; r < 4; ++r) o[(16 * et + 4 * fq + r) * 64 + 16 * dt + fr] = acc[dt][r];
        __syncthreads();
    }
}

__device__ __forceinline__ void ret_unit(Ctx& F, int b, int h, int n) {
    const bf16_t* RKB = (const bf16_t*)(F.ws + WS_RKB); const bf16_t* RVB = (const bf16_t*)(F.ws + WS_RVB);
    const bf16_t* RQB = (const bf16_t*)(F.ws + WS_RQB); const bf16_t* RGB = (const bf16_t*)(F.ws + WS_RGB);
    const float* CST = (const float*)(F.ws + WS_CST); bf16_t* CAT = (bf16_t*)(F.ws + WS_CAT);
    LAS char* base = (LAS char*)F.lds;
    ldsc_ptr Qt = (ldsc_ptr)base, Kt = Qt + 16384, Vt = Kt + 16384, SfT = Vt + 128 * TRS, SbT = SfT + 8192;
    const int lane = F.lane, w = F.wave, fr = lane & 15, fq = lane >> 4;
    const float l2f = log2_sigmoid(F.in[I_DFW][h]), l2b = log2_sigmoid(F.in[I_DBW][h]);
    {
        const int s = F.tid >> 2, c2 = (F.tid & 3) * 2;
        const size_t gq = ((size_t)b * L + n * 128 + s) * 512 + h * 64 + c2 * 8;
        const size_t gk = ((size_t)b * LK + n * 128 + s) * 512 + h * 64 + c2 * 8;
        const u32x4 q0 = *(const u32x4*)(RQB + gq), q1 = *(const u32x4*)(RQB + gq + 8);
        const u32x4 k0 = *(const u32x4*)(RKB + gk), k1 = *(const u32x4*)(RKB + gk + 8);
        const u32x4 v0 = *(const u32x4*)(RVB + gk), v1 = *(const u32x4*)(RVB + gk + 8);
        *(LAS u32x4*)(base + rsw(s, c2)) = q0; *(LAS u32x4*)(base + rsw(s, c2 + 1)) = q1;
        *(LAS u32x4*)(base + 16384 + rsw(s, c2)) = k0; *(LAS u32x4*)(base + 16384 + rsw(s, c2 + 1)) = k1;
        LAS u32x2* pv = (LAS u32x2*)(base + 32768 + s * TRS + c2 * 16);
        pv[0] = (u32x2){v0.x, v0.y}; pv[1] = (u32x2){v0.z, v0.w}; pv[2] = (u32x2){v1.x, v1.y}; pv[3] = (u32x2){v1.z, v1.w};
        const int e = F.tid >> 3, ch = F.tid & 7;
        const float* cb = CST + (((size_t)b * RH + h) * NCH) * 2 * 4096 + e * 64 + ch * 8;
        const float gcf = exp2f(l2f * 128.f), gcb = exp2f(l2b * 128.f);
        f32x4 sf0 = {0.f, 0.f, 0.f, 0.f}, sf1 = sf0, sb0 = sf0, sb1 = sf0;
        for (int v = -2; v < n; ++v) { const int cc = v < 0 ? 18 + v : v; const float* p = cb + (size_t)(cc * 2 + 0) * 4096;
            sf0 = sf0 * gcf + *(const f32x4*)p; sf1 = sf1 * gcf + *(const f32x4*)(p + 4); }
        for (int v = 17; v > n; --v) { const float* p = cb + (size_t)(v * 2 + 1) * 4096;
            sb0 = sb0 * gcb + *(const f32x4*)p; sb1 = sb1 * gcb + *(const f32x4*)(p + 4); }
        *(LAS u32x4*)(base + 32768 + 128 * TRS + rsw(e, ch)) = (u32x4){pk2(sf0.x, sf0.y), pk2(sf0.z, sf0.w), pk2(sf1.x, sf1.y), pk2(sf1.z, sf1.w)};
        *(LAS u32x4*)(base + 32768 + 128 * TRS + 8192 + rsw(e, ch)) = (u32x4){pk2(sb0.x, sb0.y), pk2(sb0.z, sb0.w), pk2(sb1.x, sb1.y), pk2(sb1.z, sb1.w)};
    }
    __syncthreads();
    bf16x8 qf[2];
#pragma unroll
    for (int kk = 0; kk < 2; ++kk) qf[kk] = *(const LAS bf16x8*)(Qt + rsw(16 * w + fr, 4 * kk + fq));
    f32x4 sc[8];
#pragma unroll
    for (int nt = 0; nt < 8; ++nt) { sc[nt] = (f32x4){0.f, 0.f, 0.f, 0.f};
#pragma unroll
        for (int kk = 0; kk < 2; ++kk) { const bf16x8 kf = *(const LAS bf16x8*)(Kt + rsw(16 * nt + fr, 4 * kk + fq)); sc[nt] = MFMA16(kf, qf[kk], sc[nt]); } }
    const int cpos = 16 * w + fr;
#pragma unroll
    for (int nt = 0; nt < 8; ++nt)
#pragma unroll
        for (int r = 0; r < 4; ++r) { const int s = 16 * nt + 4 * fq + r; const int df = cpos - s;
            float wgt = 0.f; if (df >= 0) wgt += exp2f(l2f * (float)df); if (df <= 0) wgt += exp2f(l2b * (float)(-df));
            sc[nt][r] *= wgt; }
    f32x4 acc[4], af[4], ab[4];
#pragma unroll
    for (int et = 0; et < 4; ++et) { acc[et] = (f32x4){0.f, 0.f, 0.f, 0.f}; af[et] = acc[et]; ab[et] = acc[et]; }
#pragma unroll
    for (int kk = 0; kk < 4; ++kk) {
        u32x4 pw; pw.x = pk2(sc[2 * kk][0], sc[2 * kk][1]); pw.y = pk2(sc[2 * kk][2], sc[2 * kk][3]); pw.z = pk2(sc[2 * kk + 1][0], sc[2 * kk + 1][1]); pw.w = pk2(sc[2 * kk + 1][2], sc[2 * kk + 1][3]);
        const bf16x8 pb = __builtin_bit_cast(bf16x8, pw);
#pragma unroll
        for (int et = 0; et < 4; ++et) { const bf16x8 va = tr_frag(Vt, 32 * kk + 4 * fq, 32 * kk + 16 + 4 * fq, 16 * et, lane); acc[et] = MFMA16(va, pb, acc[et]); }
    }
#pragma unroll
    for (int et = 0; et < 4; ++et)
#pragma unroll
        for (int kk = 0; kk < 2; ++kk) {
            const bf16x8 sfa = *(const LAS bf16x8*)(SfT + rsw(16 * et + fr, 4 * kk + fq)); af[et] = MFMA16(sfa, qf[kk], af[et]);
            const bf16x8 sba = *(const LAS bf16x8*)(SbT + rsw(16 * et + fr, 4 * kk + fq)); ab[et] = MFMA16(sba, qf[kk], ab[et]);
        }
    const float xif = exp2f(l2f * (float)(cpos + 1)), xib = exp2f(l2b * (float)(128 - cpos));
    float ss = 0.f;
#pragma unroll
    for (int et = 0; et < 4; ++et) { acc[et] = acc[et] + af[et] * xif + ab[et] * xib; ss += (acc[et].x * acc[et].x + acc[et].y * acc[et].y) + (acc[et].z * acc[et].z + acc[et].w * acc[et].w); }
    ss += __shfl_xor(ss, 16); ss += __shfl_xor(ss, 32);
    const float rinv = rsqrtf(ss * (1.f / 64.f) + EPS);
    const size_t row = (size_t)b * L + n * 128 + cpos;
#pragma unroll
    for (int et = 0; et < 4; ++et) {
        const u32x2 gg = *(const u32x2*)(RGB + row * 512 + h * 64 + 16 * et + 4 * fq);
        const f32x4 y = acc[et] * rinv;
        u32x2 o; o.x = pk2(y.x * bflo(gg.x), y.y * bfhi(gg.x)); o.y = pk2(y.z * bflo(gg.y), y.w * bfhi(gg.y));
        *(u32x2*)(CAT + row * D + 512 + h * 64 + 16 * et + 4 * fq) = o;
    }
    __syncthreads();
}

__device__ __forceinline__ void phase_mix(Ctx& F) {
    for (int u = F.vcu; u < NB * AH * (L / 256); u += F.G) {
        const int pair = u >> 5, j = u & 31, b = pair >> 1, kvh = pair & 1, hq = kvh * 4 + (j >> 3), qb = j & 7;
        attn_body::attn_unit<8>(b, hq, kvh, qb, (const attn_body::bf16*)(F.ws + WS_QB), (const attn_body::bf16*)(F.ws + WS_KB), (const attn_body::bf16*)(F.ws + WS_VB),
                                (attn_body::bf16*)(F.ws + WS_CAT), (char*)F.lds);
    }
    __syncthreads();
    for (int u = F.vcu; u < NB * RH * (L / 128); u += F.G) { const int n = u & 15, h = (u >> 4) & 7, b = u >> 7; ret_unit(F, b, h, n); }
}

struct EpiX1 {
    static constexpr bool PERM = true, HEADPERM = false, AFTER_DRAIN = false;
    const float* x; const float* modv; float* x1;
    __device__ __forceinline__ void operator()(const f32x4 (&acc)[2][2][4][2], const pg8::Unit& u, int wr, int wc, int fr, int fq) const {
        const int col0 = u.pn * 256 + wc * 32 + 8 * fq;
#pragma unroll
        for (int ai = 0; ai < 2; ++ai)
#pragma unroll
            for (int m = 0; m < 4; ++m) {
                const int r = u.pm * 256 + ai * 128 + wr * 64 + m * 16 + fr; const int b = r >> 11;
                const float* g1 = modv + (size_t)b * (6 * D) + 2 * D;
#pragma unroll
                for (int bj = 0; bj < 2; ++bj)
#pragma unroll
                    for (int n = 0; n < 2; ++n) { const int c = col0 + bj * 128 + 4 * n; const size_t off = (size_t)r * D + c;
                        *(f32x4*)(x1 + off) = *(const f32x4*)(x + off) + *(const f32x4*)(g1 + c) * acc[ai][bj][m][n]; }
            }
    }
};
__device__ __forceinline__ void phase_p4(Ctx& F) {
    pg8::Gemm g{(const bf16_t*)(F.ws + WS_CAT), (const bf16_t*)(F.ws + WS_WOUT), T, D, D};
    pg8::StaticOrder S; S.init(T, D, F.G, F.bx);
    EpiX1 E{F.in[I_X], (const float*)(F.ws + WS_MODV), (float*)(F.ws + WS_X1)};
    pg8::gemm_phase<EpiX1, pg8::StaticOrder, true, true>(F.lds, g, S, E);
}

__device__ __forceinline__ void phase_p5(Ctx& F) {
    const float* modv = (const float*)(F.ws + WS_MODV); const float* X1 = (const float*)(F.ws + WS_X1);
    bf16_t* H2 = (bf16_t*)(F.ws + WS_H2B);
    const int gw = F.vcu * NWAVES + F.wave, NGW = F.G * NWAVES;
    f32x4 nw[4];
#pragma unroll
    for (int j = 0; j < 4; ++j) nw[j] = ((const f32x4*)F.in[I_N2W])[F.lane + 64 * j];
    for (int m = gw; m < T; m += NGW) {
        const f32x4* sh = (const f32x4*)(modv + (size_t)(m / L) * (6 * D) + 3 * D); const f32x4* sc = sh + D / 4;
        f32x4 v[4]; float s = 0.f;
#pragma unroll
        for (int j = 0; j < 4; ++j) { v[j] = ((const f32x4*)(X1 + (size_t)m * D))[F.lane + 64 * j]; s += (v[j].x * v[j].x + v[j].y * v[j].y) + (v[j].z * v[j].z + v[j].w * v[j].w); }
        const float rinv = rsqrtf(wave_sum(s) * (1.f / D) + EPS);
        unsigned long long* oh = (unsigned long long*)(H2 + (size_t)m * D) + F.lane; unsigned long long* ol = (unsigned long long*)(H2 + (size_t)(T + m) * D) + F.lane;
#pragma unroll
        for (int j = 0; j < 4; ++j) { const f32x4 a = sh[F.lane + 64 * j], b = sc[F.lane + 64 * j];
            const f32x4 o = v[j] * rinv * nw[j] * (1.f + b) + a;
            const unsigned h0 = pk2(o.x, o.y), h1 = pk2(o.z, o.w);
            oh[64 * j] = (unsigned long long)h0 | ((unsigned long long)h1 << 32);
            const unsigned l0 = pk2(o.x - bflo(h0), o.y - bfhi(h0)), l1 = pk2(o.z - bflo(h1), o.w - bfhi(h1));
            ol[64 * j] = (unsigned long long)l0 | ((unsigned long long)l1 << 32); }
    }
}

struct P6Order {
    int c, G;
    __device__ __forceinline__ bool next(int i, pg8::Unit& u) const {
        const int q = i * G + c; if (q >= 320) return false;
        const int t = q >> 6, m = q & 63;
        u.pm = (t == 1) ? 64 + m : m; u.pn = (t <= 1) ? 0 : t - 1; return true;
    }
    __device__ __forceinline__ void a_ready(const pg8::Unit&) const {}
    __device__ __forceinline__ void done(const pg8::Unit&) const {}
};
struct EpiP6 {
    static constexpr bool PERM = true, HEADPERM = false, AFTER_DRAIN = false;
    float* logp; bf16_t* acts;
    __device__ __forceinline__ void operator()(const f32x4 (&acc)[2][2][4][2], const pg8::Unit& u, int wr, int wc, int fr, int fq) const {
        if (u.pn < 2) {
            const int part = u.pn == 1 ? 2 : (u.pm >= 64 ? 1 : 0); const int pm = u.pm & 63;
            float* o = logp + (size_t)part * T * NE;
#pragma unroll
            for (int ai = 0; ai < 2; ++ai)
#pragma unroll
                for (int m = 0; m < 4; ++m) { const int r = pm * 256 + ai * 128 + wr * 64 + m * 16 + fr;
#pragma unroll
                    for (int bj = 0; bj < 2; ++bj)
#pragma unroll
                        for (int n = 0; n < 2; ++n) *(f32x4*)(o + (size_t)r * NE + bj * 128 + wc * 32 + 8 * fq + 4 * n) = acc[ai][bj][m][n]; }
        } else {
            const int f0 = (u.pn - 2) * 128 + wc * 32 + 8 * fq;
#pragma unroll
            for (int ai = 0; ai < 2; ++ai)
#pragma unroll
                for (int m = 0; m < 4; ++m) { const int r = u.pm * 256 + ai * 128 + wr * 64 + m * 16 + fr;
                    const f32x4 g0 = acc[ai][0][m][0], g1 = acc[ai][0][m][1], u0 = acc[ai][1][m][0], u1 = acc[ai][1][m][1];
                    u32x4 w; w.x = pg8::cvt_pk_bf16(siluf(g0.x) * u0.x, siluf(g0.y) * u0.y); w.y = pg8::cvt_pk_bf16(siluf(g0.z) * u0.z, siluf(g0.w) * u0.w);
                    w.z = pg8::cvt_pk_bf16(siluf(g1.x) * u1.x, siluf(g1.y) * u1.y); w.w = pg8::cvt_pk_bf16(siluf(g1.z) * u1.z, siluf(g1.w) * u1.w);
                    *(u32x4*)(acts + (size_t)r * FF + f0) = w; }
        }
    }
};
__device__ __forceinline__ void phase_p6(Ctx& F) {
    pg8::Gemm g{(const bf16_t*)(F.ws + WS_H2B), (const bf16_t*)(F.ws + WS_WR), 2 * T, 1024, D};
    P6Order S{F.vcu, F.G};
    EpiP6 E{(float*)(F.ws + WS_LOGP), (bf16_t*)(F.ws + WS_ACTS)};
    pg8::gemm_phase<EpiP6, P6Order, true, true>(F.lds, g, S, E);
}

__device__ __forceinline__ void phase_p7(Ctx& F) {
    const float* LOGP = (const float*)(F.ws + WS_LOGP); const float* rbias = F.in[I_RB];
    int* RIDX = (int*)(F.ws + WS_RIDX); float* RWT = (float*)(F.ws + WS_RWT);
    int* SDST = (int*)(F.ws + WS_SDST); float* SW = (float*)(F.ws + WS_SW);
    unsigned* ecnt = (unsigned*)(F.ws + WS_CTL) + CW_ECNT;
    const int gw = F.vcu * NWAVES + F.wave, NGW = F.G * NWAVES, lane = F.lane;
    const f32x4 bi = ((const f32x4*)rbias)[lane];
    for (int tok = gw; tok < T; tok += NGW) {
        const f32x4 lg = ((const f32x4*)(LOGP + (size_t)tok * NE))[lane] + ((const f32x4*)(LOGP + (size_t)(T + tok) * NE))[lane] + ((const f32x4*)(LOGP + (size_t)(2 * T + tok) * NE))[lane];
        const float s0 = sigmoidf_(lg.x), s1 = sigmoidf_(lg.y), s2 = sigmoidf_(lg.z), s3 = sigmoidf_(lg.w);
        float v0 = s0 + bi.x, v1 = s1 + bi.y, v2 = s2 + bi.z, v3 = s3 + bi.w;
        float gs = 0.f;
        {
            float a0 = v0, a1 = v1, a2 = v2, a3 = v3;
#pragma unroll
            for (int r = 0; r < 2; ++r) {
                float mv = a0; int mi = lane * 4;
                if (a1 > mv) { mv = a1; mi = lane * 4 + 1; }
                if (a2 > mv) { mv = a2; mi = lane * 4 + 2; }
                if (a3 > mv) { mv = a3; mi = lane * 4 + 3; }
#pragma unroll
                for (int o = 1; o < 8; o <<= 1) { const float ov = __shfl_xor(mv, o); const int oi = __shfl_xor(mi, o); if (ov > mv || (ov == mv && oi < mi)) { mv = ov; mi = oi; } }
                gs += mv;
                if (mi == lane * 4) a0 = -INFINITY; if (mi == lane * 4 + 1) a1 = -INFINITY; if (mi == lane * 4 + 2) a2 = -INFINITY; if (mi == lane * 4 + 3) a3 = -INFINITY;
            }
        }
        const int g = lane >> 3; int rank = 0;
#pragma unroll
        for (int g2 = 0; g2 < 8; ++g2) { const float o = __shfl(gs, g2 * 8); if (o > gs || (o == gs && g2 < g)) ++rank; }
        if (rank >= 4) { v0 = v1 = v2 = v3 = -INFINITY; }
        float wsum = 0.f, myw = 0.f; int myi = 0;
#pragma unroll
        for (int r = 0; r < TOPK; ++r) {
            float mv = v0; int mi = lane * 4;
            if (v1 > mv) { mv = v1; mi = lane * 4 + 1; }
            if (v2 > mv) { mv = v2; mi = lane * 4 + 2; }
            if (v3 > mv) { mv = v3; mi = lane * 4 + 3; }
#pragma unroll
            for (int o = 1; o < 64; o <<= 1) { const float ov = __shfl_xor(mv, o); const int oi = __shfl_xor(mi, o); if (ov > mv || (ov == mv && oi < mi)) { mv = ov; mi = oi; } }
            const int own = mi >> 2, sub = mi & 3;
            float sv = sub == 0 ? s0 : sub == 1 ? s1 : sub == 2 ? s2 : s3;
            sv = __shfl(sv, own);
            wsum += sv;
            if (lane == r) { myw = sv; myi = mi; }
            if (lane == own) { if (sub == 0) v0 = -INFINITY; if (sub == 1) v1 = -INFINITY; if (sub == 2) v2 = -INFINITY; if (sub == 3) v3 = -INFINITY; }
        }
        if (lane < TOPK) {
            const float wt = myw / wsum * 2.5f;
            RIDX[(size_t)tok * TOPK + lane] = myi; RWT[(size_t)tok * TOPK + lane] = wt;
            const unsigned pos = __hip_atomic_fetch_add(ecnt + myi, 1u, __ATOMIC_RELAXED, __HIP_MEMORY_SCOPE_AGENT);
            SDST[(size_t)myi * CAP + pos] = tok * TOPK + lane; SW[(size_t)myi * CAP + pos] = wt;
        }
    }
}

struct EpiSD {
    static constexpr bool PERM = true, HEADPERM = false, AFTER_DRAIN = false;
    const float* x1; const float* modv; float* out;
    __device__ __forceinline__ void operator()(const f32x4 (&acc)[2][2][4][2], const pg8::Unit& u, int wr, int wc, int fr, int fq) const {
        const int col0 = u.pn * 256 + wc * 32 + 8 * fq;
#pragma unroll
        for (int ai = 0; ai < 2; ++ai)
#pragma unroll
            for (int m = 0; m < 4; ++m) {
                const int r = u.pm * 256 + ai * 128 + wr * 64 + m * 16 + fr; const int b = r >> 11;
                const float* g2 = modv + (size_t)b * (6 * D) + 5 * D;
#pragma unroll
                for (int bj = 0; bj < 2; ++bj)
#pragma unroll
                    for (int n = 0; n < 2; ++n) { const int c = col0 + bj * 128 + 4 * n; const size_t off = (size_t)r * D + c;
                        *(f32x4*)(out + off) = *(const f32x4*)(x1 + off) + *(const f32x4*)(g2 + c) * acc[ai][bj][m][n]; }
            }
    }
};

constexpr int TAB_OFF = LDSCTL_OFF + 1024;
constexpr int MOE_BM = 224, MOE_MT = 7, MOE_ACT1 = 0, MOE_ACT0 = MOE_BM * 256, MOE_AST = 0, MOE_ASZ = MOE_BM * 64, MOE_BST = 2 * MOE_BM * 256;
static_assert(MOE_BST + 32768 <= LDSCTL_OFF && 2 * MOE_ASZ <= MOE_ACT0, "MoE LDS map");
__device__ __forceinline__ int sw64(int row, int ch) { return row * 64 + ((ch ^ ((row >> 1) & 3)) << 4); }

__device__ __forceinline__ void moe_unit(Ctx& F, int e, int row0, int nrows) {
    const bf16_t* H2 = (const bf16_t*)(F.ws + WS_H2B);
    const int* SDST = (const int*)(F.ws + WS_SDST) + (size_t)e * CAP + row0; const float* SW = (const float*)(F.ws + WS_SW) + (size_t)e * CAP + row0;
    bf16_t* YEXP = (bf16_t*)(F.ws + WS_YEXP);
    const float* Wg = F.in[I_EWG] + (size_t)e * D * FF; const float* Wu = F.in[I_EWU] + (size_t)e * D * FF; const float* Wd = F.in[I_EWD] + (size_t)e * FF * D;
    LAS char* lds = (LAS char*)F.lds;
    int tid = F.tid; asm volatile("" : "+v"(tid));
    const int lane = tid & 63, w = __builtin_amdgcn_readfirstlane(tid >> 6), wr = w >> 2, wc = w & 3, fr = lane & 15, fq = lane >> 4;
    const int mc = (nrows + 31) >> 5;
    const char* H2c = (const char*)H2;
    unsigned asrc0, asrc1; int aw0, aw1;
    { const int r0 = tid >> 2, r1 = (tid + 512) >> 2, ch = tid & 3;
      asrc0 = (unsigned)(((SDST[r0 < nrows ? r0 : 0] >> 3) * D + ch * 8) * 2); asrc1 = (unsigned)(((SDST[(r1 < nrows) ? r1 : 0] >> 3) * D + ch * 8) * 2);
      aw0 = MOE_AST + sw64(r0, ch); aw1 = MOE_AST + sw64(r1 < MOE_BM ? r1 : 0, ch); }
    const bool a2 = tid < 4 * MOE_BM - 512;
    const int bch = w >> 1, bhalf = (w & 1) * 8;
    int pb_gu; { const int ffl = 4 * (lane & 31); pb_gu = 64 * (ffl >> 5) + 32 * (lane >> 5) + (ffl & 31); }
    const int pb_d = 4 * lane;
    const int bw_gu = MOE_BST + pb_gu * 64 + bhalf + ((bch ^ ((pb_gu >> 1) & 3)) << 4), bw_gu2 = MOE_BST + pb_gu * 64 + bhalf + ((bch ^ ((pb_gu >> 1) & 3) ^ 1) << 4);
    const int bw_d = MOE_BST + pb_d * 64 + bhalf + ((bch ^ ((pb_d >> 1) & 3)) << 4), bw_d2 = MOE_BST + pb_d * 64 + bhalf + ((bch ^ ((pb_d >> 1) & 3) ^ 1) << 4);
    const int fsw = ((fq ^ ((fr >> 1) & 3)) << 4);
    const int trow = wr * 16 * mc + fr;
    const int ab = MOE_AST + trow * 64 + fsw;
    const int bb = MOE_BST + (64 * wc + fr) * 64 + fsw;
    f32x4 acc[MOE_MT][4];
    u32x4 ar0a, ar0b, ar1a, ar1b; f32x4 br0[4], br1[4];
#define MOE_ZERO() do { _Pragma("unroll") for (int m = 0; m < MOE_MT; ++m) _Pragma("unroll") for (int n = 0; n < 4; ++n) acc[m][n] = (f32x4){0.f, 0.f, 0.f, 0.f}; } while (0)
#define MOE_MMA(AFR, m) do { _Pragma("unroll") for (int n = 0; n < 4; ++n) acc[m][n] = MFMA16(bfr[n], AFR, acc[m][n]); } while (0)
#define MOE_LDB(BUF) bf16x8 bfr[4]; _Pragma("unroll") for (int n = 0; n < 4; ++n) bfr[n] = *(const LAS bf16x8*)(lds + bb + ((BUF) * 16384 + n * 1024))
#define MOE_BWRITE(BUF, R, o0, o2) do { \
        _Pragma("unroll") for (int i = 0; i < 4; ++i) { u32x2 c; c.x = pg8::cvt_pk_bf16(R[0][i], R[1][i]); c.y = pg8::cvt_pk_bf16(R[2][i], R[3][i]); \
            *(LAS u32x2*)(lds + ((i < 2) ? (o0) : (o2)) + ((BUF) * 16384 + i * 64)) = c; } } while (0)
    {
        const float* bsrc = (lane >> 5 ? Wu : Wg) + (size_t)(4 * w) * FF + 4 * (lane & 31);
#define GU_LOAD(s, RA, RB, RBR) do { const int kk_ = (s) & 31, nt_ = (s) >> 5; \
        RA = *(const u32x4*)(H2c + (size_t)(asrc0 + (unsigned)(kk_ * 64))); RB = *(const u32x4*)(H2c + (size_t)(asrc1 + (unsigned)(kk_ * 64))); \
        const float* bp_ = bsrc + (size_t)(kk_ * 32) * FF + nt_ * 128; \
        _Pragma("unroll") for (int j = 0; j < 4; ++j) RBR[j] = *(const f32x4*)(bp_ + (size_t)j * FF); } while (0)
#define GU_AWRITE(BUF, RA, RB) do { *(LAS u32x4*)(lds + aw0 + (BUF) * MOE_ASZ) = RA; if (a2) *(LAS u32x4*)(lds + aw1 + (BUF) * MOE_ASZ) = RB; } while (0)
#define GU_COMPUTE(BUF) do { MOE_LDB(BUF); \
        _Pragma("unroll") for (int m = 0; m < MOE_MT; ++m) if (m < mc) { const bf16x8 afr = *(const LAS bf16x8*)(lds + ab + ((BUF) * MOE_ASZ + m * 1024)); MOE_MMA(afr, m); } } while (0)
#define GU_EPI(nt) do { \
        _Pragma("unroll") for (int m = 0; m < MOE_MT; ++m) if (m < mc) { const int tr = trow + 16 * m; \
            const float wsl_ = SWl[trow + 16 * m]; \
            _Pragma("unroll") for (int n = 0; n < 2; ++n) { const f32x4 g = acc[m][n], u = acc[m][n + 2]; \
                u32x2 o; o.x = pg8::cvt_pk_bf16(siluf(g.x) * u.x * wsl_, siluf(g.y) * u.y * wsl_); o.y = pg8::cvt_pk_bf16(siluf(g.z) * u.z * wsl_, siluf(g.w) * u.w * wsl_); \
                const int c = 4 * wc + 2 * n + (fq >> 1); \
                *(LAS u32x2*)(lds + ((nt) ? MOE_ACT1 : MOE_ACT0) + tr * 256 + ((c ^ (tr & 15)) << 4) + (fq & 1) * 8) = o; } } \
        MOE_ZERO(); } while (0)
        LAS float* SWl = (LAS float*)(F.lds + TAB_OFF + 4096);
        if (tid < MOE_BM) SWl[tid] = tid < nrows ? SW[tid] : 0.f;
        MOE_ZERO();
        GU_LOAD(0, ar0a, ar0b, br0); GU_LOAD(1, ar1a, ar1b, br1);
        GU_AWRITE(0, ar0a, ar0b); MOE_BWRITE(0, br0, bw_gu, bw_gu2);
        __syncthreads();
#pragma unroll 1
        for (int nt = 0; nt < 2; ++nt) {
#pragma unroll 1
            for (int s = 32 * nt; s < 32 * nt + 32; s += 2) {
                { const int sl = min(s + 2, 63); GU_LOAD(sl, ar0a, ar0b, br0); }
                GU_COMPUTE(0);
                GU_AWRITE(1, ar1a, ar1b); MOE_BWRITE(1, br1, bw_gu, bw_gu2);
                __syncthreads();
                { const int sl = min(s + 3, 63); GU_LOAD(sl, ar1a, ar1b, br1); }
                GU_COMPUTE(1);
                GU_AWRITE(0, ar0a, ar0b); MOE_BWRITE(0, br0, bw_gu, bw_gu2);
                __syncthreads();
            }
            if (nt == 0) { GU_EPI(0); } else { GU_EPI(1); }
        }
#undef GU_LOAD
#undef GU_AWRITE
#undef GU_COMPUTE
#undef GU_EPI
    }
    {
        const float* bsrc = Wd + (size_t)(4 * w) * D + 4 * lane;
#define DN_LOAD(s, RBR) do { const int kk_ = (s) & 7, nt_ = (s) >> 3; const float* bp_ = bsrc + (size_t)(kk_ * 32) * D + nt_ * 256; \
        _Pragma("unroll") for (int j = 0; j < 4; ++j) RBR[j] = *(const f32x4*)(bp_ + (size_t)j * D); } while (0)
#define DN_COMPUTE(BUF, s) do { MOE_LDB(BUF); const int kk_ = (s) & 7; const int abase_ = ((kk_ >> 2) ? MOE_ACT1 : MOE_ACT0) + (((4 * (kk_ & 3) + fq) ^ fr) << 4) + trow * 256; \
        _Pragma("unroll") for (int m = 0; m < MOE_MT; ++m) if (m < mc) { const bf16x8 afr = *(const LAS bf16x8*)(lds + abase_ + m * 4096); MOE_MMA(afr, m); } } while (0)
#define DN_EPI(nt) do { \
        _Pragma("unroll") for (int m = 0; m < MOE_MT; ++m) if (m < mc) { const int d_ = DSTl[trow + 16 * m]; if (d_ >= 0) { \
            _Pragma("unroll") for (int n = 0; n < 4; ++n) { const f32x4 v = acc[m][n]; u32x2 o; o.x = pg8::cvt_pk_bf16(v.x, v.y); o.y = pg8::cvt_pk_bf16(v.z, v.w); \
                *(u32x2*)(YEXP + (size_t)d_ * D + (nt) * 256 + 64 * wc + 16 * n + 4 * fq) = o; } } } \
        MOE_ZERO(); } while (0)
        LAS int* DSTl = (LAS int*)(F.lds + TAB_OFF + 4096 + 1024);
        if (tid < MOE_BM) DSTl[tid] = tid < nrows ? SDST[tid] : -1;
        DN_LOAD(0, br0); DN_LOAD(1, br1);
        __syncthreads();
        MOE_BWRITE(0, br0, bw_d, bw_d2);
        __syncthreads();
#pragma unroll 1
        for (int nt = 0; nt < 4; ++nt) {
#pragma unroll 1
            for (int s = 8 * nt; s < 8 * nt + 8; s += 2) {
                { const int sl = min(s + 2, 31); DN_LOAD(sl, br0); }
                DN_COMPUTE(0, s);
                MOE_BWRITE(1, br1, bw_d, bw_d2);
                __syncthreads();
                { const int sl = min(s + 3, 31); DN_LOAD(sl, br1); }
                DN_COMPUTE(1, s + 1);
                MOE_BWRITE(0, br0, bw_d, bw_d2);
                __syncthreads();
            }
            DN_EPI(nt);
        }
#undef DN_LOAD
#undef DN_COMPUTE
#undef DN_EPI
    }
#undef MOE_ZERO
#undef MOE_MMA
#undef MOE_LDB
#undef MOE_BWRITE
}

__device__ __forceinline__ void phase_moe(Ctx& F) {
    {
        pg8::Gemm g{(const bf16_t*)(F.ws + WS_ACTS), (const bf16_t*)(F.ws + WS_WSD), T, D, FF};
        pg8::StaticOrder S; S.init(T, D, F.G, F.bx);
        EpiSD E{(const float*)(F.ws + WS_X1), (const float*)(F.ws + WS_MODV), F.out};
        pg8::gemm_phase<EpiSD, pg8::StaticOrder, true, true>(F.lds, g, S, E);
    }
    __syncthreads();
    LAS int* cnt = (LAS int*)(F.lds + TAB_OFF); LAS int* pstart = cnt + 256; LAS int* tstart = pstart + 257;
    const unsigned* ecnt = (const unsigned*)(F.ws + WS_CTL) + CW_ECNT;
    if (F.tid < NE) cnt[F.tid] = (int)__hip_atomic_load(ecnt + F.tid, __ATOMIC_RELAXED, __HIP_MEMORY_SCOPE_AGENT);
    __syncthreads();
    if (F.tid == 0) { int a = 0, t = 0; for (int e = 0; e < NE; ++e) { pstart[e] = a; tstart[e] = t; a += cnt[e]; t += (cnt[e] + MOE_BM - 1) / MOE_BM; } pstart[NE] = a; tstart[NE] = t; }
    __syncthreads();
    const int ntot = tstart[NE];
    for (int u = F.vcu; u < ntot; u += F.G) {
        int lo = 0, hi = NE;
        while (hi - lo > 1) { const int mid = (lo + hi) >> 1; if (tstart[mid] <= u) lo = mid; else hi = mid; }
        const int e = lo, c = cnt[e], nt = (c + MOE_BM - 1) / MOE_BM, mt = u - tstart[e];
        const int rpt = (c + nt - 1) / nt, row0 = mt * rpt, nrows = min(rpt, c - row0);
        if (nrows > 0) moe_unit(F, e, row0, nrows);
    }
}

__device__ __forceinline__ void phase_final(Ctx& F) {
    const float* modv = (const float*)(F.ws + WS_MODV); const bf16_t* YEXP = (const bf16_t*)(F.ws + WS_YEXP);
    const int gw = F.vcu * NWAVES + F.wave, NGW = F.G * NWAVES;
    for (int m = gw; m < T; m += NGW) {
        const float* g2 = modv + (size_t)(m / L) * (6 * D) + 5 * D;
#pragma unroll
        for (int j = 0; j < 2; ++j) {
            const int c = 8 * (F.lane + 64 * j);
            f32x4 s0 = {0.f, 0.f, 0.f, 0.f}, s1 = s0;
#pragma unroll
            for (int k = 0; k < TOPK; ++k) { const u32x4 y = *(const u32x4*)(YEXP + ((size_t)m * TOPK + k) * D + c);
                s0.x += bflo(y.x); s0.y += bfhi(y.x); s0.z += bflo(y.y); s0.w += bfhi(y.y); s1.x += bflo(y.z); s1.y += bfhi(y.z); s1.z += bflo(y.w); s1.w += bfhi(y.w); }
            float* o = F.out + (size_t)m * D + c;
            *(f32x4*)o = *(const f32x4*)o + *(const f32x4*)(g2 + c) * s0; *(f32x4*)(o + 4) = *(const f32x4*)(o + 4) + *(const f32x4*)(g2 + c + 4) * s1;
        }
    }
}
#if DBG
constexpr int GBLK = 64;
constexpr int NSLOT_G = NASSIGN + NE * GBLK;
constexpr int NBLK_G = NSLOT_G / GBLK;
__global__ void __launch_bounds__(256) g_mod(const float* __restrict__ c, const float* __restrict__ cctx, const float* __restrict__ Wm,
                                             const float* __restrict__ bm, float* __restrict__ modv) {
    const int col = blockIdx.x * 256 + threadIdx.x, r = blockIdx.y;
    const float* cv = (r < NB) ? c + (size_t)r * D : cctx;
    float acc = 0.f;
    for (int k = 0; k < D; ++k) acc += siluf(cv[k]) * Wm[(size_t)k * (6 * D) + col];
    modv[(size_t)r * (6 * D) + col] = acc + bm[col];
}

__global__ void __launch_bounds__(256) g_norm_mod(const float* __restrict__ x, const float* __restrict__ w, const float* __restrict__ modv,
                                                  int shift_off, int scale_off, int rows_per_b, int fixed_r, float* __restrict__ out) {
    __shared__ float red[4];
    const int row = blockIdx.x, tid = threadIdx.x;
    const float4 v = ((const float4*)(x + (size_t)row * D))[tid];
    float s = v.x * v.x + v.y * v.y + v.z * v.z + v.w * v.w;
    for (int o = 32; o > 0; o >>= 1) s += __shfl_xor(s, o);
    if ((tid & 63) == 0) red[tid >> 6] = s;
    __syncthreads();
    s = red[0] + red[1] + red[2] + red[3];
    const float rinv = rsqrtf(s * (1.f / D) + EPS);
    const int r = fixed_r >= 0 ? fixed_r : row / rows_per_b;
    const float* mv = modv + (size_t)r * (6 * D);
    const float4 ww = ((const float4*)w)[tid], sh = ((const float4*)(mv + shift_off))[tid], sc = ((const float4*)(mv + scale_off))[tid];
    float4 o;
    o.x = v.x * rinv * ww.x * (1.f + sc.x) + sh.x; o.y = v.y * rinv * ww.y * (1.f + sc.y) + sh.y;
    o.z = v.z * rinv * ww.z * (1.f + sc.z) + sh.z; o.w = v.w * rinv * ww.w * (1.f + sc.w) + sh.w;
    ((float4*)(out + (size_t)row * D))[tid] = o;
}

template <int MODE>
__global__ void __launch_bounds__(256) g_sgemm(const float* __restrict__ A, int lda, const float* __restrict__ B, int ldb, size_t bstride,
                                               float* __restrict__ C, int ldc, int K, const int* __restrict__ slot_tok,
                                               const float* __restrict__ slot_w, const int* __restrict__ blk_e, int ntok) {
    __shared__ float As[16][68];
    __shared__ float Bs[16][68];
    const int bm = blockIdx.y * 64, bn = blockIdx.x * 64, tid = threadIdx.x;
    const float* Bp = B;
    if (MODE == 1 || MODE == 2) { const int e = blk_e[blockIdx.y]; if (e < 0) return; Bp += (size_t)e * bstride; }
    const int tx = tid & 15, ty = tid >> 4;
    float acc[4][4];
#pragma unroll
    for (int i = 0; i < 4; ++i)
#pragma unroll
        for (int j = 0; j < 4; ++j) acc[i][j] = 0.f;
    const int arow = tid >> 2, ak = (tid & 3) * 4;
    bool avalid = true; const float* aptr;
    if (MODE == 1) { const int tok = slot_tok[bm + arow]; avalid = tok < ntok; aptr = A + (size_t)(avalid ? tok : 0) * lda; }
    else aptr = A + (size_t)(bm + arow) * lda;
    const int bk = tid >> 4, bnn = (tid & 15) * 4;
    for (int k0 = 0; k0 < K; k0 += 16) {
        float4 av = make_float4(0.f, 0.f, 0.f, 0.f);
        if (avalid) av = *(const float4*)(aptr + k0 + ak);
        const float4 bv = *(const float4*)(Bp + (size_t)(k0 + bk) * ldb + bn + bnn);
        As[ak + 0][arow] = av.x; As[ak + 1][arow] = av.y; As[ak + 2][arow] = av.z; As[ak + 3][arow] = av.w;
        *(float4*)&Bs[bk][bnn] = bv;
        __syncthreads();
#pragma unroll
        for (int kk = 0; kk < 16; ++kk) {
            const float4 a = *(const float4*)&As[kk][ty * 4];
            const float4 b = *(const float4*)&Bs[kk][tx * 4];
            acc[0][0] += a.x * b.x; acc[0][1] += a.x * b.y; acc[0][2] += a.x * b.z; acc[0][3] += a.x * b.w;
            acc[1][0] += a.y * b.x; acc[1][1] += a.y * b.y; acc[1][2] += a.y * b.z; acc[1][3] += a.y * b.w;
            acc[2][0] += a.z * b.x; acc[2][1] += a.z * b.y; acc[2][2] += a.z * b.z; acc[2][3] += a.z * b.w;
            acc[3][0] += a.w * b.x; acc[3][1] += a.w * b.y; acc[3][2] += a.w * b.z; acc[3][3] += a.w * b.w;
        }
        __syncthreads();
    }
#pragma unroll
    for (int i = 0; i < 4; ++i) {
        const int r = bm + ty * 4 + i;
        if (MODE == 2) {
            const int tok = slot_tok[r];
            if (tok < ntok) {
                const float w = slot_w[r];
#pragma unroll
                for (int j = 0; j < 4; ++j) atomicAdd(C + (size_t)tok * ldc + bn + tx * 4 + j, w * acc[i][j]);
            }
        } else if (MODE == 3) {
            float4* cp = (float4*)(C + (size_t)r * ldc + bn + tx * 4); const float4 o = *cp;
            *cp = make_float4(o.x + acc[i][0], o.y + acc[i][1], o.z + acc[i][2], o.w + acc[i][3]);
        } else {
            *(float4*)(C + (size_t)r * ldc + bn + tx * 4) = make_float4(acc[i][0], acc[i][1], acc[i][2], acc[i][3]);
        }
    }
}

__global__ void __launch_bounds__(256) g_qk_prep(const float* __restrict__ Z, const float* __restrict__ ZC, const float* __restrict__ qw,
                                                 const float* __restrict__ kw, float* __restrict__ AQ, float* __restrict__ AK, float* __restrict__ AV) {
    const int gid = blockIdx.x * 256 + threadIdx.x;
    const int NLAT = T * 12;
    const float* src; float* dst; const float* nw = nullptr; bool rope = false; int pos = 0;
    if (gid < NLAT) {
        const int row = gid / 12, it = gid % 12, b = row / L, t = row % L; pos = t;
        if (it < 8) { src = Z + (size_t)row * INC + OFF_AQ + it * 64; dst = AQ + (size_t)row * 512 + it * 64; nw = qw; rope = true; }
        else if (it < 10) { src = Z + (size_t)row * INC + OFF_AK + (it - 8) * 64; dst = AK + ((size_t)b * LK + t) * 128 + (it - 8) * 64; nw = kw; rope = true; }
        else { src = Z + (size_t)row * INC + OFF_AV + (it - 10) * 64; dst = AV + ((size_t)b * LK + t) * 128 + (it - 10) * 64; }
    } else {
        const int g2 = gid - NLAT; if (g2 >= TC * 4) return;
        const int row = g2 / 4, it = g2 % 4, b = row / LC, t = row % LC;
        if (it < 2) { src = ZC + (size_t)row * CTXC + OFF_AK + it * 64; dst = AK + ((size_t)b * LK + L + t) * 128 + it * 64; nw = kw; }
        else { src = ZC + (size_t)row * CTXC + OFF_AV + (it - 2) * 64; dst = AV + ((size_t)b * LK + L + t) * 128 + (it - 2) * 64; }
    }
    if (!nw) { for (int d = 0; d < 64; ++d) dst[d] = src[d]; return; }
    float s = 0.f;
    for (int d = 0; d < 64; ++d) s += src[d] * src[d];
    const float rinv = rsqrtf(s * (1.f / 64.f) + EPS);
    const float fr = (float)(pos / 64), fc = (float)(pos % 64);
    for (int i = 0; i < 32; ++i) {
        float a = src[2 * i] * rinv * nw[2 * i], bb = src[2 * i + 1] * rinv * nw[2 * i + 1];
        if (rope) {
            const float freq = powf(10000.f, -(float)(i & 15) / 16.f);
            const float ang = (i < 16 ? fr : fc) * freq;
            const float cs = cosf(ang), sn = sinf(ang);
            const float oa = a * cs - bb * sn, ob = a * sn + bb * cs; a = oa; bb = ob;
        }
        dst[2 * i] = a; dst[2 * i + 1] = bb;
    }
}

__global__ void __launch_bounds__(256) g_attn(const float* __restrict__ AQ, const float* __restrict__ AK, const float* __restrict__ AV, float* __restrict__ CAT) {
    const int gid = blockIdx.x * 256 + threadIdx.x;
    const int part = gid & 3, qi = gid >> 2;
    const int t = qi % L, hq = (qi / L) % AH, b = qi / (L * AH), kvh = hq / 4;
    const size_t row = (size_t)b * L + t;
    float q[16], acc[16];
#pragma unroll
    for (int d = 0; d < 16; ++d) { q[d] = AQ[row * 512 + hq * 64 + part * 16 + d] * 0.125f; acc[d] = 0.f; }
    float m = -1e30f, l = 0.f;
    const float* kp = AK + (size_t)b * LK * 128 + kvh * 64 + part * 16;
    const float* vp = AV + (size_t)b * LK * 128 + kvh * 64 + part * 16;
    for (int j = 0; j < LK; ++j) {
        float s = 0.f;
#pragma unroll
        for (int d = 0; d < 16; ++d) s += q[d] * kp[(size_t)j * 128 + d];
        s += __shfl_xor(s, 1); s += __shfl_xor(s, 2);
        const float mn = fmaxf(m, s), corr = __expf(m - mn), p = __expf(s - mn);
        l = l * corr + p; m = mn;
#pragma unroll
        for (int d = 0; d < 16; ++d) acc[d] = acc[d] * corr + p * vp[(size_t)j * 128 + d];
    }
    const float il = 1.f / l;
#pragma unroll
    for (int d = 0; d < 16; ++d) CAT[row * D + hq * 64 + part * 16 + d] = acc[d] * il;
}

__global__ void __launch_bounds__(256) g_ret(const float* __restrict__ Z, const float* __restrict__ ZC, const float* __restrict__ dfw,
                                             const float* __restrict__ dbw, float* __restrict__ CAT) {
    const int gid = blockIdx.x * 256 + threadIdx.x;
    const int part = gid & 3, qi = gid >> 2;
    const int t = qi % L, h = (qi / L) % RH, b = qi / (L * RH);
    const size_t row = (size_t)b * L + t;
    const float l2f = -log1pf(__expf(-dfw[h])) * 1.4426950408889634f, l2b = -log1pf(__expf(-dbw[h])) * 1.4426950408889634f;
    float q[16], acc[16];
#pragma unroll
    for (int d = 0; d < 16; ++d) { q[d] = Z[row * INC + OFF_RQ + h * 64 + part * 16 + d] * 0.125f; acc[d] = 0.f; }
    const float* kp = Z + (size_t)b * L * INC + OFF_RK + h * 64 + part * 16;
    const float* vp = Z + (size_t)b * L * INC + OFF_RV + h * 64 + part * 16;
    for (int j = 0; j < L; ++j) {
        float s = 0.f;
#pragma unroll
        for (int d = 0; d < 16; ++d) s += q[d] * kp[(size_t)j * INC + d];
        s += __shfl_xor(s, 1); s += __shfl_xor(s, 2);
        const int df = t - j;
        float w = 0.f;
        if (df >= 0) w += exp2f((float)df * l2f);
        if (df <= 0) w += exp2f((float)(-df) * l2b);
        const float p = s * w;
#pragma unroll
        for (int d = 0; d < 16; ++d) acc[d] += p * vp[(size_t)j * INC + d];
    }
    const float* kc = ZC + (size_t)b * LC * CTXC + OFF_RK + h * 64 + part * 16;
    const float* vc = ZC + (size_t)b * LC * CTXC + OFF_RV + h * 64 + part * 16;
    for (int j = 0; j < LC; ++j) {
        float s = 0.f;
#pragma unroll
        for (int d = 0; d < 16; ++d) s += q[d] * kc[(size_t)j * CTXC + d];
        s += __shfl_xor(s, 1); s += __shfl_xor(s, 2);
        const float w = exp2f((float)(t + LC - j) * l2f) + exp2f((float)(L - t + j) * l2b);
        const float p = s * w;
#pragma unroll
        for (int d = 0; d < 16; ++d) acc[d] += p * vc[(size_t)j * CTXC + d];
    }
    float ss = 0.f;
#pragma unroll
    for (int d = 0; d < 16; ++d) ss += acc[d] * acc[d];
    ss += __shfl_xor(ss, 1); ss += __shfl_xor(ss, 2);
    const float rinv = rsqrtf(ss * (1.f / 64.f) + EPS);
#pragma unroll
    for (int d = 0; d < 16; ++d) {
        const float g = Z[row * INC + OFF_RG + h * 64 + part * 16 + d];
        CAT[row * D + 512 + h * 64 + part * 16 + d] = acc[d] * rinv * siluf(g);
    }
}

__global__ void __launch_bounds__(256) g_resid(const float* __restrict__ x, const float* __restrict__ y, const float* __restrict__ y2,
                                               const float* __restrict__ modv, int goff, float* __restrict__ out) {
    const size_t i = (size_t)blockIdx.x * 256 + threadIdx.x;
    const size_t e = i * 4; const int col = (int)(e % D), b = (int)(e / ((size_t)L * D));
    const float4 xv = ((const float4*)x)[i]; float4 yv = ((const float4*)y)[i];
    if (y2) { const float4 z = ((const float4*)y2)[i]; yv.x += z.x; yv.y += z.y; yv.z += z.z; yv.w += z.w; }
    const float4 g = *(const float4*)(modv + (size_t)b * (6 * D) + goff + col);
    ((float4*)out)[i] = make_float4(xv.x + g.x * yv.x, xv.y + g.y * yv.y, xv.z + g.z * yv.z, xv.w + g.w * yv.w);
}

__global__ void __launch_bounds__(256) g_route(const float* __restrict__ logits, const float* __restrict__ rbias, int* __restrict__ idx, float* __restrict__ wout) {
    const int tok = blockIdx.x * 4 + (threadIdx.x >> 6), lane = threadIdx.x & 63;
    const float4 lg = ((const float4*)(logits + (size_t)tok * NE))[lane];
    const float4 bi = ((const float4*)rbias)[lane];
    float s0 = sigmoidf_(lg.x), s1 = sigmoidf_(lg.y), s2 = sigmoidf_(lg.z), s3 = sigmoidf_(lg.w);
    float v0 = s0 + bi.x, v1 = s1 + bi.y, v2 = s2 + bi.z, v3 = s3 + bi.w;
    float gs = 0.f;
    {
        float a0 = v0, a1 = v1, a2 = v2, a3 = v3;
        for (int r = 0; r < 2; ++r) {
            float mv = a0; int mi = lane * 4;
            if (a1 > mv) { mv = a1; mi = lane * 4 + 1; }
            if (a2 > mv) { mv = a2; mi = lane * 4 + 2; }
            if (a3 > mv) { mv = a3; mi = lane * 4 + 3; }
            for (int o = 1; o < 8; o <<= 1) {
                const float ov = __shfl_xor(mv, o); const int oi = __shfl_xor(mi, o);
                if (ov > mv || (ov == mv && oi < mi)) { mv = ov; mi = oi; }
            }
            gs += mv;
            if (mi == lane * 4) a0 = -INFINITY; if (mi == lane * 4 + 1) a1 = -INFINITY;
            if (mi == lane * 4 + 2) a2 = -INFINITY; if (mi == lane * 4 + 3) a3 = -INFINITY;
        }
    }
    const int g = lane >> 3; int rank = 0;
    for (int g2 = 0; g2 < 8; ++g2) { const float o = __shfl(gs, g2 * 8); if (o > gs || (o == gs && g2 < g)) ++rank; }
    if (rank >= 4) { v0 = v1 = v2 = v3 = -INFINITY; }
    float wsum = 0.f, myw = 0.f; int myi = 0;
    for (int r = 0; r < TOPK; ++r) {
        float mv = v0; int mi = lane * 4;
        if (v1 > mv) { mv = v1; mi = lane * 4 + 1; }
        if (v2 > mv) { mv = v2; mi = lane * 4 + 2; }
        if (v3 > mv) { mv = v3; mi = lane * 4 + 3; }
        for (int o = 1; o < 64; o <<= 1) {
            const float ov = __shfl_xor(mv, o); const int oi = __shfl_xor(mi, o);
            if (ov > mv || (ov == mv && oi < mi)) { mv = ov; mi = oi; }
        }
        const int own = mi >> 2, sub = mi & 3;
        float sv = sub == 0 ? s0 : sub == 1 ? s1 : sub == 2 ? s2 : s3;
        sv = __shfl(sv, own);
        wsum += sv;
        if (lane == r) { myw = sv; myi = mi; }
        if (lane == own) { if (sub == 0) v0 = -INFINITY; if (sub == 1) v1 = -INFINITY; if (sub == 2) v2 = -INFINITY; if (sub == 3) v3 = -INFINITY; }
    }
    if (lane < TOPK) { idx[(size_t)tok * TOPK + lane] = myi; wout[(size_t)tok * TOPK + lane] = myw / wsum * 2.5f; }
}

__global__ void __launch_bounds__(256) g_count(const int* __restrict__ idx, int* __restrict__ cnt) {
    const int i = blockIdx.x * 256 + threadIdx.x; atomicAdd(&cnt[idx[i]], 1);
}
__global__ void __launch_bounds__(256) g_offsets(const int* __restrict__ cnt, int* __restrict__ pstart, int* __restrict__ blk_e) {
    __shared__ int ps[NE + 1];
    if (threadIdx.x == 0) { int a = 0; for (int e = 0; e < NE; ++e) { ps[e] = a; a += (cnt[e] + GBLK - 1) / GBLK * GBLK; } ps[NE] = a; }
    __syncthreads();
    pstart[threadIdx.x] = ps[threadIdx.x];
    for (int bI = threadIdx.x; bI < NBLK_G; bI += 256) blk_e[bI] = -1;
    __syncthreads();
    const int e = threadIdx.x;
    for (int s = ps[e]; s < ps[e + 1]; s += GBLK) blk_e[s / GBLK] = e;
}
__global__ void __launch_bounds__(256) g_slot_init(int* __restrict__ slot_tok, float* __restrict__ slot_w) {
    const int i = blockIdx.x * 256 + threadIdx.x; if (i < NSLOT_G) { slot_tok[i] = T; slot_w[i] = 0.f; }
}
__global__ void __launch_bounds__(256) g_fill(const int* __restrict__ idx, const float* __restrict__ w, const int* __restrict__ pstart,
                                              int* __restrict__ fillc, int* __restrict__ slot_tok, float* __restrict__ slot_w) {
    const int i = blockIdx.x * 256 + threadIdx.x; const int e = idx[i];
    const int pos = atomicAdd(&fillc[e], 1); const int s = pstart[e] + pos;
    slot_tok[s] = i / TOPK; slot_w[s] = w[i];
}
__global__ void __launch_bounds__(256) g_act(const float* __restrict__ G, const float* __restrict__ U, float* __restrict__ A, size_t n4) {
    const size_t i = (size_t)blockIdx.x * 256 + threadIdx.x; if (i >= n4) return;
    const float4 g = ((const float4*)G)[i], u = ((const float4*)U)[i];
    ((float4*)A)[i] = make_float4(siluf(g.x) * u.x, siluf(g.y) * u.y, siluf(g.z) * u.z, siluf(g.w) * u.w);
}

#endif
constexpr int N_PHASES = 11;
__global__ void __launch_bounds__(NTHR, 2) mega_fwd(Params p) {
    extern __shared__ __attribute__((aligned(16))) unsigned char lds_raw[];
    Ctx F;
    F.lds = (LAS unsigned char*)lds_raw;
    F.ws = p.ws; F.out = p.out;
#pragma unroll
    for (int i = 0; i < 22; ++i) F.in[i] = p.in[i];
    F.tid = threadIdx.x; F.lane = F.tid & 63; F.wave = __builtin_amdgcn_readfirstlane(F.tid >> 6);
    F.G = gridDim.x; F.bx = blockIdx.x; F.vcu = (F.G % 8 == 0) ? (F.bx % 8) * (F.G / 8) + F.bx / 8 : F.bx;
    for (int u = F.tid; u < (LDS_BYTES - LDSCTL_OFF) / 4; u += NTHR) ((LAS unsigned*)(F.lds + LDSCTL_OFF))[u] = 0u;
    __syncthreads();
    volatile LAS unsigned* MISC = (volatile LAS unsigned*)(F.lds + MISC_OFF);
    XcdBarrier bar = xcd_barrier_post((unsigned*)(F.ws + WS_CTL) + CW_BAR + p.li * XCD_BAR_WORDS, MISC + 8);
    const int lo = p.ph_lo, hi = p.ph_hi;
#ifndef PH_MASK
#define PH_MASK 0xFFFF
#endif
#define IN(k) (((PH_MASK >> (k)) & 1) && lo <= (k) && (k) < hi)
#ifndef REP_MASK
#define REP_MASK 0
#endif
#define REP(k) ((REP_MASK >> (k)) & 1)
#define SEAM(k) do { if (IN(k) && IN((k) + 1)) xcd_barrier(bar); } while (0)
    if (IN(0)) { phase_p0(F); }   SEAM(0);
    if (IN(1)) { phase_p0b(F); }  SEAM(1);
    if (IN(2)) { phase_p1(F); }   SEAM(2);
    if (IN(3)) { phase_r1(F); }   SEAM(3);
    if (IN(4)) { phase_mix(F); }  SEAM(4);
    if (IN(5)) { phase_p4(F); }   SEAM(5);
    if (IN(6)) { phase_p5(F); }   SEAM(6);
    if (IN(7)) { phase_p6(F); }   SEAM(7);
    if (IN(8)) { phase_p7(F); }   SEAM(8);
    if (IN(9)) { phase_moe(F); }  SEAM(9);
    if (IN(10)) { phase_final(F); }
#undef IN
#undef SEAM
}

#if DBG
struct CmpArgs { const void* mptr; const void* mptr2; int mbf16; int rpb; int bstride; int roff; int mpitch; int mcoff; const float* gptr; int gpitch; int gcoff; float gscale; int gsilu; int rows; int cols; };
__global__ void __launch_bounds__(256) dbg_compare(CmpArgs a, double* accum) {
    const size_t n = (size_t)a.rows * a.cols; double d2 = 0.0, r2 = 0.0;
    for (size_t i = (size_t)blockIdx.x * 256 + threadIdx.x; i < n; i += (size_t)gridDim.x * 256) {
        const int r = (int)(i / a.cols), c = (int)(i % a.cols);
        const size_t mi = ((size_t)(r / a.rpb) * a.bstride + (r % a.rpb) + a.roff) * a.mpitch + a.mcoff + c;
        float mv = a.mbf16 ? bf2f(((const bf16_t*)a.mptr)[mi]) : ((const float*)a.mptr)[mi];
        if (a.mptr2) mv += a.mbf16 ? bf2f(((const bf16_t*)a.mptr2)[mi]) : ((const float*)a.mptr2)[mi];
        float gv = a.gptr[(size_t)r * a.gpitch + a.gcoff + c] * a.gscale; if (a.gsilu) gv = siluf(gv);
        const double d = (double)mv - (double)gv; d2 += d * d; r2 += (double)gv * gv;
    }
    for (int o = 32; o > 0; o >>= 1) { d2 += __shfl_xor(d2, o); r2 += __shfl_xor(r2, o); }
    if ((threadIdx.x & 63) == 0) { atomicAdd(accum, d2); atomicAdd(accum + 1, r2); }
}
__global__ void __launch_bounds__(256) dbg_encode(float* out, const double* accum, size_t n4) {
    const double d2 = accum[0], r2 = accum[1];
    float f = 0.f;
    if (r2 > 0.0 && d2 == d2 && d2 < 1e300) { double e = sqrt(d2 / r2); if (e > 1.0) e = 1.0; f = 1.f + (float)sqrt(e); }
    for (size_t i = (size_t)blockIdx.x * 256 + threadIdx.x; i < n4; i += (size_t)gridDim.x * 256) { float4 v = ((float4*)out)[i]; v.x *= f; v.y *= f; v.z *= f; v.w *= f; ((float4*)out)[i] = v; }
}
struct WsG {
    float *modv, *H, *Z, *ZC, *AQ, *AK, *AV, *CAT, *Y, *X1, *H2, *LOG, *rw, *G, *U, *ACT, *MOE, *SG, *SU, *SA, *SD, *slot_w;
    int *ridx, *cnt, *fillc, *pstart, *blk_e, *slot_tok; double* accum;
};
static WsG carve_g(void* d_ws, size_t ws_size, size_t start) {
    char* p = (char*)d_ws + start; WsG w;
    auto take = [&](size_t bytes) { char* r = p; p += (bytes + 255) / 256 * 256; return r; };
    w.accum = (double*)take(256);
    w.cnt = (int*)take(NE * 4); w.fillc = (int*)take(NE * 4); w.pstart = (int*)take((NE + 1) * 4); w.blk_e = (int*)take(NBLK_G * 4);
    w.modv = (float*)take((size_t)9 * 6 * D * 4);
    w.H = (float*)take((size_t)(T + TC) * D * 4);
    w.Z = (float*)take((size_t)T * INC * 4); w.ZC = (float*)take((size_t)TC * CTXC * 4);
    w.AQ = (float*)take((size_t)T * 512 * 4); w.AK = (float*)take((size_t)NB * LK * 128 * 4); w.AV = (float*)take((size_t)NB * LK * 128 * 4);
    w.CAT = (float*)take((size_t)T * D * 4);
    w.Y = (float*)take((size_t)T * D * 4); w.X1 = (float*)take((size_t)T * D * 4);
    w.LOG = (float*)take((size_t)T * NE * 4); w.rw = (float*)take((size_t)NASSIGN * 4); w.ridx = (int*)take((size_t)NASSIGN * 4);
    w.slot_tok = (int*)take((size_t)NSLOT_G * 4); w.slot_w = (float*)take((size_t)NSLOT_G * 4);
    w.SD = nullptr; w.SG = (float*)take((size_t)T * FF * 4); w.SU = (float*)take((size_t)T * FF * 4); w.SA = w.SG;
    w.H2 = w.H; w.MOE = w.Y;
    w.G = w.Z; w.U = w.Z + (size_t)NSLOT_G * FF; w.ACT = w.G;
    if ((size_t)(p - (char*)d_ws) > ws_size || (char*)(w.U + (size_t)NSLOT_G * FF) > (char*)w.Y) { fprintf(stderr, "kernel_launch(DBG): workspace too small: need %zu have %zu\n", (size_t)(p - (char*)d_ws), ws_size); w.accum = nullptr; }
    return w;
}
static void run_golden(void* const* d_in, float* out, const WsG& w, hipStream_t stream) {
    const float* x = (const float*)d_in[0]; const float* c = (const float*)d_in[1]; const float* ctx = (const float*)d_in[2]; const float* cctx = (const float*)d_in[3];
    const float* w_mod = (const float*)d_in[4]; const float* b_mod = (const float*)d_in[5]; const float* n1w = (const float*)d_in[6]; const float* n2w = (const float*)d_in[7];
    const float* w_in = (const float*)d_in[8]; const float* qnw = (const float*)d_in[9]; const float* knw = (const float*)d_in[10];
    const float* dfw = (const float*)d_in[11]; const float* dbw = (const float*)d_in[12]; const float* w_out = (const float*)d_in[13];
    const float* rw = (const float*)d_in[14]; const float* rb = (const float*)d_in[15];
    const float* ewg = (const float*)d_in[16]; const float* ewu = (const float*)d_in[17]; const float* ewd = (const float*)d_in[18];
    const float* swg = (const float*)d_in[19]; const float* swu = (const float*)d_in[20]; const float* swd = (const float*)d_in[21];
    (void)hipMemsetAsync(w.cnt, 0, NE * 4, stream); (void)hipMemsetAsync(w.fillc, 0, NE * 4, stream);
    g_mod<<<dim3(6 * D / 256, 9), 256, 0, stream>>>(c, cctx, w_mod, b_mod, w.modv);
    g_norm_mod<<<T, 256, 0, stream>>>(x, n1w, w.modv, 0, D, L, -1, w.H);
    g_norm_mod<<<TC, 256, 0, stream>>>(ctx, n1w, w.modv, 0, D, LC, 8, w.H + (size_t)T * D);
    g_sgemm<0><<<dim3(INC / 64, T / 64), 256, 0, stream>>>(w.H, D, w_in, INC, 0, w.Z, INC, D, nullptr, nullptr, nullptr, 0);
    g_sgemm<0><<<dim3(CTXC / 64, TC / 64), 256, 0, stream>>>(w.H + (size_t)T * D, D, w_in, INC, 0, w.ZC, CTXC, D, nullptr, nullptr, nullptr, 0);
    g_qk_prep<<<(T * 12 + TC * 4 + 255) / 256, 256, 0, stream>>>(w.Z, w.ZC, qnw, knw, w.AQ, w.AK, w.AV);
    g_attn<<<NB * AH * L * 4 / 256, 256, 0, stream>>>(w.AQ, w.AK, w.AV, w.CAT);
    g_ret<<<NB * RH * L * 4 / 256, 256, 0, stream>>>(w.Z, w.ZC, dfw, dbw, w.CAT);
    g_sgemm<0><<<dim3(D / 64, T / 64), 256, 0, stream>>>(w.CAT, D, w_out, D, 0, w.Y, D, D, nullptr, nullptr, nullptr, 0);
    g_resid<<<T * D / 4 / 256, 256, 0, stream>>>(x, w.Y, nullptr, w.modv, 2 * D, w.X1);
}
static void run_golden_tail(void* const* d_in, float* out, const WsG& w, hipStream_t stream) {
    const float* n2w = (const float*)d_in[7]; const float* rw = (const float*)d_in[14]; const float* rb = (const float*)d_in[15];
    const float* ewg = (const float*)d_in[16]; const float* ewu = (const float*)d_in[17]; const float* ewd = (const float*)d_in[18];
    const float* swg = (const float*)d_in[19]; const float* swu = (const float*)d_in[20]; const float* swd = (const float*)d_in[21];
    g_norm_mod<<<T, 256, 0, stream>>>(w.X1, n2w, w.modv, 3 * D, 4 * D, L, -1, w.H2);
    g_sgemm<0><<<dim3(NE / 64, T / 64), 256, 0, stream>>>(w.H2, D, rw, NE, 0, w.LOG, NE, D, nullptr, nullptr, nullptr, 0);
    g_route<<<T / 4, 256, 0, stream>>>(w.LOG, rb, w.ridx, w.rw);
    g_count<<<NASSIGN / 256, 256, 0, stream>>>(w.ridx, w.cnt);
    g_offsets<<<1, 256, 0, stream>>>(w.cnt, w.pstart, w.blk_e);
    g_slot_init<<<(NSLOT_G + 255) / 256, 256, 0, stream>>>(w.slot_tok, w.slot_w);
    g_fill<<<NASSIGN / 256, 256, 0, stream>>>(w.ridx, w.rw, w.pstart, w.fillc, w.slot_tok, w.slot_w);
}
static void run_golden_tail2(void* const* d_in, float* out, const WsG& w, hipStream_t stream) {
    const float* ewg = (const float*)d_in[16]; const float* ewu = (const float*)d_in[17]; const float* ewd = (const float*)d_in[18];
    const float* swg = (const float*)d_in[19]; const float* swu = (const float*)d_in[20]; const float* swd = (const float*)d_in[21];
    g_sgemm<1><<<dim3(FF / 64, NBLK_G), 256, 0, stream>>>(w.H2, D, ewg, FF, (size_t)D * FF, w.G, FF, D, w.slot_tok, w.slot_w, w.blk_e, T);
    g_sgemm<1><<<dim3(FF / 64, NBLK_G), 256, 0, stream>>>(w.H2, D, ewu, FF, (size_t)D * FF, w.U, FF, D, w.slot_tok, w.slot_w, w.blk_e, T);
    g_act<<<(unsigned)(((size_t)NSLOT_G * FF / 4 + 255) / 256), 256, 0, stream>>>(w.G, w.U, w.ACT, (size_t)NSLOT_G * FF / 4);
    (void)hipMemsetAsync(w.MOE, 0, (size_t)T * D * 4, stream);
    g_sgemm<2><<<dim3(D / 64, NBLK_G), 256, 0, stream>>>(w.ACT, FF, ewd, D, (size_t)FF * D, w.MOE, D, FF, w.slot_tok, w.slot_w, w.blk_e, T);
    g_sgemm<0><<<dim3(FF / 64, T / 64), 256, 0, stream>>>(w.H2, D, swg, FF, 0, w.SG, FF, D, nullptr, nullptr, nullptr, 0);
    g_sgemm<0><<<dim3(FF / 64, T / 64), 256, 0, stream>>>(w.H2, D, swu, FF, 0, w.SU, FF, D, nullptr, nullptr, nullptr, 0);
    g_act<<<(unsigned)(((size_t)T * FF / 4 + 255) / 256), 256, 0, stream>>>(w.SG, w.SU, w.SA, (size_t)T * FF / 4);
    g_sgemm<3><<<dim3(D / 64, T / 64), 256, 0, stream>>>(w.SA, FF, swd, D, 0, w.MOE, D, FF, nullptr, nullptr, nullptr, 0);
    g_resid<<<T * D / 4 / 256, 256, 0, stream>>>(w.X1, w.MOE, nullptr, w.modv, 5 * D, out);
}
#endif

extern "C" void kernel_launch(void* const* d_in, const int* in_sizes, int n_in, void* d_out, int out_size, void* d_ws, size_t ws_size, hipStream_t stream) {
    static int grid = 0;
    if (grid == 0) {
        int dev = 0, cus = 0, per_cu = 0;
        if (hipGetDevice(&dev) != hipSuccess || hipDeviceGetAttribute(&cus, hipDeviceAttributeMultiprocessorCount, dev) != hipSuccess) { fprintf(stderr, "kernel_launch: device query failed\n"); grid = -1; return; }
        if (hipFuncSetAttribute((const void*)mega_fwd, hipFuncAttributeMaxDynamicSharedMemorySize, LDS_BYTES) != hipSuccess) { fprintf(stderr, "kernel_launch: hipFuncSetAttribute failed\n"); grid = -1; return; }
        if (hipOccupancyMaxActiveBlocksPerMultiprocessor(&per_cu, (const void*)mega_fwd, NTHR, LDS_BYTES) != hipSuccess || per_cu < 1) { fprintf(stderr, "kernel_launch: occupancy query says %d blocks/CU\n", per_cu); per_cu = 1; }
        (void)hipGetLastError();
        grid = cus;
        if (grid != 256) fprintf(stderr, "kernel_launch: built for 256 CUs, device has %d\n", cus);
        if (ws_size < WS_END_B) { fprintf(stderr, "kernel_launch: workspace too small\n"); grid = -1; return; }
    }
    if (grid < 0) return;
    (void)hipMemsetAsync((char*)d_ws + WS_CTL, 0, CTL_ZERO_BYTES, stream);
    Params p{};
    for (int i = 0; i < 22; ++i) p.in[i] = (const float*)d_in[i];
    p.out = (float*)d_out; p.ws = (unsigned char*)d_ws;
#if DBG
    WsG w = carve_g(d_ws, ws_size, WS_END_A);
    if (!w.accum) { (void)hipMemsetAsync(d_out, 0, (size_t)T * D * 4, stream); return; }
    run_golden(d_in, (float*)d_out, w, stream);
    p.ph_lo = 0; p.ph_hi = DBG_PH_HI;
    { void* args[] = {&p}; hipError_t e = hipLaunchCooperativeKernel((const void*)mega_fwd, dim3(grid), dim3(NTHR), args, LDS_BYTES, stream);
      if (e != hipSuccess) fprintf(stderr, "cooperative launch failed: %s\n", hipGetErrorString(e)); }
    (void)hipMemsetAsync(w.accum, 0, 16, stream);
    unsigned char* ws = (unsigned char*)d_ws;
    auto cmp = [&](const void* mp, const void* mp2, int mbf16, int rpb, int bstride, int roff, int mpitch, int mcoff, const float* gp, int gpitch, int gcoff, float gscale, int gsilu, int rows, int cols) {
        CmpArgs a{mp, mp2, mbf16, rpb, bstride, roff, mpitch, mcoff, gp, gpitch, gcoff, gscale, gsilu, rows, cols};
        dbg_compare<<<1024, 256, 0, stream>>>(a, w.accum); };
#if DBG == 1
    cmp(ws + WS_HB, nullptr, 1, TALL, 0, 0, D, 0, w.H, D, 0, 1.f, 0, TALL, D);
#elif DBG == 2
    cmp(ws + WS_QB, nullptr, 1, T, 0, 0, 512, 0, w.AQ, 512, 0, C2, 0, T, 512);
#elif DBG == 3
    cmp(ws + WS_KB, nullptr, 1, NB * LK, 0, 0, 128, 0, w.AK, 128, 0, 1.f, 0, NB * LK, 128);
    cmp(ws + WS_VB, nullptr, 1, NB * LK, 0, 0, 128, 0, w.AV, 128, 0, 1.f, 0, NB * LK, 128);
#elif DBG == 4
    cmp(ws + WS_RKB, nullptr, 1, L, LK, 0, 512, 0, w.Z, INC, OFF_RK, 0.125f, 0, T, 512);
    cmp(ws + WS_RKB, nullptr, 1, LC, LK, L, 512, 0, w.ZC, CTXC, OFF_RK, 0.125f, 0, TC, 512);
    cmp(ws + WS_RVB, nullptr, 1, L, LK, 0, 512, 0, w.Z, INC, OFF_RV, 1.f, 0, T, 512);
    cmp(ws + WS_RVB, nullptr, 1, LC, LK, L, 512, 0, w.ZC, CTXC, OFF_RV, 1.f, 0, TC, 512);
#elif DBG == 5
    cmp(ws + WS_RQB, nullptr, 1, T, 0, 0, 512, 0, w.Z, INC, OFF_RQ, 1.f, 0, T, 512);
    cmp(ws + WS_RGB, nullptr, 1, T, 0, 0, 512, 0, w.Z, INC, OFF_RG, 1.f, 1, T, 512);
#elif DBG == 9
    cmp(ws + WS_CAT, nullptr, 1, T, 0, 0, D, 0, w.CAT, D, 0, 1.f, 0, T, 512);
#elif DBG == 10
    cmp(ws + WS_CAT, nullptr, 1, T, 0, 0, D, 512, w.CAT, D, 512, 1.f, 0, T, 512);
#elif DBG == 11
    cmp(ws + WS_X1, nullptr, 0, T, 0, 0, D, 0, w.X1, D, 0, 1.f, 0, T, D);
#elif DBG == 6
    cmp(ws + WS_QB, nullptr, 1, T, 0, 0, 512, 0, w.AQ, 512, 0, C2, 0, T, 512);
    cmp(ws + WS_KB, nullptr, 1, NB * LK, 0, 0, 128, 0, w.AK, 128, 0, 1.f, 0, NB * LK, 128);
    cmp(ws + WS_VB, nullptr, 1, NB * LK, 0, 0, 128, 0, w.AV, 128, 0, 1.f, 0, NB * LK, 128);
    cmp(ws + WS_RKB, nullptr, 1, L, LK, 0, 512, 0, w.Z, INC, OFF_RK, 0.125f, 0, T, 512);
    cmp(ws + WS_RKB, nullptr, 1, LC, LK, L, 512, 0, w.ZC, CTXC, OFF_RK, 0.125f, 0, TC, 512);
    cmp(ws + WS_RVB, nullptr, 1, L, LK, 0, 512, 0, w.Z, INC, OFF_RV, 1.f, 0, T, 512);
    cmp(ws + WS_RVB, nullptr, 1, LC, LK, L, 512, 0, w.ZC, CTXC, OFF_RV, 1.f, 0, TC, 512);
    cmp(ws + WS_RQB, nullptr, 1, T, 0, 0, 512, 0, w.Z, INC, OFF_RQ, 1.f, 0, T, 512);
    cmp(ws + WS_RGB, nullptr, 1, T, 0, 0, 512, 0, w.Z, INC, OFF_RG, 1.f, 1, T, 512);
#endif
    run_golden_tail(d_in, (float*)d_out, w, stream);
#if DBG == 12
    cmp(ws + WS_H2B, ws + WS_H2B + (size_t)T * D * 2, 1, T, 0, 0, D, 0, w.H2, D, 0, 1.f, 0, T, D);
#elif DBG == 13
    cmp(ws + WS_RWT, nullptr, 0, T, 0, 0, TOPK, 0, w.rw, TOPK, 0, 1.f, 0, T, TOPK);
#endif
    run_golden_tail2(d_in, (float*)d_out, w, stream);
    dbg_encode<<<1024, 256, 0, stream>>>((float*)d_out, w.accum, (size_t)T * D / 4);
#else
    p.ph_lo = 0; p.ph_hi = N_PHASES;
    void* args[] = {&p};
    hipError_t e = hipLaunchCooperativeKernel((const void*)mega_fwd, dim3(grid), dim3(NTHR), args, LDS_BYTES, stream);
    if (e != hipSuccess) fprintf(stderr, "cooperative launch failed: %s (grid %d)\n", hipGetErrorString(e), grid);
#if defined(PROBE_LO)
    for (int r = 0; r < PROBE_N; ++r) { p.ph_lo = PROBE_LO; p.ph_hi = PROBE_HI; p.li = 1 + r;
        (void)hipLaunchCooperativeKernel((const void*)mega_fwd, dim3(grid), dim3(NTHR), args, LDS_BYTES, stream); }
#endif
#endif
}
```

```cpp
#define DBG 0
#define DBG_PH_HI 11
#include <hip/hip_runtime.h>
#include <hip/hip_bf16.h>
#include <cstdio>
#include <cstdint>
#include <cmath>

#ifndef DBG
#define DBG 0
#endif

constexpr int D = 1024, NB = 8, L = 2048, LC = 256, T = NB * L, TC = NB * LC, TALL = T + TC;
constexpr int HD = 64, AH = 8, KVH = 2, RH = 8;
constexpr int OFF_AK = 0, OFF_AV = 128, OFF_RK = 256, OFF_RV = 768, CTXC = 1280, OFF_AQ = 1280, OFF_RQ = 1792, OFF_RG = 2304, INC = 2816;
constexpr int NE = 256, TOPK = 8, FF = 256;
constexpr int LK = L + LC;
constexpr int NCH = LK / 128;
constexpr int NASSIGN = T * TOPK;
constexpr int CAP = 16384;
constexpr float EPS = 1e-6f;
constexpr float C2 = 0.125f * 1.4426950408889634f;

typedef unsigned short bf16_t;
typedef float f32x4 __attribute__((ext_vector_type(4)));
typedef unsigned u32x4 __attribute__((ext_vector_type(4)));
typedef unsigned u32x2 __attribute__((ext_vector_type(2)));
typedef short bf16x8 __attribute__((ext_vector_type(8)));

__device__ __forceinline__ float siluf(float v) { return v / (1.f + __expf(-v)); }
__device__ __forceinline__ float sigmoidf_(float v) { return 1.f / (1.f + __expf(-v)); }
__device__ __forceinline__ unsigned f2bf(float f) { unsigned u = __builtin_bit_cast(unsigned, f); return (u + 0x7fffu + ((u >> 16) & 1u)) >> 16; }
__device__ __forceinline__ unsigned pk2(float lo, float hi) { return f2bf(lo) | (f2bf(hi) << 16); }
__device__ __forceinline__ float bf2f(unsigned short h) { return __builtin_bit_cast(float, (unsigned)h << 16); }
__device__ __forceinline__ float bflo(unsigned w) { return __builtin_bit_cast(float, w << 16); }
__device__ __forceinline__ float bfhi(unsigned w) { return __builtin_bit_cast(float, w & 0xffff0000u); }

constexpr size_t MiB = 1u << 20;
constexpr size_t al256(size_t x) { return (x + 255) / 256 * 256; }
constexpr size_t WS_CTL = 0, CTL_ZERO_BYTES = 1 * MiB;
constexpr size_t WS_MODV = WS_CTL + CTL_ZERO_BYTES;
constexpr size_t WS_ROPE = WS_MODV + al256((size_t)9 * 6 * D * 4);
constexpr size_t WS_WIN = WS_ROPE + al256((size_t)(32 + 64) * 16 * 8);
constexpr size_t WS_WOUT = WS_WIN + al256((size_t)INC * D * 2);
constexpr size_t WS_WR = WS_WOUT + al256((size_t)D * D * 2);
constexpr size_t WS_WSGU = WS_WR + al256((size_t)512 * D * 2);
constexpr size_t WS_WSD = WS_WSGU + al256((size_t)512 * D * 2);
constexpr size_t WS_HB = WS_WSD + al256((size_t)D * FF * 2);
constexpr size_t WS_QB = WS_HB + al256((size_t)TALL * D * 2);
constexpr size_t WS_KB = WS_QB + al256((size_t)T * 512 * 2);
constexpr size_t WS_VB = WS_KB + al256((size_t)NB * LK * 128 * 2);
constexpr size_t WS_RKB = WS_VB + al256((size_t)NB * LK * 128 * 2);
constexpr size_t WS_RVB = WS_RKB + al256((size_t)NB * LK * 512 * 2);
constexpr size_t WS_RQB = WS_RVB + al256((size_t)NB * LK * 512 * 2);
constexpr size_t WS_RGB = WS_RQB + al256((size_t)T * 512 * 2);
constexpr size_t WS_CST = WS_RGB + al256((size_t)T * 512 * 2);
constexpr size_t WS_CAT = WS_CST + al256((size_t)NB * RH * NCH * 2 * 4096 * 4);
constexpr size_t WS_X1 = WS_CAT + al256((size_t)T * D * 2);
constexpr size_t WS_H2B = WS_X1 + al256((size_t)T * D * 4);
constexpr size_t WS_LOGP = WS_H2B + al256((size_t)2 * T * D * 2);
constexpr size_t WS_ACTS = WS_LOGP + al256((size_t)3 * T * NE * 4);
constexpr size_t WS_RIDX = WS_ACTS + al256((size_t)T * FF * 2);
constexpr size_t WS_RWT = WS_RIDX + al256((size_t)NASSIGN * 4);
constexpr size_t WS_SDST = WS_RWT + al256((size_t)NASSIGN * 4);
constexpr size_t WS_SW = WS_SDST + al256((size_t)NE * 16384 * 4);
constexpr size_t WS_END_A = WS_SW + al256((size_t)NE * 16384 * 4);
constexpr size_t WS_ACT = WS_END_A;
constexpr size_t WS_YEXP = WS_ACT + al256((size_t)NASSIGN * FF * 2);
constexpr size_t WS_END_B = WS_YEXP + al256((size_t)NASSIGN * D * 2);
constexpr int CW_BAR = 4096;
constexpr int CW_ECNT = 16384;

#define GAS __attribute__((address_space(1)))
#define LAS __attribute__((address_space(3)))
#define LDS_WAIT() asm volatile("s_waitcnt lgkmcnt(0)" ::: "memory")
#define VM_WAIT() asm volatile("s_waitcnt vmcnt(0)" ::: "memory")
constexpr int NWAVES = 8, NTHR = NWAVES * 64;
constexpr int RING_BYTES = 131072, LDSCTL_OFF = 147456, MISC_OFF = LDSCTL_OFF + 320, LDS_BYTES = 163840;

__device__ __forceinline__ int lane_id() { int l; asm volatile("v_mbcnt_lo_u32_b32 %0, -1, 0\n\tv_mbcnt_hi_u32_b32 %0, -1, %0" : "=v"(l)); return l; }
#define MK_TID(wave) ((wave) * 64 + lane_id())

struct Params {
    const float* in[22];
    float* out;
    unsigned char* ws;
    int ph_lo, ph_hi, li, pad;
};
namespace pg8 {
#define PG8_LAS __attribute__((address_space(3)))
typedef unsigned short bf16_t;
typedef short bf16x8 __attribute__((ext_vector_type(8)));
typedef float f32x4 __attribute__((ext_vector_type(4)));
typedef unsigned u32x4 __attribute__((ext_vector_type(4)));
constexpr int BM = 256, BK = 64, HALF = 128, HTB = HALF * BK * 2  , STAGE_BYTES = 8 * HTB, NXCD = 8, WGM = 8;

__host__ __device__ __forceinline__ int lds_byte(int r, int c) { const int st = (r >> 4) * 2 + (c >> 5), rr = r & 15, cc = c & 31, ob = rr * 64 + cc * 2; return st * 1024 + (ob ^ (((ob >> 9) & 1) << 5)); }
__host__ __device__ __forceinline__ void stage_rc(int b, int& R, int& C) { const int st = b / 1024, sb = b % 1024, swz = sb ^ (((sb >> 9) & 1) << 5); R = (st >> 1) * 16 + swz / 64; C = (st & 1) * 32 + (swz % 64) / 2; }
__host__ __device__ __forceinline__ int perm32(int rho) { const int n = rho >> 4, i = rho & 15; return 8 * (i >> 2) + 4 * n + (i & 3); }

struct Unit { int pm, pn; };
struct Gemm { const bf16_t* A; const bf16_t* Bt; int M, N, K; };

struct StaticOrder {
    int nM, nN, nwg, G, c;
    __host__ __device__ void init(int M, int N, int G_, int c_) { nM = M / BM; nN = N / BM; nwg = nM * nN; G = G_; c = c_; }
    __host__ __device__ bool next(int i, Unit& u) const {
        const long L = (long)i * G + c; if (L >= nwg) return false;
        int wgid = (int)L; { const int q = nwg / NXCD, r = nwg % NXCD, xcd = wgid % NXCD, off = wgid / NXCD; wgid = (xcd < r ? xcd * (q + 1) : r * (q + 1) + (xcd - r) * q) + off; }
        const int nig = WGM * nN, gid = wgid / nig, fm = gid * WGM, gsz = (nM - fm) < WGM ? (nM - fm) : WGM;
        u.pm = fm + ((wgid % nig) % gsz); u.pn = (wgid % nig) / gsz; return true;
    }
    __device__ __forceinline__ void a_ready(const Unit&) const {}
    __device__ __forceinline__ void done(const Unit&) const {}
};

__device__ __forceinline__ unsigned cvt_pk_bf16(float lo, float hi) { unsigned r; asm volatile("v_cvt_pk_bf16_f32 %0, %1, %2" : "=v"(r) : "v"(lo), "v"(hi)); return r; }
typedef float f32x2 __attribute__((ext_vector_type(2)));

template <class Epi, class Sched, bool ALIGN_EPI = false, bool SP2 = false>
__device__ __forceinline__ void gemm_phase(PG8_LAS unsigned char* lds, const Gemm g, const Sched& S, const Epi& E, const int wave_id) {
    const int tid = MK_TID(wave_id), wid = __builtin_amdgcn_readfirstlane(tid >> 6), lane = tid & 63, wr = wid >> 2, wc = wid & 3, fr = lane & 15, fq = lane >> 4;
    const int K = g.K, nt = K / BK;
    unsigned voffA[2], voffB[2];
#pragma unroll
    for (int i = 0; i < 2; ++i) { int R, C; stage_rc(tid * 16 + i * 8192, R, C); const int Rb = Epi::HEADPERM ? (64 * (R >> 5) + perm32(R & 31)) : (Epi::PERM ? ((R & ~31) + perm32(R & 31)) : R);
        voffA[i] = (unsigned)(R * K + C) * 2u; voffB[i] = (unsigned)(Rb * K + C) * 2u; }
    const size_t kstep = (size_t)(BK * 2);
    const size_t hstep = (size_t)HALF * K * 2;
    const size_t tstep = 2 * hstep; const size_t bhstep = Epi::HEADPERM ? (size_t)32 * K * 2 : hstep;
    const unsigned ldsw = (unsigned)wid * 1024u;
    const int aoff = lds_byte(wr * 64 + fr, fq * 8), boff = lds_byte(wc * 32 + fr, fq * 8);
#define PG8_SA(b, h) (((b) * 2 + (h)) * HTB)
#define PG8_SB(b, h) ((4 + (b) * 2 + (h)) * HTB)
#define PG8_STAGE(bufoff, gbase, voff) do { _Pragma("unroll") for (int _i = 0; _i < 2; ++_i) \
        __builtin_amdgcn_global_load_lds((const unsigned*)((const char*)(gbase) + (voff)[_i]), (PG8_LAS unsigned*)(lds + (bufoff) + ldsw + _i * 8192), 16, 0, 0); } while (0)
#define PG8_LDA(dst, b, h) do { _Pragma("unroll") for (int m = 0; m < 4; ++m) _Pragma("unroll") for (int k = 0; k < 2; ++k) dst[m][k] = *(const PG8_LAS bf16x8*)(lds + PG8_SA(b, h) + aoff + m * 2048 + k * 1024); } while (0)
#define PG8_LDB(dst, b, h) do { _Pragma("unroll") for (int n = 0; n < 2; ++n) _Pragma("unroll") for (int k = 0; k < 2; ++k) dst[n][k] = *(const PG8_LAS bf16x8*)(lds + PG8_SB(b, h) + boff + n * 2048 + k * 1024); } while (0)
#define PG8_MMA(ai, bj, At, Bt) do { __builtin_amdgcn_s_setprio(1); _Pragma("unroll") for (int m = 0; m < 4; ++m) _Pragma("unroll") for (int n = 0; n < 2; ++n) _Pragma("unroll") for (int k = 0; k < 2; ++k) \
        acc[ai][bj][m][n] = __builtin_amdgcn_mfma_f32_16x16x32_bf16(Bt[n][k], At[m][k], acc[ai][bj][m][n], 0, 0, 0); __builtin_amdgcn_s_setprio(0); } while (0)
#define PG8_WAIT_V(n) asm volatile("s_waitcnt vmcnt(" #n ")" ::: "memory")
#define PG8_WAIT_L(n) asm volatile("s_waitcnt lgkmcnt(" #n ")" ::: "memory")
#define PG8_BAR __builtin_amdgcn_s_barrier()
#define PG8_SCHED __builtin_amdgcn_sched_barrier(0)
    Unit cur, nxt; int ui = 0;
    if (!S.next(0, cur)) return;
    f32x4 acc[2][2][4][2];
#pragma unroll
    for (int a = 0; a < 2; ++a)
#pragma unroll
        for (int b = 0; b < 2; ++b)
#pragma unroll
            for (int m = 0; m < 4; ++m)
#pragma unroll
                for (int n = 0; n < 2; ++n) acc[a][b][m][n] = (f32x4){0.f, 0.f, 0.f, 0.f};
    bf16x8 At[4][2], B0[2][2], B1[2][2];
    const char* cA = (const char*)g.A + (size_t)cur.pm * tstep; const char* cB = (const char*)g.Bt + (size_t)cur.pn * tstep;
    S.a_ready(cur);
    if constexpr (SP2) {
        PG8_STAGE(PG8_SB(0, 0), cB, voffB); PG8_STAGE(PG8_SB(0, 1), cB + bhstep, voffB); PG8_STAGE(PG8_SA(0, 0), cA, voffA); PG8_STAGE(PG8_SA(0, 1), cA + hstep, voffA);
        if (wr == 1) PG8_BAR;
        PG8_WAIT_V(2); PG8_BAR;
        PG8_STAGE(PG8_SB(1, 0), cB + kstep, voffB); PG8_STAGE(PG8_SA(1, 0), cA + kstep, voffA); PG8_STAGE(PG8_SB(1, 1), cB + bhstep + kstep, voffB);
        PG8_WAIT_V(6); PG8_BAR;
    } else {
        PG8_STAGE(PG8_SB(0, 0), cB, voffB); PG8_STAGE(PG8_SA(0, 0), cA, voffA); PG8_STAGE(PG8_SB(0, 1), cB + bhstep, voffB); PG8_STAGE(PG8_SA(0, 1), cA + hstep, voffA);
        if (wr == 1) PG8_BAR;
        PG8_WAIT_V(4); PG8_BAR;
        PG8_STAGE(PG8_SB(1, 0), cB + kstep, voffB); PG8_STAGE(PG8_SA(1, 0), cA + kstep, voffA); PG8_STAGE(PG8_SB(1, 1), cB + bhstep + kstep, voffB);
        PG8_WAIT_V(6); PG8_BAR;
    }
    for (;;) {
        const bool has_next = S.next(ui + 1, nxt);
        const char* nA = has_next ? (const char*)g.A + (size_t)nxt.pm * tstep : cA; const char* nB = has_next ? (const char*)g.Bt + (size_t)nxt.pn * tstep : cB;
        for (int t = 0; t < nt; t += 2) {
            const bool last = (t == nt - 2);
            const char* a1 = cA + (size_t)(t + 1) * kstep;
            const char* a2 = last ? nA : cA + (size_t)(t + 2) * kstep; const char* b2 = last ? nB : cB + (size_t)(t + 2) * kstep;
            const char* a3 = a2 + kstep; const char* b3 = b2 + kstep;
            if (last && has_next) S.a_ready(nxt);
            if constexpr (SP2) {
            PG8_LDB(B0, 0, 0); PG8_LDB(B1, 0, 1); PG8_SCHED; PG8_LDA(At, 0, 0); PG8_STAGE(PG8_SA(1, 1), a1 + hstep, voffA);
            PG8_WAIT_V(8); PG8_WAIT_L(0); PG8_BAR; PG8_MMA(0, 0, At, B0); PG8_MMA(0, 1, At, B1); PG8_BAR; PG8_SCHED;
            PG8_LDA(At, 0, 1); PG8_STAGE(PG8_SB(0, 0), b2, voffB); PG8_STAGE(PG8_SB(0, 1), b2 + bhstep, voffB); PG8_STAGE(PG8_SA(0, 0), a2, voffA);
            PG8_WAIT_V(8); PG8_WAIT_L(0); PG8_BAR; PG8_MMA(1, 0, At, B0); PG8_MMA(1, 1, At, B1); PG8_BAR; PG8_SCHED;
            PG8_LDB(B0, 1, 0); PG8_LDB(B1, 1, 1); PG8_SCHED; PG8_LDA(At, 1, 0); PG8_STAGE(PG8_SA(0, 1), a2 + hstep, voffA);
            PG8_WAIT_V(8); PG8_WAIT_L(0); PG8_BAR; PG8_MMA(0, 0, At, B0); PG8_MMA(0, 1, At, B1); PG8_BAR; PG8_SCHED;
            PG8_LDA(At, 1, 1); PG8_STAGE(PG8_SB(1, 0), b3, voffB); PG8_STAGE(PG8_SB(1, 1), b3 + bhstep, voffB); PG8_STAGE(PG8_SA(1, 0), a3, voffA);
            PG8_WAIT_V(8); PG8_WAIT_L(0); PG8_BAR; PG8_MMA(1, 0, At, B0); PG8_MMA(1, 1, At, B1); PG8_BAR; PG8_SCHED;
            } else {
            PG8_LDB(B0, 0, 0); PG8_SCHED; PG8_LDA(At, 0, 0); PG8_STAGE(PG8_SA(1, 1), a1 + hstep, voffA);
            PG8_WAIT_L(8); PG8_BAR; PG8_WAIT_L(0); PG8_MMA(0, 0, At, B0); PG8_BAR; PG8_SCHED;
            PG8_LDB(B1, 0, 1); PG8_STAGE(PG8_SB(0, 0), b2, voffB);
            PG8_BAR; PG8_WAIT_L(0); PG8_MMA(0, 1, At, B1); PG8_BAR;
            PG8_LDA(At, 0, 1); PG8_STAGE(PG8_SA(0, 0), a2, voffA);
            PG8_BAR; PG8_WAIT_L(0); PG8_MMA(1, 0, At, B0); PG8_BAR; PG8_SCHED;
            PG8_STAGE(PG8_SB(0, 1), b2 + bhstep, voffB);
            PG8_WAIT_V(6); PG8_BAR; PG8_MMA(1, 1, At, B1); PG8_BAR;
            PG8_LDB(B0, 1, 0); PG8_SCHED; PG8_LDA(At, 1, 0); PG8_STAGE(PG8_SA(0, 1), a2 + hstep, voffA);
            PG8_WAIT_L(8); PG8_BAR; PG8_WAIT_L(0); PG8_MMA(0, 0, At, B0); PG8_BAR; PG8_SCHED;
            PG8_LDB(B1, 1, 1); PG8_STAGE(PG8_SB(1, 0), b3, voffB);
            PG8_BAR; PG8_WAIT_L(0); PG8_MMA(0, 1, At, B1); PG8_BAR;
            PG8_LDA(At, 1, 1); PG8_STAGE(PG8_SA(1, 0), a3, voffA);
            PG8_BAR; PG8_WAIT_L(0); PG8_MMA(1, 0, At, B0); PG8_BAR; PG8_SCHED;
            PG8_STAGE(PG8_SB(1, 1), b3 + bhstep, voffB);
            PG8_WAIT_V(6); PG8_BAR; PG8_MMA(1, 1, At, B1); PG8_BAR;
            }
        }
        if constexpr (ALIGN_EPI) { if (wr == 0) PG8_BAR; }
        if constexpr (!Epi::AFTER_DRAIN) { E(acc, cur, wr, wc, fr, fq); S.done(cur); }
        if (!has_next) break;
#pragma unroll
        for (int a = 0; a < 2; ++a)
#pragma unroll
            for (int b = 0; b < 2; ++b)
#pragma unroll
                for (int m = 0; m < 4; ++m)
#pragma unroll
                    for (int n = 0; n < 2; ++n) acc[a][b][m][n] = (f32x4){0.f, 0.f, 0.f, 0.f};
        cur = nxt; cA = nA; cB = nB; ++ui;
        if constexpr (ALIGN_EPI) { if (wr == 1) PG8_BAR; }
    }
    PG8_WAIT_V(0);
    if constexpr (!ALIGN_EPI) { if (wr == 0) PG8_BAR; }
    PG8_BAR;
    if constexpr (Epi::AFTER_DRAIN) { E.fused(acc, cur, wr, wc, fr, fq, lds, wid, lane); S.done(cur); }
#undef PG8_SA
#undef PG8_SB
#undef PG8_STAGE
#undef PG8_LDA
#undef PG8_LDB
#undef PG8_MMA
#undef PG8_WAIT_V
#undef PG8_WAIT_L
#undef PG8_BAR
#undef PG8_SCHED
}
}
namespace attn_body {
using bf16=__hip_bfloat16;
using bf16x8=__attribute__((ext_vector_type(8)))short;
using s16x4=__attribute__((ext_vector_type(4)))short;
using f32x16=__attribute__((ext_vector_type(16)))float;
using u32x4=__attribute__((ext_vector_type(4)))unsigned;
constexpr int D=64, QP=512, KP=128, OP=1024, NKEYS=2304, NQ=2048;
constexpr int NW=8,QBLK=32,QB=QBLK*NW,KVBLK=64,NQB=NQ/QB;
constexpr int ATTN_UNIT_ROWS=QB;
__device__ __forceinline__ int crow(int r,int hi){return (r&3)+8*(r>>2)+4*hi;}
#define SBAR() __builtin_amdgcn_sched_barrier(0)
constexpr int NSLOT=3, SLOTB=8192;
constexpr int LDS_K=0, LDS_V=NSLOT*SLOTB, LDS_WS=2*NSLOT*SLOTB, LDS_OST=LDS_WS+NW*64*4, LDS_BYTES=LDS_OST+NW*4096;
constexpr float C2=0.125f*1.4426950408889634f;
__device__ __forceinline__ void glds16(const void*gsrc,unsigned lds_dst){unsigned keep;
  asm volatile("s_mov_b32 %0, m0\n\ts_mov_b32 m0, %2\n\ts_nop 0\n\tglobal_load_lds_dwordx4 %1, off\n\ts_mov_b32 m0, %0":"=&s"(keep):"v"(gsrc),"s"(lds_dst):"memory");}
__device__ __forceinline__ float max3f(float a,float b,float c){float r;asm("v_max3_f32 %0, %1, %2, %3":"=v"(r):"v"(a),"v"(b),"v"(c));return r;}
__device__ __forceinline__ float max2f(float a,float b){float r;asm("v_max_f32_e32 %0, %1, %2":"=v"(r):"v"(a),"v"(b));return r;}
__device__ __forceinline__ float fadd_s(float a,float b){float r;asm("v_add_f32_e32 %0, %1, %2":"=v"(r):"v"(a),"v"(b));return r;}
__device__ __forceinline__ float fsub_s(float a,float b){float r;asm("v_sub_f32_e32 %0, %1, %2":"=v"(r):"v"(a),"v"(b));return r;}
typedef float f32x2_t __attribute__((ext_vector_type(2))); typedef __bf16 bf16x2_t __attribute__((ext_vector_type(2)));
__device__ __forceinline__ unsigned cvtpk_s(float lo,float hi){f32x2_t v={lo,hi};bf16x2_t b=__builtin_convertvector(v,bf16x2_t);return __builtin_bit_cast(unsigned,b);}
#define WAIT_BAR(N) asm volatile("s_waitcnt vmcnt(" #N ") lgkmcnt(0)\n\ts_barrier":::"memory")

__device__ __forceinline__ void qkt(f32x16&p0,f32x16&p1,const char*Kslot,const bf16x8*qr,const f32x16&negm,int r32,int hi){
  const char*kb=Kslot+hi*1024+r32*16;
  #pragma unroll
  for(int d0=0;d0<4;++d0){
    const bf16x8 b0=*reinterpret_cast<const bf16x8*>(kb+d0*2048);
    const bf16x8 b1=*reinterpret_cast<const bf16x8*>(kb+d0*2048+512);
    if(d0==0){p0=__builtin_amdgcn_mfma_f32_32x32x16_bf16(b0,qr[0],negm,0,0,0);p1=__builtin_amdgcn_mfma_f32_32x32x16_bf16(b1,qr[0],negm,0,0,0);}
    else{p0=__builtin_amdgcn_mfma_f32_32x32x16_bf16(b0,qr[d0],p0,0,0,0);p1=__builtin_amdgcn_mfma_f32_32x32x16_bf16(b1,qr[d0],p1,0,0,0);}}
}
typedef __attribute__((address_space(3))) const char* lds_cptr;
typedef short v4i16_t __attribute__((ext_vector_type(4)));
__device__ __forceinline__ void kload8(bf16x8*kf,lds_cptr kp){
  kf[0]=*(const __attribute__((address_space(3))) bf16x8*)(kp);      kf[1]=*(const __attribute__((address_space(3))) bf16x8*)(kp+512);
  kf[2]=*(const __attribute__((address_space(3))) bf16x8*)(kp+2048); kf[3]=*(const __attribute__((address_space(3))) bf16x8*)(kp+2560);
  kf[4]=*(const __attribute__((address_space(3))) bf16x8*)(kp+4096); kf[5]=*(const __attribute__((address_space(3))) bf16x8*)(kp+4608);
  kf[6]=*(const __attribute__((address_space(3))) bf16x8*)(kp+6144); kf[7]=*(const __attribute__((address_space(3))) bf16x8*)(kp+6656);
}
__device__ __forceinline__ void kload2(bf16x8*kf,lds_cptr kp,int j){ kf[2*j]=*(const __attribute__((address_space(3))) bf16x8*)(kp+j*2048); kf[2*j+1]=*(const __attribute__((address_space(3))) bf16x8*)(kp+j*2048+512); }
__device__ __forceinline__ s16x4 vtr(lds_cptr p){ return __builtin_bit_cast(s16x4,__builtin_amdgcn_ds_read_tr16_b64_v4i16((__attribute__((address_space(3))) v4i16_t*)p)); }
__device__ __forceinline__ float rowmax(const f32x16&p0,const f32x16&p1){
  float a=max3f(p0[0],p0[1],p1[0]),b=max3f(p0[2],p0[3],p1[1]);a=max3f(a,p1[2],p1[3]);
  #pragma unroll
  for(int r=4;r<16;r+=4){a=max3f(a,p0[r],p0[r+1]);b=max3f(b,p0[r+2],p0[r+3]);a=max3f(a,p1[r],p1[r+1]);b=max3f(b,p1[r+2],p1[r+3]);}
  const float m=max2f(a,b);
  auto rr=__builtin_amdgcn_permlane32_swap(__float_as_uint(m),__float_as_uint(m),false,false);
  return max2f(__uint_as_float(rr[0]),__uint_as_float(rr[1]));
}
__device__ __forceinline__ void pv(f32x16*o,int vb,bf16x8 pa0,bf16x8 pa1,bf16x8 pa2,bf16x8 pa3){
  #pragma unroll
  for(int d0=0;d0<2;++d0){s16x4 lo[4],hi[4];
    #pragma unroll
    for(int ks=0;ks<4;++ks){
      asm volatile("ds_read_b64_tr_b16 %0,%1 offset:%c2":"=&v"(lo[ks]):"v"(vb),"i"(d0*4096+ks*1024):"memory");
      asm volatile("ds_read_b64_tr_b16 %0,%1 offset:%c2":"=&v"(hi[ks]):"v"(vb),"i"(d0*4096+ks*1024+512):"memory");}
    asm volatile("s_waitcnt lgkmcnt(0)":::"memory");SBAR();
    #define PK(k) (bf16x8){lo[k][0],lo[k][1],lo[k][2],lo[k][3],hi[k][0],hi[k][1],hi[k][2],hi[k][3]}
    o[d0]=__builtin_amdgcn_mfma_f32_32x32x16_bf16(pa0,PK(0),o[d0],0,0,0);
    o[d0]=__builtin_amdgcn_mfma_f32_32x32x16_bf16(pa1,PK(1),o[d0],0,0,0);
    o[d0]=__builtin_amdgcn_mfma_f32_32x32x16_bf16(pa2,PK(2),o[d0],0,0,0);
    o[d0]=__builtin_amdgcn_mfma_f32_32x32x16_bf16(pa3,PK(3),o[d0],0,0,0);
    #undef PK
  }
}

#ifndef ATTN_STORE16
#define ATTN_STORE16(p,v) (*(u32x4*)(p)=(v))
#endif
template<int THRL> __device__ __forceinline__ void attn_unit(int b,int h,int kvh,int qb,const bf16*Q,const bf16*__restrict__ K,const bf16*__restrict__ V,bf16*O,char*shm,const int wave_id){
  const int tid=MK_TID(wave_id),lane=tid&63,r32=lane&31,hi=lane>>5; const int wid=__builtin_amdgcn_readfirstlane(tid>>6);
  const long rowbase=(long)b*NQ; const int q0=qb*QB;
  const bf16*Qw=Q+(rowbase+q0+wid*QBLK)*QP+h*D;
  const bf16*Kh=K+(long)b*NKEYS*KP+kvh*D,*Vh=V+(long)b*NKEYS*KP+kvh*D;
  const unsigned lds0=(unsigned)(uintptr_t)shm;
  float*wsf=(float*)(shm+LDS_WS)+wid*64;
  const bf16*ksrc=Kh+(long)lane*KP+wid*8;
  const bf16*vsrc=Vh+(long)(16*(wid&3)+(lane>>2))*KP+(wid>>2)*32+(lane&3)*8;
  const unsigned kdst=lds0+LDS_K+wid*1024, vdst=lds0+LDS_V+wid*1024;
  #define DMA_K(t,slot) glds16(ksrc+(long)(t)*KVBLK*KP,(unsigned)__builtin_amdgcn_readfirstlane(kdst+(slot)))
  #define DMA_V(t,slot) glds16(vsrc+(long)(t)*KVBLK*KP,(unsigned)__builtin_amdgcn_readfirstlane(vdst+(slot)))
  const int vb0=(int)(lds0+LDS_V)+((lane>>4)&1)*32+(lane&3)*8+(4*hi+((lane&15)>>2))*64;
  const char*Kbase=shm+LDS_K; bf16x8 kf[8];
  const lds_cptr shm3=(lds_cptr)shm; const lds_cptr kp0=shm3+LDS_K+hi*1024+r32*16; const lds_cptr vp0=shm3+LDS_V+((lane>>4)&1)*32+(lane&3)*8+(4*hi+((lane&15)>>2))*64;
  constexpr int NT=NKEYS/KVBLK;
  DMA_K(0,0);DMA_V(0,0);DMA_K(1,SLOTB);
  bf16x8 qr[4];
  #pragma unroll
  for(int d0=0;d0<4;++d0)qr[d0]=*reinterpret_cast<const bf16x8*>(&Qw[(long)r32*QP+d0*16+hi*8]);
  float mhat=0.f,l_reg=0.f;f32x16 o[2];o[0]=f32x16{};o[1]=f32x16{};f32x16 negm=f32x16{};asm volatile("":"+v"(negm));
  #define CMASK(P0,P1,t) do{}while(0)
  bool resc=false;
  #define START(P0,P1) do{ const float rm=rowmax(P0,P1); resc=false; \
    { const float dl=rm; mhat=fadd_s(mhat,dl); \
      _Pragma("unroll") for(int r=0;r<16;++r){P0[r]=fsub_s(P0[r],dl);P1[r]=fsub_s(P1[r],dl);} \
      _Pragma("unroll") for(int r=0;r<16;++r)negm[r]=-mhat; asm volatile("":"+v"(negm)); } \
    _Pragma("unroll") for(int r=0;r<16;++r)P0[r]=__builtin_amdgcn_exp2f(P0[r]); }while(0)
  #define RESC() do{ if(resc){ asm volatile("s_waitcnt lgkmcnt(0)":::"memory"); \
      _Pragma("unroll") for(int d_=0;d_<2;++d_) _Pragma("unroll") for(int r=0;r<16;++r)o[d_][r]*=wsf[crow(r,hi)]; } }while(0)
  f32x16 pA0,pA1,pB0,pB1;
  int sl_prev=0,sl_cur=0,sl_next=SLOTB;
  #define ROT() do{sl_prev=sl_cur;sl_cur=sl_next;sl_next=(sl_next==(NSLOT-1)*SLOTB)?0:sl_next+SLOTB;}while(0)
  DMA_K(2,2*SLOTB);
  WAIT_BAR(3);
  qkt(pA0,pA1,Kbase,qr,negm,r32,hi);asm volatile("s_nop 15\n\ts_nop 7":"+v"(pA0),"+v"(pA1));CMASK(pA0,pA1,0);
  START(pA0,pA1);
  _Pragma("unroll") for(int r=0;r<16;++r)pA1[r]=__builtin_amdgcn_exp2f(pA1[r]);
  WAIT_BAR(0);
  DMA_K(3,0);DMA_V(1,SLOTB);
  ROT();
  kload8(kf,kp0+sl_cur);
  WAIT_BAR(2);
  s16x4 vlo[8],vhi[8]; u32x4 pw0,pw1,pw2,pw3;
  #define PKW(P,B) cvtpk_s(P[B],P[B+1])
  #define PAF(k) __builtin_bit_cast(bf16x8,pw##k)
  #define VFR(i) (bf16x8){vlo[i][0],vlo[i][1],vlo[i][2],vlo[i][3],vhi[i][0],vhi[i][1],vhi[i][2],vhi[i][3]}
  #define PIN(x) asm volatile("":"+v"(x))
  #define MX3(a,b,c) __builtin_fmaxf(__builtin_fmaxf((a),(b)),(c))
  #define GAPA(MF,A0,A1,A2,A3,W0,W1,PW) do{ MF; sacc+=A0; sacc+=A1; sacc+=A2; sacc+=A3; PIN(sacc); W0; W1; PIN(PW); SBAR(); }while(0)
  #define EX(v) __builtin_amdgcn_exp2f(v)
  #define GAPB(MF,X,B) do{ MF; X[B]=EX(X[B]); X[B+1]=EX(X[B+1]); X[B+2]=EX(X[B+2]); X[B+3]=EX(X[B+3]); PIN(X); SBAR(); }while(0)
  #define VRD(i) do{ vlo[i]=vtr(vp_+(((i)>>2)*4096+((i)&3)*1024)); vhi[i]=vtr(vp_+(((i)>>2)*4096+((i)&3)*1024+512)); }while(0)
  #define KRD(G,j) do{ if(G){ kload2(kf,kp0+sl_next,j); SBAR(); } }while(0)
  #define STEP(C0,C1,P0,P1,t,GK,GV,GL) do{ SBAR(); \
    const lds_cptr vp_=vp0+sl_prev; \
    VRD(0); SBAR(); float sacc=(P0[0]+P0[1]); \
    GAPA(C0=__builtin_amdgcn_mfma_f32_32x32x16_bf16(kf[0],qr[0],negm,0,0,0), P0[2],P0[3],P0[4],P0[5],     pw0[0]=PKW(P0,0), pw0[1]=PKW(P0,2), pw0); \
    VRD(4); SBAR(); GAPA(C1=__builtin_amdgcn_mfma_f32_32x32x16_bf16(kf[1],qr[0],negm,0,0,0), P0[6],P0[7],P0[8],P0[9],     pw0[2]=PKW(P0,4), pw0[3]=PKW(P0,6), pw0); \
    VRD(1); SBAR(); GAPA(C0=__builtin_amdgcn_mfma_f32_32x32x16_bf16(kf[2],qr[1],C0,0,0,0),   P0[10],P0[11],P0[12],P0[13], pw1[0]=PKW(P0,8), pw1[1]=PKW(P0,10), pw1); \
    VRD(5); SBAR(); GAPA(C1=__builtin_amdgcn_mfma_f32_32x32x16_bf16(kf[3],qr[1],C1,0,0,0),   P0[14],P0[15],P1[0],P1[1],   pw1[2]=PKW(P0,12),pw1[3]=PKW(P0,14), pw1); \
    VRD(2); SBAR(); GAPA(C0=__builtin_amdgcn_mfma_f32_32x32x16_bf16(kf[4],qr[2],C0,0,0,0),   P1[2],P1[3],P1[4],P1[5],     pw2[0]=PKW(P1,0), pw2[1]=PKW(P1,2), pw2); \
    VRD(6); SBAR(); GAPA(C1=__builtin_amdgcn_mfma_f32_32x32x16_bf16(kf[5],qr[2],C1,0,0,0),   P1[6],P1[7],P1[8],P1[9],     pw2[2]=PKW(P1,4), pw2[3]=PKW(P1,6), pw2); \
    VRD(3); SBAR(); GAPA(C0=__builtin_amdgcn_mfma_f32_32x32x16_bf16(kf[6],qr[3],C0,0,0,0),   P1[10],P1[11],P1[12],P1[13], pw3[0]=PKW(P1,8), pw3[1]=PKW(P1,10), pw3); \
    VRD(7); SBAR(); GAPA(C1=__builtin_amdgcn_mfma_f32_32x32x16_bf16(kf[7],qr[3],C1,0,0,0),   P1[14],P1[15],0.f,0.f,       pw3[2]=PKW(P1,12),pw3[3]=PKW(P1,14), pw3); \
    l_reg+=sacc; \
    if(GK){DMA_K((t)+3,sl_cur);} if(GV){DMA_V((t)+1,sl_next);} \
    CMASK(C0,C1,t); \
    { float a=MX3(C0[0],C0[1],C1[0]),b=MX3(C0[2],C0[3],C1[1]); a=MX3(a,C1[2],C1[3]); \
      _Pragma("unroll") for(int r=4;r<16;r+=4){a=MX3(a,C0[r],C0[r+1]);b=MX3(b,C0[r+2],C0[r+3]);a=MX3(a,C1[r],C1[r+1]);b=MX3(b,C1[r+2],C1[r+3]);} \
      float rm=__builtin_fmaxf(a,b); { auto rr=__builtin_amdgcn_permlane32_swap(__float_as_uint(rm),__float_as_uint(rm),false,false); rm=__builtin_fmaxf(__uint_as_float(rr[0]),__uint_as_float(rr[1])); } \
      resc=false; \
      if(__builtin_expect(__any(rm>(float)THRL),0)){ const float dl=__builtin_fmaxf(rm,0.f); mhat+=dl; \
        _Pragma("unroll") for(int r=0;r<16;++r){C0[r]-=dl;C1[r]-=dl;} \
        _Pragma("unroll") for(int r=0;r<16;++r)negm[r]=-mhat; asm volatile("":"+v"(negm)); \
        const float f=__builtin_amdgcn_exp2f(-dl); l_reg*=f; if(hi==0)wsf[r32]=f; resc=true; } } \
    SBAR(); \
    GAPB(o[0]=__builtin_amdgcn_mfma_f32_32x32x16_bf16(PAF(0),VFR(0),o[0],0,0,0), C0,0); \
    GAPB(o[1]=__builtin_amdgcn_mfma_f32_32x32x16_bf16(PAF(0),VFR(4),o[1],0,0,0), C0,4); \
    KRD(GL,0); GAPB(o[0]=__builtin_amdgcn_mfma_f32_32x32x16_bf16(PAF(1),VFR(1),o[0],0,0,0), C0,8); \
    KRD(GL,1); GAPB(o[1]=__builtin_amdgcn_mfma_f32_32x32x16_bf16(PAF(1),VFR(5),o[1],0,0,0), C0,12); \
    KRD(GL,2); GAPB(o[0]=__builtin_amdgcn_mfma_f32_32x32x16_bf16(PAF(2),VFR(2),o[0],0,0,0), C1,0); \
    KRD(GL,3); GAPB(o[1]=__builtin_amdgcn_mfma_f32_32x32x16_bf16(PAF(2),VFR(6),o[1],0,0,0), C1,4); \
    GAPB(o[0]=__builtin_amdgcn_mfma_f32_32x32x16_bf16(PAF(3),VFR(3),o[0],0,0,0), C1,8); \
    GAPB(o[1]=__builtin_amdgcn_mfma_f32_32x32x16_bf16(PAF(3),VFR(7),o[1],0,0,0), C1,12); \
    }while(0)
  int t=1;
  for(;t+5<NT;t+=2){
    STEP(pB0,pB1,pA0,pA1,t,true,true,true);     WAIT_BAR(2); RESC(); ROT();
    STEP(pA0,pA1,pB0,pB1,t+1,true,true,true);   WAIT_BAR(2); RESC(); ROT();
  }
  #define ENDW(tt) do{ if((tt)+3<NT){WAIT_BAR(2);} else if((tt)+2<NT){WAIT_BAR(1);} else {WAIT_BAR(0);} }while(0)
  for(;t+1<NT;t+=2){
    STEP(pB0,pB1,pA0,pA1,t,(t+3<NT),(t+1<NT),(t+1<NT));       ENDW(t);   RESC(); ROT();
    STEP(pA0,pA1,pB0,pB1,t+1,(t+4<NT),(t+2<NT),(t+2<NT));     ENDW(t+1); RESC(); ROT();
  }
  STEP(pB0,pB1,pA0,pA1,NT-1,false,false,false); RESC();
  { float sacc=pB0[0]+pB0[1]; _Pragma("unroll") for(int r=2;r<16;++r)sacc+=pB0[r]; _Pragma("unroll") for(int r=0;r<16;++r)sacc+=pB1[r]; l_reg+=sacc;
    pw0=(u32x4){PKW(pB0,0),PKW(pB0,2),PKW(pB0,4),PKW(pB0,6)};pw1=(u32x4){PKW(pB0,8),PKW(pB0,10),PKW(pB0,12),PKW(pB0,14)};pw2=(u32x4){PKW(pB1,0),PKW(pB1,2),PKW(pB1,4),PKW(pB1,6)};pw3=(u32x4){PKW(pB1,8),PKW(pB1,10),PKW(pB1,12),PKW(pB1,14)};
    SBAR(); pv(o,vb0+sl_cur,PAF(0),PAF(1),PAF(2),PAF(3)); }
  #undef PKW
  #undef PAF
  #undef VFR
  #undef PIN
  #undef MX3
  #undef GAPA
  #undef GAPB
  #undef EX
  #undef VRD
  #undef KRD
  #undef STEP
  #undef ENDW
  {auto rr=__builtin_amdgcn_permlane32_swap(__float_as_uint(l_reg),__float_as_uint(l_reg),false,false);l_reg=__uint_as_float(rr[0])+__uint_as_float(rr[1]);}
  if(hi==0)wsf[32+r32]=l_reg;asm volatile("s_waitcnt lgkmcnt(0)":::"memory");
  float rli[16];
  #pragma unroll
  for(int r=0;r<16;++r)rli[r]=__builtin_amdgcn_rcpf(wsf[32+crow(r,hi)]);
  bf16*Ow=O+(rowbase+q0+wid*QBLK)*OP+h*D;
  { bf16*stg=(bf16*)(shm+LDS_OST)+wid*2048;
    #pragma unroll
    for(int r=0;r<16;++r){const int orow=crow(r,hi);
      #pragma unroll
      for(int d0=0;d0<2;++d0)stg[orow*64+d0*32+r32]=__float2bfloat16(o[d0][r]*rli[r]);}
    asm volatile("s_waitcnt lgkmcnt(0)":::"memory");
    #pragma unroll
    for(int i=0;i<4;++i){const int row=i*8+(lane>>3),ch=lane&7; const u32x4 v=*(const u32x4*)(stg+row*64+ch*8); ATTN_STORE16(Ow+(long)row*OP+ch*8,v);} }
  asm volatile("s_waitcnt lgkmcnt(0)\n\ts_barrier":::"memory");
  #undef DMA_K
  #undef DMA_V
  #undef CMASK
  #undef START
  #undef RESC
  #undef ROT
}
constexpr int ATTN_LDS_BYTES=LDS_BYTES;
#undef SBAR
#undef WAIT_BAR
}
typedef GAS unsigned gu32;
typedef GAS unsigned long long gu64;
#define RLX_AGENT __ATOMIC_RELAXED, __HIP_MEMORY_SCOPE_AGENT

#define XB_TMO      128
#define XB_XCNT(j)  (256  + 64 * (j))
#define XB_XSUB(j)  (1280 + 64 * (j))
#define XB_XGEN(j)  (2304 + 64 * (j))
#define XB_TOP      3328
#define XB_TOPGEN   3392
#define XCD_BAR_WORDS 3456
#define XB_SPIN_CAP (1u << 18)

__device__ __forceinline__ unsigned xb_ld(unsigned* p)              { return __hip_atomic_load(p, __ATOMIC_RELAXED, __HIP_MEMORY_SCOPE_AGENT); }
__device__ __forceinline__ unsigned xb_add(unsigned* p, unsigned v) { return __hip_atomic_fetch_add(p, v, __ATOMIC_RELAXED, __HIP_MEMORY_SCOPE_AGENT); }
__device__ __forceinline__ unsigned xb_xcc_id() { return (unsigned)__builtin_amdgcn_s_getreg((3 << 11) | 20) & 0xFu; }
#define XB_SPIN(cond, bar) do { unsigned _sp = 0; while (cond) { __builtin_amdgcn_s_sleep(1); \
    if ((++_sp & 255u) == 0u) { if (xb_ld(&(bar)[XB_TMO])) break; if (_sp > XB_SPIN_CAP) { atomicAdd(&(bar)[XB_TMO], 1u); break; } } } } while (0)

struct XcdBarrier {
    unsigned* bar; unsigned x;
    volatile LAS unsigned* st;
};

__device__ __forceinline__ XcdBarrier xcd_barrier_post(unsigned* bar, volatile LAS unsigned* st, const bool is_t0) {
    XcdBarrier b; b.bar = bar; b.x = xb_xcc_id(); b.st = st;
    if (is_t0) (void)xb_add(&bar[XB_XCNT(b.x)], 1u);
    return b;
}
__device__ __forceinline__ void xcd_barrier_complete(unsigned* bar, unsigned x, unsigned& nloc, unsigned& nx) {
    const unsigned G = gridDim.x * gridDim.y * gridDim.z;
    unsigned sum, cnt, mine, sp = 0u;
    for (;;) {
        sum = 0u; cnt = 0u; mine = 0u;
#pragma unroll
        for (unsigned j = 0; j < 16; ++j) { const unsigned c = xb_ld(&bar[XB_XCNT(j)]); sum += c; cnt += (c > 0u) ? 1u : 0u; mine = (j == x) ? c : mine; }
        if (sum == G) break;
        __builtin_amdgcn_s_sleep(1);
        if ((++sp & 255u) == 0u) { if (xb_ld(&bar[XB_TMO])) break; if (sp > XB_SPIN_CAP) { atomicAdd(&bar[XB_TMO], 1u); break; } }
    }
    nloc = mine > 0u ? mine : 1u; nx = cnt > 0u ? cnt : 1u;
}

__device__ __forceinline__ void xcd_barrier(const XcdBarrier& b, const bool is_t0) {
    asm volatile("s_waitcnt vmcnt(0)" ::: "memory");
    __syncthreads();
    if (is_t0) {
        unsigned* bar = b.bar;
        __builtin_amdgcn_s_waitcnt(0);
        unsigned nloc = b.st[0], nx = b.st[1];
        if (nloc == 0u) { xcd_barrier_complete(bar, b.x, nloc, nx); b.st[0] = nloc; b.st[1] = nx; }
        const unsigned old = xb_add(&bar[XB_XSUB(b.x)], 1u);
        const unsigned gen = old / nloc;
        if (old + 1u == (gen + 1u) * nloc) {
            __builtin_amdgcn_fence(__ATOMIC_RELEASE, "agent");
            asm volatile("s_waitcnt vmcnt(0)" ::: "memory");
            const unsigned og = xb_add(&bar[XB_TOP], 1u);
            const unsigned tg = og / nx;
            if (og + 1u == (tg + 1u) * nx) xb_add(&bar[XB_TOPGEN], 1u);
            else XB_SPIN(xb_ld(&bar[XB_TOPGEN]) == tg, bar);
            __builtin_amdgcn_fence(__ATOMIC_ACQUIRE, "agent");
            xb_add(&bar[XB_XGEN(b.x)], 1u);
            asm volatile("s_waitcnt vmcnt(0)" ::: "memory");
        } else {
            XB_SPIN(xb_ld(&bar[XB_XGEN(b.x)]) == gen, bar);
            __builtin_amdgcn_fence(__ATOMIC_ACQUIRE, "agent");
            asm volatile("s_waitcnt vmcnt(0)" ::: "memory");
        }
    }
    __syncthreads();
}
#define FLANE lane_id()
#define FTID MK_TID(F.wave)
struct Ctx {
    LAS unsigned char* lds;
    unsigned char* ws;
    int wave, G, vcu, bx;
    const float* in[22];
    float* out;
};
enum { I_X = 0, I_C, I_CTX, I_CCTX, I_WMOD, I_BMOD, I_N1W, I_N2W, I_WIN, I_QNW, I_KNW, I_DFW, I_DBW, I_WOUT, I_RW, I_RB, I_EWG, I_EWU, I_EWD, I_SWG, I_SWU, I_SWD };

__device__ __forceinline__ float wave_sum(float v) {
#pragma unroll
    for (int o = 1; o < 64; o <<= 1) v += __shfl_xor(v, o);
    return v;
}

__device__ __forceinline__ void p0_transpose_item(const float* W, int K, int N, bf16_t* WT, int kb, int nb, int dst_row0, LAS float* scr, int lane, int mode) {
    const int k0 = 64 * kb, n0 = 32 * nb;
#pragma unroll 8
    for (int i = 0; i < 32; ++i) { const int kk = 2 * i + (lane >> 5); scr[kk * 33 + (lane & 31)] = W[(size_t)(k0 + kk) * N + n0 + (lane & 31)]; }
    LDS_WAIT(); asm volatile("" ::: "memory");
    const int c = lane & 7;
#pragma unroll
    for (int j = 0; j < 4; ++j) { const int n = (lane >> 3) + 8 * j; const LAS float* s = scr + (8 * c) * 33 + n;
        float v[8];
#pragma unroll
        for (int q = 0; q < 8; ++q) v[q] = s[q * 33];
        if (mode == 1) {
#pragma unroll
            for (int q = 0; q < 8; ++q) v[q] = v[q] - bf2f((unsigned short)f2bf(v[q]));
        }
        u32x4 o; o.x = pk2(v[0], v[1]); o.y = pk2(v[2], v[3]); o.z = pk2(v[4], v[5]); o.w = pk2(v[6], v[7]);
        *(GAS u32x4*)(WT + (size_t)(dst_row0 + n) * K + k0 + 8 * c) = o; }
    LDS_WAIT(); asm volatile("" ::: "memory");
}

__device__ __forceinline__ void phase_p0(Ctx& F) {
    float* modv = (float*)(F.ws + WS_MODV);
    if (F.bx < 96) {
        LAS float* sc = (LAS float*)F.lds;
        LAS float* red = sc + 9 * 1024;
        for (int i = FTID; i < 9 * 1024; i += NTHR) { const int r = i >> 10, k = i & 1023; const float v = r < NB ? F.in[I_C][r * D + k] : F.in[I_CCTX][k]; sc[i] = siluf(v); }
        __syncthreads();
        const int col = F.bx * 64 + FLANE;
        const float* Wm = F.in[I_WMOD] + (size_t)(F.wave * 128) * (6 * D) + col;
        float acc[9];
#pragma unroll
        for (int r = 0; r < 9; ++r) acc[r] = 0.f;
#pragma unroll 16
        for (int k = 0; k < 128; ++k) {
            const float wv = Wm[(size_t)k * (6 * D)];
#pragma unroll
            for (int r = 0; r < 9; ++r) acc[r] += sc[r * 1024 + F.wave * 128 + k] * wv;
        }
#pragma unroll
        for (int r = 0; r < 9; ++r) red[(F.wave * 9 + r) * 64 + FLANE] = acc[r];
        __syncthreads();
        for (int i = FTID; i < 9 * 64; i += NTHR) { const int r = i >> 6, l = i & 63; float s = 0.f;
#pragma unroll
            for (int w = 0; w < 8; ++w) s += red[(w * 9 + r) * 64 + l];
            modv[(size_t)r * (6 * D) + F.bx * 64 + l] = s + F.in[I_BMOD][F.bx * 64 + l]; }
        __syncthreads();
    }
    {
        LAS float* scr = (LAS float*)(F.lds + 57344 + F.wave * 8704);
        const int gw = ((F.bx + F.G - 96) % F.G) * NWAVES + F.wave, NGW = F.G * NWAVES;
        constexpr int I_IN = 16 * (INC / 32), I_OUT = 16 * (D / 32), I_R = 16 * (NE / 32), I_SG = 16 * (FF / 32), I_SD = 4 * (D / 32);
        constexpr int NITEMS = I_IN + I_OUT + 2 * I_R + 2 * I_SG + I_SD;
        for (int it = gw; it < NITEMS; it += NGW) {
            int r = it;
            if (r < I_IN) { const int nblk = INC / 32; p0_transpose_item(F.in[I_WIN], D, INC, (bf16_t*)(F.ws + WS_WIN), r / nblk, r % nblk, 32 * (r % nblk), scr, FLANE, 0); continue; } r -= I_IN;
            if (r < I_OUT) { const int nblk = D / 32; p0_transpose_item(F.in[I_WOUT], D, D, (bf16_t*)(F.ws + WS_WOUT), r / nblk, r % nblk, 32 * (r % nblk), scr, FLANE, 0); continue; } r -= I_OUT;
            if (r < 2 * I_R) { const int lo = r >= I_R; const int q = r - lo * I_R; const int nblk = NE / 32;
                p0_transpose_item(F.in[I_RW], D, NE, (bf16_t*)(F.ws + WS_WR), q / nblk, q % nblk, lo * 256 + 32 * (q % nblk), scr, FLANE, lo); continue; } r -= 2 * I_R;
            if (r < 2 * I_SG) { const int up = r >= I_SG; const int q = r - up * I_SG; const int nblk = FF / 32, nb = q % nblk;
                p0_transpose_item(F.in[up ? I_SWU : I_SWG], D, FF, (bf16_t*)(F.ws + WS_WSGU), q / nblk, nb, (nb >> 2) * 256 + up * 128 + (nb & 3) * 32, scr, FLANE, 0); continue; } r -= 2 * I_SG;
            { const int nblk = D / 32; p0_transpose_item(F.in[I_SWD], FF, D, (bf16_t*)(F.ws + WS_WSD), r / nblk, r % nblk, 32 * (r % nblk), scr, FLANE, 0); }
        }
    }
    if (F.bx == F.G - 1) {
        float2* tab = (float2*)(F.ws + WS_ROPE);
        for (int i = FTID; i < 96 * 16; i += NTHR) { const int p = i >> 4, fi = i & 15; const float pos = (float)(p < 32 ? p : p - 32);
            const float ang = pos * powf(10000.f, -(float)fi / 16.f); tab[i] = make_float2(cosf(ang), sinf(ang)); }
    }
}

__device__ __forceinline__ void phase_p0b(Ctx& F) {
    const float* modv = (const float*)(F.ws + WS_MODV);
    bf16_t* HB = (bf16_t*)(F.ws + WS_HB);
    const int gw = F.vcu * NWAVES + F.wave, NGW = F.G * NWAVES;
    f32x4 nw[4];
#pragma unroll
    for (int j = 0; j < 4; ++j) nw[j] = ((const f32x4*)F.in[I_N1W])[FLANE + 64 * j];
    for (int m = gw; m < TALL; m += NGW) {
        const float* xrow = m < T ? F.in[I_X] + (size_t)m * D : F.in[I_CTX] + (size_t)(m - T) * D;
        const int r = m < T ? m / L : 8;
        const f32x4* sh = (const f32x4*)(modv + (size_t)r * (6 * D)); const f32x4* sc = sh + D / 4;
        f32x4 v[4]; float s = 0.f;
#pragma unroll
        for (int j = 0; j < 4; ++j) { v[j] = ((const f32x4*)xrow)[FLANE + 64 * j]; s += (v[j].x * v[j].x + v[j].y * v[j].y) + (v[j].z * v[j].z + v[j].w * v[j].w); }
        const float rinv = rsqrtf(wave_sum(s) * (1.f / D) + EPS);
        unsigned long long* o8 = (unsigned long long*)(HB + (size_t)m * D) + FLANE;
#pragma unroll
        for (int j = 0; j < 4; ++j) { const f32x4 a = sh[FLANE + 64 * j], b = sc[FLANE + 64 * j];
            const f32x4 o = v[j] * rinv * nw[j] * (1.f + b) + a;
            o8[64 * j] = (unsigned long long)pk2(o.x, o.y) | ((unsigned long long)pk2(o.z, o.w) << 32); }
    }
}

struct P1Order {
    int x, j;
    __device__ __forceinline__ bool next(int i, pg8::Unit& u) const {
        const int q = i * 32 + j;
        if (q < 88) { u.pm = x * 8 + q / 11; u.pn = q % 11; return true; }
        if (q < 93) { u.pm = 64 + x; u.pn = q - 88; return true; }
        return false;
    }
    __device__ __forceinline__ void a_ready(const pg8::Unit&) const {}
    __device__ __forceinline__ void done(const pg8::Unit&) const {}
};
struct EpiP1 {
    static constexpr bool PERM = true, HEADPERM = true, AFTER_DRAIN = false;
    unsigned char* ws; const float* qnw; const float* knw;
    __device__ __forceinline__ void operator()(const f32x4 (&acc)[2][2][4][2], const pg8::Unit& u, int wr, int wc, int fr, int fq) const {
        const int G = u.pn * 4 + wc;
        const bool isctx = u.pm >= 64;
        int kind, hh; bf16_t* base; int pitch;
        if (G < 2) { kind = 0; hh = G; base = (bf16_t*)(ws + WS_KB); pitch = 128; }
        else if (G < 4) { kind = 1; hh = G - 2; base = (bf16_t*)(ws + WS_VB); pitch = 128; }
        else if (G < 12) { kind = 2; hh = G - 4; base = (bf16_t*)(ws + WS_RKB); pitch = 512; }
        else if (G < 20) { kind = 1; hh = G - 12; base = (bf16_t*)(ws + WS_RVB); pitch = 512; }
        else if (G < 28) { kind = 0; hh = G - 20; base = (bf16_t*)(ws + WS_QB); pitch = 512; }
        else if (G < 36) { kind = 1; hh = G - 28; base = (bf16_t*)(ws + WS_RQB); pitch = 512; }
        else { kind = 3; hh = G - 36; base = (bf16_t*)(ws + WS_RGB); pitch = 512; }
        const bool isq = G >= 20;
        const bool keyrows = G < 20;
        f32x4 nwv[2][2];
        if (kind == 0) {
            const float* nwp = isq ? qnw : knw; const float sc = isq ? C2 : 1.f;
#pragma unroll
            for (int bj = 0; bj < 2; ++bj)
#pragma unroll
                for (int n = 0; n < 2; ++n) nwv[bj][n] = *(const f32x4*)(nwp + 32 * bj + 8 * fq + 4 * n) * sc;
        }
        const float2* tab = (const float2*)(ws + WS_ROPE);
#pragma unroll
        for (int ai = 0; ai < 2; ++ai)
#pragma unroll
            for (int m = 0; m < 4; ++m) {
                const int r = u.pm * 256 + ai * 128 + wr * 64 + m * 16 + fr;
                int b, t; if (!isctx) { b = r >> 11; t = r & 2047; } else { const int rc = r - T; b = rc >> 8; t = rc & 255; }
                const size_t drow = keyrows ? (size_t)b * LK + (isctx ? L + t : t) : (size_t)r;
                bf16_t* dst = base + drow * pitch + hh * 64 + 8 * fq;
                f32x4 v[2][2];
#pragma unroll
                for (int bj = 0; bj < 2; ++bj)
#pragma unroll
                    for (int n = 0; n < 2; ++n) v[bj][n] = acc[ai][bj][m][n];
                if (kind == 0) {
                    float ss = 0.f;
#pragma unroll
                    for (int bj = 0; bj < 2; ++bj)
#pragma unroll
                        for (int n = 0; n < 2; ++n) ss += (v[bj][n].x * v[bj][n].x + v[bj][n].y * v[bj][n].y) + (v[bj][n].z * v[bj][n].z + v[bj][n].w * v[bj][n].w);
                    ss += __shfl_xor(ss, 16); ss += __shfl_xor(ss, 32);
                    const float rinv = rsqrtf(ss * (1.f / 64.f) + EPS);
#pragma unroll
                    for (int bj = 0; bj < 2; ++bj)
#pragma unroll
                        for (int n = 0; n < 2; ++n) v[bj][n] = v[bj][n] * rinv * nwv[bj][n];
                    if (!isctx) {
                        const float2* tr = tab + (t >> 6) * 16 + 4 * fq; const float2* tc = tab + (32 + (t & 63)) * 16 + 4 * fq;
#pragma unroll
                        for (int n = 0; n < 2; ++n) {
                            const f32x4 cr = *(const f32x4*)(tr + 2 * n), cc = *(const f32x4*)(tc + 2 * n);
                            f32x4 a = v[0][n], o;
                            o.x = a.x * cr.x - a.y * cr.y; o.y = a.x * cr.y + a.y * cr.x; o.z = a.z * cr.z - a.w * cr.w; o.w = a.z * cr.w + a.w * cr.z; v[0][n] = o;
                            a = v[1][n];
                            o.x = a.x * cc.x - a.y * cc.y; o.y = a.x * cc.y + a.y * cc.x; o.z = a.z * cc.z - a.w * cc.w; o.w = a.z * cc.w + a.w * cc.z; v[1][n] = o;
                        }
                    }
                } else if (kind == 2) {
#pragma unroll
                    for (int bj = 0; bj < 2; ++bj)
#pragma unroll
                        for (int n = 0; n < 2; ++n) v[bj][n] = v[bj][n] * 0.125f;
                } else if (kind == 3) {
#pragma unroll
                    for (int bj = 0; bj < 2; ++bj)
#pragma unroll
                        for (int n = 0; n < 2; ++n) { v[bj][n].x = siluf(v[bj][n].x); v[bj][n].y = siluf(v[bj][n].y); v[bj][n].z = siluf(v[bj][n].z); v[bj][n].w = siluf(v[bj][n].w); }
                }
#pragma unroll
                for (int bj = 0; bj < 2; ++bj) { u32x4 w; w.x = pg8::cvt_pk_bf16(v[bj][0].x, v[bj][0].y); w.y = pg8::cvt_pk_bf16(v[bj][0].z, v[bj][0].w);
                    w.z = pg8::cvt_pk_bf16(v[bj][1].x, v[bj][1].y); w.w = pg8::cvt_pk_bf16(v[bj][1].z, v[bj][1].w);
                    *(u32x4*)(dst + 32 * bj) = w; }
            }
    }
};
__device__ __forceinline__ void phase_p1(Ctx& F) {
    pg8::Gemm g{(const bf16_t*)(F.ws + WS_HB), (const bf16_t*)(F.ws + WS_WIN), TALL, INC, D};
    P1Order S{F.bx & 7, F.bx >> 3};
    EpiP1 E{F.ws, F.in[I_QNW], F.in[I_KNW]};
    pg8::gemm_phase<EpiP1, P1Order, true, true>(F.lds, g, S, E, F.wave);
}

typedef short v4i16_t __attribute__((ext_vector_type(4)));
typedef __attribute__((address_space(3))) const char* ldsc_ptr;
__device__ __forceinline__ v4i16_t tr_read(ldsc_ptr p) { return __builtin_amdgcn_ds_read_tr16_b64_v4i16((__attribute__((address_space(3))) v4i16_t*)p); }
#define MFMA16(a, b, c) __builtin_amdgcn_mfma_f32_16x16x32_bf16(a, b, c, 0, 0, 0)
constexpr int TRS = 136;
__device__ __forceinline__ int rsw(int r, int ch) { return r * 128 + ((ch ^ (r & 7)) << 4); }
__device__ __forceinline__ float log2_sigmoid(float x) { return -log1pf(__expf(-x)) * 1.4426950408889634f; }
__device__ __forceinline__ bf16x8 tr_frag(ldsc_ptr tile, int rb0, int rb1, int c0, int lane) {
    const int q = (lane & 15) >> 2, p = lane & 3;
    const v4i16_t a = tr_read(tile + (rb0 + q) * TRS + (c0 + 4 * p) * 2);
    const v4i16_t b = tr_read(tile + (rb1 + q) * TRS + (c0 + 4 * p) * 2);
    return (bf16x8){a[0], a[1], a[2], a[3], b[0], b[1], b[2], b[3]};
}

__device__ __forceinline__ void phase_r1(Ctx& F) {
    const bf16_t* RKB = (const bf16_t*)(F.ws + WS_RKB); const bf16_t* RVB = (const bf16_t*)(F.ws + WS_RVB);
    float* CST = (float*)(F.ws + WS_CST);
    ldsc_ptr Vt = (ldsc_ptr)F.lds, Kf = Vt + 128 * TRS, Kb = Kf + 128 * TRS;
    const int lane = FLANE, w = F.wave, fr = lane & 15, fq = lane >> 4;
    for (int u = F.vcu; u < NB * RH * NCH; u += F.G) {
        const int c = u % NCH, h = (u / NCH) % RH, b = u / (NCH * RH);
        const float l2f = log2_sigmoid(F.in[I_DFW][h]), l2b = log2_sigmoid(F.in[I_DBW][h]);
        {
            const int s = FTID >> 2, c16 = (FTID & 3) * 16;
            const size_t g = ((size_t)b * LK + c * 128 + s) * 512 + h * 64 + c16;
            const u32x4 k0 = *(const u32x4*)(RKB + g), k1 = *(const u32x4*)(RKB + g + 8);
            const u32x4 v0 = *(const u32x4*)(RVB + g), v1 = *(const u32x4*)(RVB + g + 8);
            const float wf = exp2f(l2f * (float)(127 - s)), wb = exp2f(l2b * (float)s);
            LAS u32x2* pv = (LAS u32x2*)((LAS char*)F.lds + s * TRS + c16 * 2);
            pv[0] = (u32x2){v0.x, v0.y}; pv[1] = (u32x2){v0.z, v0.w}; pv[2] = (u32x2){v1.x, v1.y}; pv[3] = (u32x2){v1.z, v1.w};
            LAS u32x2* pf = (LAS u32x2*)((LAS char*)F.lds + 128 * TRS + s * TRS + c16 * 2);
            LAS u32x2* pb = (LAS u32x2*)((LAS char*)F.lds + 256 * TRS + s * TRS + c16 * 2);
            const unsigned kk[8] = {k0.x, k0.y, k0.z, k0.w, k1.x, k1.y, k1.z, k1.w};
#pragma unroll
            for (int i = 0; i < 4; ++i) {
                const float a0 = bflo(kk[2 * i]), a1 = bfhi(kk[2 * i]), a2 = bflo(kk[2 * i + 1]), a3 = bfhi(kk[2 * i + 1]);
                pf[i] = (u32x2){pk2(a0 * wf, a1 * wf), pk2(a2 * wf, a3 * wf)};
                pb[i] = (u32x2){pk2(a0 * wb, a1 * wb), pk2(a2 * wb, a3 * wb)};
            }
        }
        __syncthreads();
        const int dir = w >> 2, et = w & 3;
        ldsc_ptr Kt = dir ? Kb : Kf;
        f32x4 acc[4];
#pragma unroll
        for (int dt = 0; dt < 4; ++dt) acc[dt] = (f32x4){0.f, 0.f, 0.f, 0.f};
#pragma unroll
        for (int ks = 0; ks < 4; ++ks) {
            const int rb0 = 32 * ks + 8 * fq, rb1 = rb0 + 4;
            const bf16x8 a = tr_frag(Vt, rb0, rb1, 16 * et, lane);
#pragma unroll
            for (int dt = 0; dt < 4; ++dt) { const bf16x8 bb = tr_frag(Kt, rb0, rb1, 16 * dt, lane); acc[dt] = MFMA16(a, bb, acc[dt]); }
        }
        float* o = CST + ((((size_t)b * RH + h) * NCH + c) * 2 + dir) * 4096;
#pragma unroll
        for (int dt = 0; dt < 4; ++dt)
#pragma unroll
            for (int r = 0; r < 4; ++r) o[(16 * et + 4 * fq + r) * 64 + 16 * dt + fr] = acc[dt][r];
        __syncthreads();
    }
}

__device__ __forceinline__ void ret_unit(Ctx& F, int b, int h, int n) {
    const bf16_t* RKB = (const bf16_t*)(F.ws + WS_RKB); const bf16_t* RVB = (const bf16_t*)(F.ws + WS_RVB);
    const bf16_t* RQB = (const bf16_t*)(F.ws + WS_RQB); const bf16_t* RGB = (const bf16_t*)(F.ws + WS_RGB);
    const float* CST = (const float*)(F.ws + WS_CST); bf16_t* CAT = (bf16_t*)(F.ws + WS_CAT);
    LAS char* base = (LAS char*)F.lds;
    ldsc_ptr Qt = (ldsc_ptr)base, Kt = Qt + 16384, Vt = Kt + 16384, SfT = Vt + 128 * TRS, SbT = SfT + 8192;
    const int lane = FLANE, w = F.wave, fr = lane & 15, fq = lane >> 4;
    const float l2f = log2_sigmoid(F.in[I_DFW][h]), l2b = log2_sigmoid(F.in[I_DBW][h]);
    {
        const int s = FTID >> 2, c2 = (FTID & 3) * 2;
        const size_t gq = ((size_t)b * L + n * 128 + s) * 512 + h * 64 + c2 * 8;
        const size_t gk = ((size_t)b * LK + n * 128 + s) * 512 + h * 64 + c2 * 8;
        const u32x4 q0 = *(const u32x4*)(RQB + gq), q1 = *(const u32x4*)(RQB + gq + 8);
        const u32x4 k0 = *(const u32x4*)(RKB + gk), k1 = *(const u32x4*)(RKB + gk + 8);
        const u32x4 v0 = *(const u32x4*)(RVB + gk), v1 = *(const u32x4*)(RVB + gk + 8);
        *(LAS u32x4*)(base + rsw(s, c2)) = q0; *(LAS u32x4*)(base + rsw(s, c2 + 1)) = q1;
        *(LAS u32x4*)(base + 16384 + rsw(s, c2)) = k0; *(LAS u32x4*)(base + 16384 + rsw(s, c2 + 1)) = k1;
        LAS u32x2* pv = (LAS u32x2*)(base + 32768 + s * TRS + c2 * 16);
        pv[0] = (u32x2){v0.x, v0.y}; pv[1] = (u32x2){v0.z, v0.w}; pv[2] = (u32x2){v1.x, v1.y}; pv[3] = (u32x2){v1.z, v1.w};
        const int e = FTID >> 3, ch = FTID & 7;
        const float* cb = CST + (((size_t)b * RH + h) * NCH) * 2 * 4096 + e * 64 + ch * 8;
        const float gcf = exp2f(l2f * 128.f), gcb = exp2f(l2b * 128.f);
        f32x4 sf0 = {0.f, 0.f, 0.f, 0.f}, sf1 = sf0, sb0 = sf0, sb1 = sf0;
        for (int v = -2; v < n; ++v) { const int cc = v < 0 ? 18 + v : v; const float* p = cb + (size_t)(cc * 2 + 0) * 4096;
            sf0 = sf0 * gcf + *(const f32x4*)p; sf1 = sf1 * gcf + *(const f32x4*)(p + 4); }
        for (int v = 17; v > n; --v) { const float* p = cb + (size_t)(v * 2 + 1) * 4096;
            sb0 = sb0 * gcb + *(const f32x4*)p; sb1 = sb1 * gcb + *(const f32x4*)(p + 4); }
        *(LAS u32x4*)(base + 32768 + 128 * TRS + rsw(e, ch)) = (u32x4){pk2(sf0.x, sf0.y), pk2(sf0.z, sf0.w), pk2(sf1.x, sf1.y), pk2(sf1.z, sf1.w)};
        *(LAS u32x4*)(base + 32768 + 128 * TRS + 8192 + rsw(e, ch)) = (u32x4){pk2(sb0.x, sb0.y), pk2(sb0.z, sb0.w), pk2(sb1.x, sb1.y), pk2(sb1.z, sb1.w)};
    }
    __syncthreads();
    bf16x8 qf[2];
#pragma unroll
    for (int kk = 0; kk < 2; ++kk) qf[kk] = *(const LAS bf16x8*)(Qt + rsw(16 * w + fr, 4 * kk + fq));
    f32x4 sc[8];
#pragma unroll
    for (int nt = 0; nt < 8; ++nt) { sc[nt] = (f32x4){0.f, 0.f, 0.f, 0.f};
#pragma unroll
        for (int kk = 0; kk < 2; ++kk) { const bf16x8 kf = *(const LAS bf16x8*)(Kt + rsw(16 * nt + fr, 4 * kk + fq)); sc[nt] = MFMA16(kf, qf[kk], sc[nt]); } }
    const int cpos = 16 * w + fr;
#pragma unroll
    for (int nt = 0; nt < 8; ++nt)
#pragma unroll
        for (int r = 0; r < 4; ++r) { const int s = 16 * nt + 4 * fq + r; const int df = cpos - s;
            float wgt = 0.f; if (df >= 0) wgt += exp2f(l2f * (float)df); if (df <= 0) wgt += exp2f(l2b * (float)(-df));
            sc[nt][r] *= wgt; }
    f32x4 acc[4], af[4], ab[4];
#pragma unroll
    for (int et = 0; et < 4; ++et) { acc[et] = (f32x4){0.f, 0.f, 0.f, 0.f}; af[et] = acc[et]; ab[et] = acc[et]; }
#pragma unroll
    for (int kk = 0; kk < 4; ++kk) {
        u32x4 pw; pw.x = pk2(sc[2 * kk][0], sc[2 * kk][1]); pw.y = pk2(sc[2 * kk][2], sc[2 * kk][3]); pw.z = pk2(sc[2 * kk + 1][0], sc[2 * kk + 1][1]); pw.w = pk2(sc[2 * kk + 1][2], sc[2 * kk + 1][3]);
        const bf16x8 pb = __builtin_bit_cast(bf16x8, pw);
#pragma unroll
        for (int et = 0; et < 4; ++et) { const bf16x8 va = tr_frag(Vt, 32 * kk + 4 * fq, 32 * kk + 16 + 4 * fq, 16 * et, lane); acc[et] = MFMA16(va, pb, acc[et]); }
    }
#pragma unroll
    for (int et = 0; et < 4; ++et)
#pragma unroll
        for (int kk = 0; kk < 2; ++kk) {
            const bf16x8 sfa = *(const LAS bf16x8*)(SfT + rsw(16 * et + fr, 4 * kk + fq)); af[et] = MFMA16(sfa, qf[kk], af[et]);
            const bf16x8 sba = *(const LAS bf16x8*)(SbT + rsw(16 * et + fr, 4 * kk + fq)); ab[et] = MFMA16(sba, qf[kk], ab[et]);
        }
    const float xif = exp2f(l2f * (float)(cpos + 1)), xib = exp2f(l2b * (float)(128 - cpos));
    float ss = 0.f;
#pragma unroll
    for (int et = 0; et < 4; ++et) { acc[et] = acc[et] + af[et] * xif + ab[et] * xib; ss += (acc[et].x * acc[et].x + acc[et].y * acc[et].y) + (acc[et].z * acc[et].z + acc[et].w * acc[et].w); }
    ss += __shfl_xor(ss, 16); ss += __shfl_xor(ss, 32);
    const float rinv = rsqrtf(ss * (1.f / 64.f) + EPS);
    const size_t row = (size_t)b * L + n * 128 + cpos;
#pragma unroll
    for (int et = 0; et < 4; ++et) {
        const u32x2 gg = *(const u32x2*)(RGB + row * 512 + h * 64 + 16 * et + 4 * fq);
        const f32x4 y = acc[et] * rinv;
        u32x2 o; o.x = pk2(y.x * bflo(gg.x), y.y * bfhi(gg.x)); o.y = pk2(y.z * bflo(gg.y), y.w * bfhi(gg.y));
        *(u32x2*)(CAT + row * D + 512 + h * 64 + 16 * et + 4 * fq) = o;
    }
    __syncthreads();
}

__device__ __forceinline__ void phase_mix(Ctx& F) {
    for (int u = F.vcu; u < NB * AH * (L / 256); u += F.G) {
        const int pair = u >> 5, j = u & 31, b = pair >> 1, kvh = pair & 1, hq = kvh * 4 + (j >> 3), qb = j & 7;
        attn_body::attn_unit<8>(b, hq, kvh, qb, (const attn_body::bf16*)(F.ws + WS_QB), (const attn_body::bf16*)(F.ws + WS_KB), (const attn_body::bf16*)(F.ws + WS_VB),
                                (attn_body::bf16*)(F.ws + WS_CAT), (char*)F.lds, F.wave);
    }
    __syncthreads();
    for (int u = F.vcu; u < NB * RH * (L / 128); u += F.G) { const int n = u & 15, h = (u >> 4) & 7, b = u >> 7; ret_unit(F, b, h, n); }
}

struct EpiX1 {
    static constexpr bool PERM = true, HEADPERM = false, AFTER_DRAIN = false;
    const float* x; const float* modv; float* x1;
    __device__ __forceinline__ void operator()(const f32x4 (&acc)[2][2][4][2], const pg8::Unit& u, int wr, int wc, int fr, int fq) const {
        const int col0 = u.pn * 256 + wc * 32 + 8 * fq;
#pragma unroll
        for (int ai = 0; ai < 2; ++ai)
#pragma unroll
            for (int m = 0; m < 4; ++m) {
                const int r = u.pm * 256 + ai * 128 + wr * 64 + m * 16 + fr; const int b = r >> 11;
                const float* g1 = modv + (size_t)b * (6 * D) + 2 * D;
#pragma unroll
                for (int bj = 0; bj < 2; ++bj)
#pragma unroll
                    for (int n = 0; n < 2; ++n) { const int c = col0 + bj * 128 + 4 * n; const size_t off = (size_t)r * D + c;
                        *(f32x4*)(x1 + off) = *(const f32x4*)(x + off) + *(const f32x4*)(g1 + c) * acc[ai][bj][m][n]; }
            }
    }
};
__device__ __forceinline__ void phase_p4(Ctx& F) {
    pg8::Gemm g{(const bf16_t*)(F.ws + WS_CAT), (const bf16_t*)(F.ws + WS_WOUT), T, D, D};
    pg8::StaticOrder S; S.init(T, D, F.G, F.bx);
    EpiX1 E{F.in[I_X], (const float*)(F.ws + WS_MODV), (float*)(F.ws + WS_X1)};
    pg8::gemm_phase<EpiX1, pg8::StaticOrder, true, true>(F.lds, g, S, E, F.wave);
}

__device__ __forceinline__ void phase_p5(Ctx& F) {
    const float* modv = (const float*)(F.ws + WS_MODV); const float* X1 = (const float*)(F.ws + WS_X1);
    bf16_t* H2 = (bf16_t*)(F.ws + WS_H2B);
    const int gw = F.vcu * NWAVES + F.wave, NGW = F.G * NWAVES;
    f32x4 nw[4];
#pragma unroll
    for (int j = 0; j < 4; ++j) nw[j] = ((const f32x4*)F.in[I_N2W])[FLANE + 64 * j];
    for (int m = gw; m < T; m += NGW) {
        const f32x4* sh = (const f32x4*)(modv + (size_t)(m / L) * (6 * D) + 3 * D); const f32x4* sc = sh + D / 4;
        f32x4 v[4]; float s = 0.f;
#pragma unroll
        for (int j = 0; j < 4; ++j) { v[j] = ((const f32x4*)(X1 + (size_t)m * D))[FLANE + 64 * j]; s += (v[j].x * v[j].x + v[j].y * v[j].y) + (v[j].z * v[j].z + v[j].w * v[j].w); }
        const float rinv = rsqrtf(wave_sum(s) * (1.f / D) + EPS);
        unsigned long long* oh = (unsigned long long*)(H2 + (size_t)m * D) + FLANE; unsigned long long* ol = (unsigned long long*)(H2 + (size_t)(T + m) * D) + FLANE;
#pragma unroll
        for (int j = 0; j < 4; ++j) { const f32x4 a = sh[FLANE + 64 * j], b = sc[FLANE + 64 * j];
            const f32x4 o = v[j] * rinv * nw[j] * (1.f + b) + a;
            const unsigned h0 = pk2(o.x, o.y), h1 = pk2(o.z, o.w);
            oh[64 * j] = (unsigned long long)h0 | ((unsigned long long)h1 << 32);
            const unsigned l0 = pk2(o.x - bflo(h0), o.y - bfhi(h0)), l1 = pk2(o.z - bflo(h1), o.w - bfhi(h1));
            ol[64 * j] = (unsigned long long)l0 | ((unsigned long long)l1 << 32); }
    }
}

struct P6Order {
    int c, G;
    __device__ __forceinline__ bool next(int i, pg8::Unit& u) const {
        const int q = i * G + c; if (q >= 320) return false;
        const int t = q >> 6, m = q & 63;
        u.pm = (t == 1) ? 64 + m : m; u.pn = (t <= 1) ? 0 : t - 1; return true;
    }
    __device__ __forceinline__ void a_ready(const pg8::Unit&) const {}
    __device__ __forceinline__ void done(const pg8::Unit&) const {}
};
struct EpiP6 {
    static constexpr bool PERM = true, HEADPERM = false, AFTER_DRAIN = false;
    float* logp; bf16_t* acts;
    __device__ __forceinline__ void operator()(const f32x4 (&acc)[2][2][4][2], const pg8::Unit& u, int wr, int wc, int fr, int fq) const {
        if (u.pn < 2) {
            const int part = u.pn == 1 ? 2 : (u.pm >= 64 ? 1 : 0); const int pm = u.pm & 63;
            float* o = logp + (size_t)part * T * NE;
#pragma unroll
            for (int ai = 0; ai < 2; ++ai)
#pragma unroll
                for (int m = 0; m < 4; ++m) { const int r = pm * 256 + ai * 128 + wr * 64 + m * 16 + fr;
#pragma unroll
                    for (int bj = 0; bj < 2; ++bj)
#pragma unroll
                        for (int n = 0; n < 2; ++n) *(f32x4*)(o + (size_t)r * NE + bj * 128 + wc * 32 + 8 * fq + 4 * n) = acc[ai][bj][m][n]; }
        } else {
            const int f0 = (u.pn - 2) * 128 + wc * 32 + 8 * fq;
#pragma unroll
            for (int ai = 0; ai < 2; ++ai)
#pragma unroll
                for (int m = 0; m < 4; ++m) { const int r = u.pm * 256 + ai * 128 + wr * 64 + m * 16 + fr;
                    const f32x4 g0 = acc[ai][0][m][0], g1 = acc[ai][0][m][1], u0 = acc[ai][1][m][0], u1 = acc[ai][1][m][1];
                    u32x4 w; w.x = pg8::cvt_pk_bf16(siluf(g0.x) * u0.x, siluf(g0.y) * u0.y); w.y = pg8::cvt_pk_bf16(siluf(g0.z) * u0.z, siluf(g0.w) * u0.w);
                    w.z = pg8::cvt_pk_bf16(siluf(g1.x) * u1.x, siluf(g1.y) * u1.y); w.w = pg8::cvt_pk_bf16(siluf(g1.z) * u1.z, siluf(g1.w) * u1.w);
                    *(u32x4*)(acts + (size_t)r * FF + f0) = w; }
        }
    }
};
__device__ __forceinline__ void phase_p6(Ctx& F) {
    pg8::Gemm g{(const bf16_t*)(F.ws + WS_H2B), (const bf16_t*)(F.ws + WS_WR), 2 * T, 1024, D};
    P6Order S{F.vcu, F.G};
    EpiP6 E{(float*)(F.ws + WS_LOGP), (bf16_t*)(F.ws + WS_ACTS)};
    pg8::gemm_phase<EpiP6, P6Order, true, true>(F.lds, g, S, E, F.wave);
}

__device__ __forceinline__ void phase_p7(Ctx& F) {
    const float* LOGP = (const float*)(F.ws + WS_LOGP); const float* rbias = F.in[I_RB];
    int* RIDX = (int*)(F.ws + WS_RIDX); float* RWT = (float*)(F.ws + WS_RWT);
    int* SDST = (int*)(F.ws + WS_SDST); float* SW = (float*)(F.ws + WS_SW);
    unsigned* ecnt = (unsigned*)(F.ws + WS_CTL) + CW_ECNT;
    const int gw = F.vcu * NWAVES + F.wave, NGW = F.G * NWAVES, lane = FLANE;
    const f32x4 bi = ((const f32x4*)rbias)[lane];
    for (int tok = gw; tok < T; tok += NGW) {
        const f32x4 lg = ((const f32x4*)(LOGP + (size_t)tok * NE))[lane] + ((const f32x4*)(LOGP + (size_t)(T + tok) * NE))[lane] + ((const f32x4*)(LOGP + (size_t)(2 * T + tok) * NE))[lane];
        const float s0 = sigmoidf_(lg.x), s1 = sigmoidf_(lg.y), s2 = sigmoidf_(lg.z), s3 = sigmoidf_(lg.w);
        float v0 = s0 + bi.x, v1 = s1 + bi.y, v2 = s2 + bi.z, v3 = s3 + bi.w;
        float gs = 0.f;
        {
            float a0 = v0, a1 = v1, a2 = v2, a3 = v3;
#pragma unroll
            for (int r = 0; r < 2; ++r) {
                float mv = a0; int mi = lane * 4;
                if (a1 > mv) { mv = a1; mi = lane * 4 + 1; }
                if (a2 > mv) { mv = a2; mi = lane * 4 + 2; }
                if (a3 > mv) { mv = a3; mi = lane * 4 + 3; }
#pragma unroll
                for (int o = 1; o < 8; o <<= 1) { const float ov = __shfl_xor(mv, o); const int oi = __shfl_xor(mi, o); if (ov > mv || (ov == mv && oi < mi)) { mv = ov; mi = oi; } }
                gs += mv;
                if (mi == lane * 4) a0 = -INFINITY; if (mi == lane * 4 + 1) a1 = -INFINITY; if (mi == lane * 4 + 2) a2 = -INFINITY; if (mi == lane * 4 + 3) a3 = -INFINITY;
            }
        }
        const int g = lane >> 3; int rank = 0;
#pragma unroll
        for (int g2 = 0; g2 < 8; ++g2) { const float o = __shfl(gs, g2 * 8); if (o > gs || (o == gs && g2 < g)) ++rank; }
        if (rank >= 4) { v0 = v1 = v2 = v3 = -INFINITY; }
        float wsum = 0.f, myw = 0.f; int myi = 0;
#pragma unroll
        for (int r = 0; r < TOPK; ++r) {
            float mv = v0; int mi = lane * 4;
            if (v1 > mv) { mv = v1; mi = lane * 4 + 1; }
            if (v2 > mv) { mv = v2; mi = lane * 4 + 2; }
            if (v3 > mv) { mv = v3; mi = lane * 4 + 3; }
#pragma unroll
            for (int o = 1; o < 64; o <<= 1) { const float ov = __shfl_xor(mv, o); const int oi = __shfl_xor(mi, o); if (ov > mv || (ov == mv && oi < mi)) { mv = ov; mi = oi; } }
            const int own = mi >> 2, sub = mi & 3;
            float sv = sub == 0 ? s0 : sub == 1 ? s1 : sub == 2 ? s2 : s3;
            sv = __shfl(sv, own);
            wsum += sv;
            if (lane == r) { myw = sv; myi = mi; }
            if (lane == own) { if (sub == 0) v0 = -INFINITY; if (sub == 1) v1 = -INFINITY; if (sub == 2) v2 = -INFINITY; if (sub == 3) v3 = -INFINITY; }
        }
        if (lane < TOPK) {
            const float wt = myw / wsum * 2.5f;
            RIDX[(size_t)tok * TOPK + lane] = myi; RWT[(size_t)tok * TOPK + lane] = wt;
            const unsigned pos = __hip_atomic_fetch_add(ecnt + myi * 64, 1u, __ATOMIC_RELAXED, __HIP_MEMORY_SCOPE_AGENT);
            SDST[(size_t)myi * CAP + pos] = tok * TOPK + lane; SW[(size_t)myi * CAP + pos] = wt;
        }
    }
}

struct EpiSD {
    static constexpr bool PERM = true, HEADPERM = false, AFTER_DRAIN = false;
    const float* x1; const float* modv; float* out;
    __device__ __forceinline__ void operator()(const f32x4 (&acc)[2][2][4][2], const pg8::Unit& u, int wr, int wc, int fr, int fq) const {
        const int col0 = u.pn * 256 + wc * 32 + 8 * fq;
#pragma unroll
        for (int ai = 0; ai < 2; ++ai)
#pragma unroll
            for (int m = 0; m < 4; ++m) {
                const int r = u.pm * 256 + ai * 128 + wr * 64 + m * 16 + fr; const int b = r >> 11;
                const float* g2 = modv + (size_t)b * (6 * D) + 5 * D;
#pragma unroll
                for (int bj = 0; bj < 2; ++bj)
#pragma unroll
                    for (int n = 0; n < 2; ++n) { const int c = col0 + bj * 128 + 4 * n; const size_t off = (size_t)r * D + c;
                        *(f32x4*)(out + off) = *(const f32x4*)(x1 + off) + *(const f32x4*)(g2 + c) * acc[ai][bj][m][n]; }
            }
    }
};

constexpr int TAB_OFF = LDSCTL_OFF + 1024;
constexpr int MOE_BM = 224, MOE_MT = 7, MOE_ACT1 = 0, MOE_ACT0 = MOE_BM * 256, MOE_AST = 0, MOE_ASZ = MOE_BM * 64, MOE_BST = 2 * MOE_BM * 256;
static_assert(MOE_BST + 32768 <= LDSCTL_OFF && 2 * MOE_ASZ <= MOE_ACT0, "MoE LDS map");
__device__ __forceinline__ int sw64(int row, int ch) { return row * 64 + ((ch ^ ((row >> 1) & 3)) << 4); }

__device__ __forceinline__ void moe_unit(Ctx& F, int e, int row0, int nrows) {
    const bf16_t* H2 = (const bf16_t*)(F.ws + WS_H2B);
    const int* SDST = (const int*)(F.ws + WS_SDST) + (size_t)e * CAP + row0; const float* SW = (const float*)(F.ws + WS_SW) + (size_t)e * CAP + row0;
    bf16_t* YEXP = (bf16_t*)(F.ws + WS_YEXP);
    const float* Wg = F.in[I_EWG] + (size_t)e * D * FF; const float* Wu = F.in[I_EWU] + (size_t)e * D * FF; const float* Wd = F.in[I_EWD] + (size_t)e * FF * D;
    LAS char* lds = (LAS char*)F.lds;
    int tid = FTID; asm volatile("" : "+v"(tid));
    const int lane = tid & 63, w = __builtin_amdgcn_readfirstlane(tid >> 6), wr = w >> 2, wc = w & 3, fr = lane & 15, fq = lane >> 4;
    const int mc = (nrows + 31) >> 5;
    const char* H2c = (const char*)H2;
    unsigned asrc0, asrc1; int aw0, aw1;
    { const int r0 = tid >> 2, r1 = (tid + 512) >> 2, ch = tid & 3;
      asrc0 = (unsigned)(((SDST[r0 < nrows ? r0 : 0] >> 3) * D + ch * 8) * 2); asrc1 = (unsigned)(((SDST[(r1 < nrows) ? r1 : 0] >> 3) * D + ch * 8) * 2);
      aw0 = MOE_AST + sw64(r0, ch); aw1 = MOE_AST + sw64(r1 < MOE_BM ? r1 : 0, ch); }
    const bool a2 = tid < 4 * MOE_BM - 512;
    const int bch = w >> 1, bhalf = (w & 1) * 8;
    int pb_gu; { const int ffl = 4 * (lane & 31); pb_gu = 64 * (ffl >> 5) + 32 * (lane >> 5) + (ffl & 31); }
    const int pb_d = 4 * lane;
    const int bw_gu = MOE_BST + pb_gu * 64 + bhalf + ((bch ^ ((pb_gu >> 1) & 3)) << 4), bw_gu2 = MOE_BST + pb_gu * 64 + bhalf + ((bch ^ ((pb_gu >> 1) & 3) ^ 1) << 4);
    const int bw_d = MOE_BST + pb_d * 64 + bhalf + ((bch ^ ((pb_d >> 1) & 3)) << 4), bw_d2 = MOE_BST + pb_d * 64 + bhalf + ((bch ^ ((pb_d >> 1) & 3) ^ 1) << 4);
    const int fsw = ((fq ^ ((fr >> 1) & 3)) << 4);
    const int trow = wr * 16 * mc + fr;
    const int ab = MOE_AST + trow * 64 + fsw;
    const int bb = MOE_BST + (64 * wc + fr) * 64 + fsw;
    f32x4 acc[MOE_MT][4];
    u32x4 ar0a, ar0b, ar1a, ar1b; f32x4 br0[4], br1[4];
#define MOE_ZERO() do { _Pragma("unroll") for (int m = 0; m < MOE_MT; ++m) _Pragma("unroll") for (int n = 0; n < 4; ++n) acc[m][n] = (f32x4){0.f, 0.f, 0.f, 0.f}; } while (0)
#define MOE_MMA(AFR, m) do { _Pragma("unroll") for (int n = 0; n < 4; ++n) acc[m][n] = MFMA16(bfr[n], AFR, acc[m][n]); } while (0)
#define MOE_LDB(BUF) bf16x8 bfr[4]; _Pragma("unroll") for (int n = 0; n < 4; ++n) bfr[n] = *(const LAS bf16x8*)(lds + bb + ((BUF) * 16384 + n * 1024))
#define MOE_BWRITE(BUF, R, o0, o2) do { \
        _Pragma("unroll") for (int i = 0; i < 4; ++i) { u32x2 c; c.x = pg8::cvt_pk_bf16(R[0][i], R[1][i]); c.y = pg8::cvt_pk_bf16(R[2][i], R[3][i]); \
            *(LAS u32x2*)(lds + ((i < 2) ? (o0) : (o2)) + ((BUF) * 16384 + i * 64)) = c; } } while (0)
    {
        const float* bsrc = (lane >> 5 ? Wu : Wg) + (size_t)(4 * w) * FF + 4 * (lane & 31);
#define GU_LOAD(s, RA, RB, RBR) do { const int kk_ = (s) & 31, nt_ = (s) >> 5; \
        RA = *(const u32x4*)(H2c + (size_t)(asrc0 + (unsigned)(kk_ * 64))); RB = *(const u32x4*)(H2c + (size_t)(asrc1 + (unsigned)(kk_ * 64))); \
        const float* bp_ = bsrc + (size_t)(kk_ * 32) * FF + nt_ * 128; \
        _Pragma("unroll") for (int j = 0; j < 4; ++j) RBR[j] = *(const f32x4*)(bp_ + (size_t)j * FF); } while (0)
#define GU_AWRITE(BUF, RA, RB) do { *(LAS u32x4*)(lds + aw0 + (BUF) * MOE_ASZ) = RA; if (a2) *(LAS u32x4*)(lds + aw1 + (BUF) * MOE_ASZ) = RB; } while (0)
#define GU_COMPUTE(BUF) do { MOE_LDB(BUF); \
        _Pragma("unroll") for (int m = 0; m < MOE_MT; ++m) if (m < mc) { const bf16x8 afr = *(const LAS bf16x8*)(lds + ab + ((BUF) * MOE_ASZ + m * 1024)); MOE_MMA(afr, m); } } while (0)
#define GU_EPI(nt) do { \
        _Pragma("unroll") for (int m = 0; m < MOE_MT; ++m) if (m < mc) { const int tr = trow + 16 * m; \
            const float wsl_ = SWl[trow + 16 * m]; \
            _Pragma("unroll") for (int n = 0; n < 2; ++n) { const f32x4 g = acc[m][n], u = acc[m][n + 2]; \
                u32x2 o; o.x = pg8::cvt_pk_bf16(siluf(g.x) * u.x * wsl_, siluf(g.y) * u.y * wsl_); o.y = pg8::cvt_pk_bf16(siluf(g.z) * u.z * wsl_, siluf(g.w) * u.w * wsl_); \
                const int c = 4 * wc + 2 * n + (fq >> 1); \
                *(LAS u32x2*)(lds + ((nt) ? MOE_ACT1 : MOE_ACT0) + tr * 256 + ((c ^ (tr & 15)) << 4) + (fq & 1) * 8) = o; } } \
        MOE_ZERO(); } while (0)
        LAS float* SWl = (LAS float*)(F.lds + TAB_OFF + 4096);
        if (tid < MOE_BM) SWl[tid] = tid < nrows ? SW[tid] : 0.f;
        MOE_ZERO();
        GU_LOAD(0, ar0a, ar0b, br0); GU_LOAD(1, ar1a, ar1b, br1);
        GU_AWRITE(0, ar0a, ar0b); MOE_BWRITE(0, br0, bw_gu, bw_gu2);
        __syncthreads();
#pragma unroll 1
        for (int nt = 0; nt < 2; ++nt) {
#pragma unroll 1
            for (int s = 32 * nt; s < 32 * nt + 32; s += 2) {
                { const int sl = min(s + 2, 63); GU_LOAD(sl, ar0a, ar0b, br0); }
                GU_COMPUTE(0);
                GU_AWRITE(1, ar1a, ar1b); MOE_BWRITE(1, br1, bw_gu, bw_gu2);
                __syncthreads();
                { const int sl = min(s + 3, 63); GU_LOAD(sl, ar1a, ar1b, br1); }
                GU_COMPUTE(1);
                GU_AWRITE(0, ar0a, ar0b); MOE_BWRITE(0, br0, bw_gu, bw_gu2);
                __syncthreads();
            }
            if (nt == 0) { GU_EPI(0); } else { GU_EPI(1); }
        }
#undef GU_LOAD
#undef GU_AWRITE
#undef GU_COMPUTE
#undef GU_EPI
    }
    {
        const float* bsrc = Wd + (size_t)(4 * w) * D + 4 * lane;
#define DN_LOAD(s, RBR) do { const int kk_ = (s) & 7, nt_ = (s) >> 3; const float* bp_ = bsrc + (size_t)(kk_ * 32) * D + nt_ * 256; \
        _Pragma("unroll") for (int j = 0; j < 4; ++j) RBR[j] = *(const f32x4*)(bp_ + (size_t)j * D); } while (0)
#define DN_COMPUTE(BUF, s) do { MOE_LDB(BUF); const int kk_ = (s) & 7; const int abase_ = ((kk_ >> 2) ? MOE_ACT1 : MOE_ACT0) + (((4 * (kk_ & 3) + fq) ^ fr) << 4) + trow * 256; \
        _Pragma("unroll") for (int m = 0; m < MOE_MT; ++m) if (m < mc) { const bf16x8 afr = *(const LAS bf16x8*)(lds + abase_ + m * 4096); MOE_MMA(afr, m); } } while (0)
#define DN_EPI(nt) do { \
        _Pragma("unroll") for (int m = 0; m < MOE_MT; ++m) if (m < mc) { const int d_ = DSTl[trow + 16 * m]; if (d_ >= 0) { \
            _Pragma("unroll") for (int n = 0; n < 4; ++n) { const f32x4 v = acc[m][n]; u32x2 o; o.x = pg8::cvt_pk_bf16(v.x, v.y); o.y = pg8::cvt_pk_bf16(v.z, v.w); \
                *(u32x2*)(YEXP + (size_t)d_ * D + (nt) * 256 + 64 * wc + 16 * n + 4 * fq) = o; } } } \
        MOE_ZERO(); } while (0)
        LAS int* DSTl = (LAS int*)(F.lds + TAB_OFF + 4096 + 1024);
        if (tid < MOE_BM) DSTl[tid] = tid < nrows ? SDST[tid] : -1;
        DN_LOAD(0, br0); DN_LOAD(1, br1);
        __syncthreads();
        MOE_BWRITE(0, br0, bw_d, bw_d2);
        __syncthreads();
#pragma unroll 1
        for (int nt = 0; nt < 4; ++nt) {
#pragma unroll 1
            for (int s = 8 * nt; s < 8 * nt + 8; s += 2) {
                { const int sl = min(s + 2, 31); DN_LOAD(sl, br0); }
                DN_COMPUTE(0, s);
                MOE_BWRITE(1, br1, bw_d, bw_d2);
                __syncthreads();
                { const int sl = min(s + 3, 31); DN_LOAD(sl, br1); }
                DN_COMPUTE(1, s + 1);
                MOE_BWRITE(0, br0, bw_d, bw_d2);
                __syncthreads();
            }
            DN_EPI(nt);
        }
#undef DN_LOAD
#undef DN_COMPUTE
#undef DN_EPI
    }
#undef MOE_ZERO
#undef MOE_MMA
#undef MOE_LDB
#undef MOE_BWRITE
}

__device__ __forceinline__ void phase_moe(Ctx& F) {
    {
        pg8::Gemm g{(const bf16_t*)(F.ws + WS_ACTS), (const bf16_t*)(F.ws + WS_WSD), T, D, FF};
        pg8::StaticOrder S; S.init(T, D, F.G, F.bx);
        EpiSD E{(const float*)(F.ws + WS_X1), (const float*)(F.ws + WS_MODV), F.out};
        pg8::gemm_phase<EpiSD, pg8::StaticOrder, true, true>(F.lds, g, S, E, F.wave);
    }
    __syncthreads();
    LAS int* cnt = (LAS int*)(F.lds + TAB_OFF); LAS int* pstart = cnt + 256; LAS int* tstart = pstart + 257;
    const unsigned* ecnt = (const unsigned*)(F.ws + WS_CTL) + CW_ECNT;
    if (FTID < NE) cnt[FTID] = (int)__hip_atomic_load(ecnt + FTID * 64, __ATOMIC_RELAXED, __HIP_MEMORY_SCOPE_AGENT);
    __syncthreads();
    if (FTID == 0) { int a = 0, t = 0; for (int e = 0; e < NE; ++e) { pstart[e] = a; tstart[e] = t; a += cnt[e]; t += (cnt[e] + MOE_BM - 1) / MOE_BM; } pstart[NE] = a; tstart[NE] = t; }
    __syncthreads();
    const int ntot = tstart[NE];
    for (int u = F.vcu; u < ntot; u += F.G) {
        int lo = 0, hi = NE;
        while (hi - lo > 1) { const int mid = (lo + hi) >> 1; if (tstart[mid] <= u) lo = mid; else hi = mid; }
        const int e = lo, c = cnt[e], nt = (c + MOE_BM - 1) / MOE_BM, mt = u - tstart[e];
        const int rpt = (c + nt - 1) / nt, row0 = mt * rpt, nrows = min(rpt, c - row0);
        if (nrows > 0) moe_unit(F, e, row0, nrows);
    }
}

__device__ __forceinline__ void phase_final(Ctx& F) {
    const float* modv = (const float*)(F.ws + WS_MODV); const bf16_t* YEXP = (const bf16_t*)(F.ws + WS_YEXP);
    const int gw = F.vcu * NWAVES + F.wave, NGW = F.G * NWAVES;
    for (int m = gw; m < T; m += NGW) {
        const float* g2 = modv + (size_t)(m / L) * (6 * D) + 5 * D;
#pragma unroll
        for (int j = 0; j < 2; ++j) {
            const int c = 8 * (FLANE + 64 * j);
            f32x4 s0 = {0.f, 0.f, 0.f, 0.f}, s1 = s0;
#pragma unroll
            for (int k = 0; k < TOPK; ++k) { const u32x4 y = *(const u32x4*)(YEXP + ((size_t)m * TOPK + k) * D + c);
                s0.x += bflo(y.x); s0.y += bfhi(y.x); s0.z += bflo(y.y); s0.w += bfhi(y.y); s1.x += bflo(y.z); s1.y += bfhi(y.z); s1.z += bflo(y.w); s1.w += bfhi(y.w); }
            float* o = F.out + (size_t)m * D + c;
            *(f32x4*)o = *(const f32x4*)o + *(const f32x4*)(g2 + c) * s0; *(f32x4*)(o + 4) = *(const f32x4*)(o + 4) + *(const f32x4*)(g2 + c + 4) * s1;
        }
    }
}
#if DBG
constexpr int GBLK = 64;
constexpr int NSLOT_G = NASSIGN + NE * GBLK;
constexpr int NBLK_G = NSLOT_G / GBLK;
__global__ void __launch_bounds__(256) g_mod(const float* __restrict__ c, const float* __restrict__ cctx, const float* __restrict__ Wm,
                                             const float* __restrict__ bm, float* __restrict__ modv) {
    const int col = blockIdx.x * 256 + threadIdx.x, r = blockIdx.y;
    const float* cv = (r < NB) ? c + (size_t)r * D : cctx;
    float acc = 0.f;
    for (int k = 0; k < D; ++k) acc += siluf(cv[k]) * Wm[(size_t)k * (6 * D) + col];
    modv[(size_t)r * (6 * D) + col] = acc + bm[col];
}

__global__ void __launch_bounds__(256) g_norm_mod(const float* __restrict__ x, const float* __restrict__ w, const float* __restrict__ modv,
                                                  int shift_off, int scale_off, int rows_per_b, int fixed_r, float* __restrict__ out) {
    __shared__ float red[4];
    const int row = blockIdx.x, tid = threadIdx.x;
    const float4 v = ((const float4*)(x + (size_t)row * D))[tid];
    float s = v.x * v.x + v.y * v.y + v.z * v.z + v.w * v.w;
    for (int o = 32; o > 0; o >>= 1) s += __shfl_xor(s, o);
    if ((tid & 63) == 0) red[tid >> 6] = s;
    __syncthreads();
    s = red[0] + red[1] + red[2] + red[3];
    const float rinv = rsqrtf(s * (1.f / D) + EPS);
    const int r = fixed_r >= 0 ? fixed_r : row / rows_per_b;
    const float* mv = modv + (size_t)r * (6 * D);
    const float4 ww = ((const float4*)w)[tid], sh = ((const float4*)(mv + shift_off))[tid], sc = ((const float4*)(mv + scale_off))[tid];
    float4 o;
    o.x = v.x * rinv * ww.x * (1.f + sc.x) + sh.x; o.y = v.y * rinv * ww.y * (1.f + sc.y) + sh.y;
    o.z = v.z * rinv * ww.z * (1.f + sc.z) + sh.z; o.w = v.w * rinv * ww.w * (1.f + sc.w) + sh.w;
    ((float4*)(out + (size_t)row * D))[tid] = o;
}

template <int MODE>
__global__ void __launch_bounds__(256) g_sgemm(const float* __restrict__ A, int lda, const float* __restrict__ B, int ldb, size_t bstride,
                                               float* __restrict__ C, int ldc, int K, const int* __restrict__ slot_tok,
                                               const float* __restrict__ slot_w, const int* __restrict__ blk_e, int ntok) {
    __shared__ float As[16][68];
    __shared__ float Bs[16][68];
    const int bm = blockIdx.y * 64, bn = blockIdx.x * 64, tid = threadIdx.x;
    const float* Bp = B;
    if (MODE == 1 || MODE == 2) { const int e = blk_e[blockIdx.y]; if (e < 0) return; Bp += (size_t)e * bstride; }
    const int tx = tid & 15, ty = tid >> 4;
    float acc[4][4];
#pragma unroll
    for (int i = 0; i < 4; ++i)
#pragma unroll
        for (int j = 0; j < 4; ++j) acc[i][j] = 0.f;
    const int arow = tid >> 2, ak = (tid & 3) * 4;
    bool avalid = true; const float* aptr;
    if (MODE == 1) { const int tok = slot_tok[bm + arow]; avalid = tok < ntok; aptr = A + (size_t)(avalid ? tok : 0) * lda; }
    else aptr = A + (size_t)(bm + arow) * lda;
    const int bk = tid >> 4, bnn = (tid & 15) * 4;
    for (int k0 = 0; k0 < K; k0 += 16) {
        float4 av = make_float4(0.f, 0.f, 0.f, 0.f);
        if (avalid) av = *(const float4*)(aptr + k0 + ak);
        const float4 bv = *(const float4*)(Bp + (size_t)(k0 + bk) * ldb + bn + bnn);
        As[ak + 0][arow] = av.x; As[ak + 1][arow] = av.y; As[ak + 2][arow] = av.z; As[ak + 3][arow] = av.w;
        *(float4*)&Bs[bk][bnn] = bv;
        __syncthreads();
#pragma unroll
        for (int kk = 0; kk < 16; ++kk) {
            const float4 a = *(const float4*)&As[kk][ty * 4];
            const float4 b = *(const float4*)&Bs[kk][tx * 4];
            acc[0][0] += a.x * b.x; acc[0][1] += a.x * b.y; acc[0][2] += a.x * b.z; acc[0][3] += a.x * b.w;
            acc[1][0] += a.y * b.x; acc[1][1] += a.y * b.y; acc[1][2] += a.y * b.z; acc[1][3] += a.y * b.w;
            acc[2][0] += a.z * b.x; acc[2][1] += a.z * b.y; acc[2][2] += a.z * b.z; acc[2][3] += a.z * b.w;
            acc[3][0] += a.w * b.x; acc[3][1] += a.w * b.y; acc[3][2] += a.w * b.z; acc[3][3] += a.w * b.w;
        }
        __syncthreads();
    }
#pragma unroll
    for (int i = 0; i < 4; ++i) {
        const int r = bm + ty * 4 + i;
        if (MODE == 2) {
            const int tok = slot_tok[r];
            if (tok < ntok) {
                const float w = slot_w[r];
#pragma unroll
                for (int j = 0; j < 4; ++j) atomicAdd(C + (size_t)tok * ldc + bn + tx * 4 + j, w * acc[i][j]);
            }
        } else if (MODE == 3) {
            float4* cp = (float4*)(C + (size_t)r * ldc + bn + tx * 4); const float4 o = *cp;
            *cp = make_float4(o.x + acc[i][0], o.y + acc[i][1], o.z + acc[i][2], o.w + acc[i][3]);
        } else {
            *(float4*)(C + (size_t)r * ldc + bn + tx * 4) = make_float4(acc[i][0], acc[i][1], acc[i][2], acc[i][3]);
        }
    }
}

__global__ void __launch_bounds__(256) g_qk_prep(const float* __restrict__ Z, const float* __restrict__ ZC, const float* __restrict__ qw,
                                                 const float* __restrict__ kw, float* __restrict__ AQ, float* __restrict__ AK, float* __restrict__ AV) {
    const int gid = blockIdx.x * 256 + threadIdx.x;
    const int NLAT = T * 12;
    const float* src; float* dst; const float* nw = nullptr; bool rope = false; int pos = 0;
    if (gid < NLAT) {
        const int row = gid / 12, it = gid % 12, b = row / L, t = row % L; pos = t;
        if (it < 8) { src = Z + (size_t)row * INC + OFF_AQ + it * 64; dst = AQ + (size_t)row * 512 + it * 64; nw = qw; rope = true; }
        else if (it < 10) { src = Z + (size_t)row * INC + OFF_AK + (it - 8) * 64; dst = AK + ((size_t)b * LK + t) * 128 + (it - 8) * 64; nw = kw; rope = true; }
        else { src = Z + (size_t)row * INC + OFF_AV + (it - 10) * 64; dst = AV + ((size_t)b * LK + t) * 128 + (it - 10) * 64; }
    } else {
        const int g2 = gid - NLAT; if (g2 >= TC * 4) return;
        const int row = g2 / 4, it = g2 % 4, b = row / LC, t = row % LC;
        if (it < 2) { src = ZC + (size_t)row * CTXC + OFF_AK + it * 64; dst = AK + ((size_t)b * LK + L + t) * 128 + it * 64; nw = kw; }
        else { src = ZC + (size_t)row * CTXC + OFF_AV + (it - 2) * 64; dst = AV + ((size_t)b * LK + L + t) * 128 + (it - 2) * 64; }
    }
    if (!nw) { for (int d = 0; d < 64; ++d) dst[d] = src[d]; return; }
    float s = 0.f;
    for (int d = 0; d < 64; ++d) s += src[d] * src[d];
    const float rinv = rsqrtf(s * (1.f / 64.f) + EPS);
    const float fr = (float)(pos / 64), fc = (float)(pos % 64);
    for (int i = 0; i < 32; ++i) {
        float a = src[2 * i] * rinv * nw[2 * i], bb = src[2 * i + 1] * rinv * nw[2 * i + 1];
        if (rope) {
            const float freq = powf(10000.f, -(float)(i & 15) / 16.f);
            const float ang = (i < 16 ? fr : fc) * freq;
            const float cs = cosf(ang), sn = sinf(ang);
            const float oa = a * cs - bb * sn, ob = a * sn + bb * cs; a = oa; bb = ob;
        }
        dst[2 * i] = a; dst[2 * i + 1] = bb;
    }
}

__global__ void __launch_bounds__(256) g_attn(const float* __restrict__ AQ, const float* __restrict__ AK, const float* __restrict__ AV, float* __restrict__ CAT) {
    const int gid = blockIdx.x * 256 + threadIdx.x;
    const int part = gid & 3, qi = gid >> 2;
    const int t = qi % L, hq = (qi / L) % AH, b = qi / (L * AH), kvh = hq / 4;
    const size_t row = (size_t)b * L + t;
    float q[16], acc[16];
#pragma unroll
    for (int d = 0; d < 16; ++d) { q[d] = AQ[row * 512 + hq * 64 + part * 16 + d] * 0.125f; acc[d] = 0.f; }
    float m = -1e30f, l = 0.f;
    const float* kp = AK + (size_t)b * LK * 128 + kvh * 64 + part * 16;
    const float* vp = AV + (size_t)b * LK * 128 + kvh * 64 + part * 16;
    for (int j = 0; j < LK; ++j) {
        float s = 0.f;
#pragma unroll
        for (int d = 0; d < 16; ++d) s += q[d] * kp[(size_t)j * 128 + d];
        s += __shfl_xor(s, 1); s += __shfl_xor(s, 2);
        const float mn = fmaxf(m, s), corr = __expf(m - mn), p = __expf(s - mn);
        l = l * corr + p; m = mn;
#pragma unroll
        for (int d = 0; d < 16; ++d) acc[d] = acc[d] * corr + p * vp[(size_t)j * 128 + d];
    }
    const float il = 1.f / l;
#pragma unroll
    for (int d = 0; d < 16; ++d) CAT[row * D + hq * 64 + part * 16 + d] = acc[d] * il;
}

__global__ void __launch_bounds__(256) g_ret(const float* __restrict__ Z, const float* __restrict__ ZC, const float* __restrict__ dfw,
                                             const float* __restrict__ dbw, float* __restrict__ CAT) {
    const int gid = blockIdx.x * 256 + threadIdx.x;
    const int part = gid & 3, qi = gid >> 2;
    const int t = qi % L, h = (qi / L) % RH, b = qi / (L * RH);
    const size_t row = (size_t)b * L + t;
    const float l2f = -log1pf(__expf(-dfw[h])) * 1.4426950408889634f, l2b = -log1pf(__expf(-dbw[h])) * 1.4426950408889634f;
    float q[16], acc[16];
#pragma unroll
    for (int d = 0; d < 16; ++d) { q[d] = Z[row * INC + OFF_RQ + h * 64 + part * 16 + d] * 0.125f; acc[d] = 0.f; }
    const float* kp = Z + (size_t)b * L * INC + OFF_RK + h * 64 + part * 16;
    const float* vp = Z + (size_t)b * L * INC + OFF_RV + h * 64 + part * 16;
    for (int j = 0; j < L; ++j) {
        float s = 0.f;
#pragma unroll
        for (int d = 0; d < 16; ++d) s += q[d] * kp[(size_t)j * INC + d];
        s += __shfl_xor(s, 1); s += __shfl_xor(s, 2);
        const int df = t - j;
        float w = 0.f;
        if (df >= 0) w += exp2f((float)df * l2f);
        if (df <= 0) w += exp2f((float)(-df) * l2b);
        const float p = s * w;
#pragma unroll
        for (int d = 0; d < 16; ++d) acc[d] += p * vp[(size_t)j * INC + d];
    }
    const float* kc = ZC + (size_t)b * LC * CTXC + OFF_RK + h * 64 + part * 16;
    const float* vc = ZC + (size_t)b * LC * CTXC + OFF_RV + h * 64 + part * 16;
    for (int j = 0; j < LC; ++j) {
        float s = 0.f;
#pragma unroll
        for (int d = 0; d < 16; ++d) s += q[d] * kc[(size_t)j * CTXC + d];
        s += __shfl_xor(s, 1); s += __shfl_xor(s, 2);
        const float w = exp2f((float)(t + LC - j) * l2f) + exp2f((float)(L - t + j) * l2b);
        const float p = s * w;
#pragma unroll
        for (int d = 0; d < 16; ++d) acc[d] += p * vc[(size_t)j * CTXC + d];
    }
    float ss = 0.f;
#pragma unroll
    for (int d = 0; d < 16; ++d) ss += acc[d] * acc[d];
    ss += __shfl_xor(ss, 1); ss += __shfl_xor(ss, 2);
    const float rinv = rsqrtf(ss * (1.f / 64.f) + EPS);
#pragma unroll
    for (int d = 0; d < 16; ++d) {
        const float g = Z[row * INC + OFF_RG + h * 64 + part * 16 + d];
        CAT[row * D + 512 + h * 64 + part * 16 + d] = acc[d] * rinv * siluf(g);
    }
}

__global__ void __launch_bounds__(256) g_resid(const float* __restrict__ x, const float* __restrict__ y, const float* __restrict__ y2,
                                               const float* __restrict__ modv, int goff, float* __restrict__ out) {
    const size_t i = (size_t)blockIdx.x * 256 + threadIdx.x;
    const size_t e = i * 4; const int col = (int)(e % D), b = (int)(e / ((size_t)L * D));
    const float4 xv = ((const float4*)x)[i]; float4 yv = ((const float4*)y)[i];
    if (y2) { const float4 z = ((const float4*)y2)[i]; yv.x += z.x; yv.y += z.y; yv.z += z.z; yv.w += z.w; }
    const float4 g = *(const float4*)(modv + (size_t)b * (6 * D) + goff + col);
    ((float4*)out)[i] = make_float4(xv.x + g.x * yv.x, xv.y + g.y * yv.y, xv.z + g.z * yv.z, xv.w + g.w * yv.w);
}

__global__ void __launch_bounds__(256) g_route(const float* __restrict__ logits, const float* __restrict__ rbias, int* __restrict__ idx, float* __restrict__ wout) {
    const int tok = blockIdx.x * 4 + (threadIdx.x >> 6), lane = threadIdx.x & 63;
    const float4 lg = ((const float4*)(logits + (size_t)tok * NE))[lane];
    const float4 bi = ((const float4*)rbias)[lane];
    float s0 = sigmoidf_(lg.x), s1 = sigmoidf_(lg.y), s2 = sigmoidf_(lg.z), s3 = sigmoidf_(lg.w);
    float v0 = s0 + bi.x, v1 = s1 + bi.y, v2 = s2 + bi.z, v3 = s3 + bi.w;
    float gs = 0.f;
    {
        float a0 = v0, a1 = v1, a2 = v2, a3 = v3;
        for (int r = 0; r < 2; ++r) {
            float mv = a0; int mi = lane * 4;
            if (a1 > mv) { mv = a1; mi = lane * 4 + 1; }
            if (a2 > mv) { mv = a2; mi = lane * 4 + 2; }
            if (a3 > mv) { mv = a3; mi = lane * 4 + 3; }
            for (int o = 1; o < 8; o <<= 1) {
                const float ov = __shfl_xor(mv, o); const int oi = __shfl_xor(mi, o);
                if (ov > mv || (ov == mv && oi < mi)) { mv = ov; mi = oi; }
            }
            gs += mv;
            if (mi == lane * 4) a0 = -INFINITY; if (mi == lane * 4 + 1) a1 = -INFINITY;
            if (mi == lane * 4 + 2) a2 = -INFINITY; if (mi == lane * 4 + 3) a3 = -INFINITY;
        }
    }
    const int g = lane >> 3; int rank = 0;
    for (int g2 = 0; g2 < 8; ++g2) { const float o = __shfl(gs, g2 * 8); if (o > gs || (o == gs && g2 < g)) ++rank; }
    if (rank >= 4) { v0 = v1 = v2 = v3 = -INFINITY; }
    float wsum = 0.f, myw = 0.f; int myi = 0;
    for (int r = 0; r < TOPK; ++r) {
        float mv = v0; int mi = lane * 4;
        if (v1 > mv) { mv = v1; mi = lane * 4 + 1; }
        if (v2 > mv) { mv = v2; mi = lane * 4 + 2; }
        if (v3 > mv) { mv = v3; mi = lane * 4 + 3; }
        for (int o = 1; o < 64; o <<= 1) {
            const float ov = __shfl_xor(mv, o); const int oi = __shfl_xor(mi, o);
            if (ov > mv || (ov == mv && oi < mi)) { mv = ov; mi = oi; }
        }
        const int own = mi >> 2, sub = mi & 3;
        float sv = sub == 0 ? s0 : sub == 1 ? s1 : sub == 2 ? s2 : s3;
        sv = __shfl(sv, own);
        wsum += sv;
        if (lane == r) { myw = sv; myi = mi; }
        if (lane == own) { if (sub == 0) v0 = -INFINITY; if (sub == 1) v1 = -INFINITY; if (sub == 2) v2 = -INFINITY; if (sub == 3) v3 = -INFINITY; }
    }
    if (lane < TOPK) { idx[(size_t)tok * TOPK + lane] = myi; wout[(size_t)tok * TOPK + lane] = myw / wsum * 2.5f; }
}

__global__ void __launch_bounds__(256) g_count(const int* __restrict__ idx, int* __restrict__ cnt) {
    const int i = blockIdx.x * 256 + threadIdx.x; atomicAdd(&cnt[idx[i]], 1);
}
__global__ void __launch_bounds__(256) g_offsets(const int* __restrict__ cnt, int* __restrict__ pstart, int* __restrict__ blk_e) {
    __shared__ int ps[NE + 1];
    if (threadIdx.x == 0) { int a = 0; for (int e = 0; e < NE; ++e) { ps[e] = a; a += (cnt[e] + GBLK - 1) / GBLK * GBLK; } ps[NE] = a; }
    __syncthreads();
    pstart[threadIdx.x] = ps[threadIdx.x];
    for (int bI = threadIdx.x; bI < NBLK_G; bI += 256) blk_e[bI] = -1;
    __syncthreads();
    const int e = threadIdx.x;
    for (int s = ps[e]; s < ps[e + 1]; s += GBLK) blk_e[s / GBLK] = e;
}
__global__ void __launch_bounds__(256) g_slot_init(int* __restrict__ slot_tok, float* __restrict__ slot_w) {
    const int i = blockIdx.x * 256 + threadIdx.x; if (i < NSLOT_G) { slot_tok[i] = T; slot_w[i] = 0.f; }
}
__global__ void __launch_bounds__(256) g_fill(const int* __restrict__ idx, const float* __restrict__ w, const int* __restrict__ pstart,
                                              int* __restrict__ fillc, int* __restrict__ slot_tok, float* __restrict__ slot_w) {
    const int i = blockIdx.x * 256 + threadIdx.x; const int e = idx[i];
    const int pos = atomicAdd(&fillc[e], 1); const int s = pstart[e] + pos;
    slot_tok[s] = i / TOPK; slot_w[s] = w[i];
}
__global__ void __launch_bounds__(256) g_act(const float* __restrict__ G, const float* __restrict__ U, float* __restrict__ A, size_t n4) {
    const size_t i = (size_t)blockIdx.x * 256 + threadIdx.x; if (i >= n4) return;
    const float4 g = ((const float4*)G)[i], u = ((const float4*)U)[i];
    ((float4*)A)[i] = make_float4(siluf(g.x) * u.x, siluf(g.y) * u.y, siluf(g.z) * u.z, siluf(g.w) * u.w);
}

#endif
constexpr int N_PHASES = 11;
__global__ void __launch_bounds__(NTHR, 2) mega_fwd(Params p) {
    extern __shared__ __attribute__((aligned(16))) unsigned char lds_raw[];
    Ctx F;
    F.lds = (LAS unsigned char*)lds_raw;
    F.ws = p.ws; F.out = p.out;
#pragma unroll
    for (int i = 0; i < 22; ++i) F.in[i] = p.in[i];
    F.wave = __builtin_amdgcn_readfirstlane((int)threadIdx.x >> 6);
    F.G = gridDim.x; F.bx = blockIdx.x; F.vcu = (F.G % 8 == 0) ? (F.bx % 8) * (F.G / 8) + F.bx / 8 : F.bx;
    for (int u = threadIdx.x; u < (LDS_BYTES - LDSCTL_OFF) / 4; u += NTHR) ((LAS unsigned*)(F.lds + LDSCTL_OFF))[u] = 0u;
    __syncthreads();
    volatile LAS unsigned* MISC = (volatile LAS unsigned*)(F.lds + MISC_OFF);
    XcdBarrier bar = xcd_barrier_post((unsigned*)(F.ws + WS_CTL) + CW_BAR + p.li * XCD_BAR_WORDS, MISC + 8, threadIdx.x == 0);
    const int lo = p.ph_lo, hi = p.ph_hi;
#ifndef PH_MASK
#define PH_MASK 0xFFFF
#endif
#define IN(k) (((PH_MASK >> (k)) & 1) && lo <= (k) && (k) < hi)
#ifndef REP_MASK
#define REP_MASK 0
#endif
#define REP(k) ((REP_MASK >> (k)) & 1)
#define SEAM(k) do { if (IN(k) && IN((k) + 1)) xcd_barrier(bar, FTID == 0); } while (0)
    if (IN(0)) { phase_p0(F); }   SEAM(0);
    if (IN(1)) { phase_p0b(F); }  SEAM(1);
    if (IN(2)) { phase_p1(F); }   SEAM(2);
    if (IN(3)) { phase_r1(F); }   SEAM(3);
    if (IN(4)) { phase_mix(F); }  SEAM(4);
    if (IN(5)) { phase_p4(F); }   SEAM(5);
    if (IN(6)) { phase_p5(F); }   SEAM(6);
    if (IN(7)) { phase_p6(F); }   SEAM(7);
    if (IN(8)) { phase_p7(F); }   SEAM(8);
    if (IN(9)) { phase_moe(F); }  SEAM(9);
    if (IN(10)) { phase_final(F); }
#undef IN
#undef SEAM
}

#if DBG
struct CmpArgs { const void* mptr; const void* mptr2; int mbf16; int rpb; int bstride; int roff; int mpitch; int mcoff; const float* gptr; int gpitch; int gcoff; float gscale; int gsilu; int rows; int cols; };
__global__ void __launch_bounds__(256) dbg_compare(CmpArgs a, double* accum) {
    const size_t n = (size_t)a.rows * a.cols; double d2 = 0.0, r2 = 0.0;
    for (size_t i = (size_t)blockIdx.x * 256 + threadIdx.x; i < n; i += (size_t)gridDim.x * 256) {
        const int r = (int)(i / a.cols), c = (int)(i % a.cols);
        const size_t mi = ((size_t)(r / a.rpb) * a.bstride + (r % a.rpb) + a.roff) * a.mpitch + a.mcoff + c;
        float mv = a.mbf16 ? bf2f(((const bf16_t*)a.mptr)[mi]) : ((const float*)a.mptr)[mi];
        if (a.mptr2) mv += a.mbf16 ? bf2f(((const bf16_t*)a.mptr2)[mi]) : ((const float*)a.mptr2)[mi];
        float gv = a.gptr[(size_t)r * a.gpitch + a.gcoff + c] * a.gscale; if (a.gsilu) gv = siluf(gv);
        const double d = (double)mv - (double)gv; d2 += d * d; r2 += (double)gv * gv;
    }
    for (int o = 32; o > 0; o >>= 1) { d2 += __shfl_xor(d2, o); r2 += __shfl_xor(r2, o); }
    if ((threadIdx.x & 63) == 0) { atomicAdd(accum, d2); atomicAdd(accum + 1, r2); }
}
__global__ void __launch_bounds__(256) dbg_encode(float* out, const double* accum, size_t n4) {
    const double d2 = accum[0], r2 = accum[1];
    float f = 0.f;
    if (r2 > 0.0 && d2 == d2 && d2 < 1e300) { double e = sqrt(d2 / r2); if (e > 1.0) e = 1.0; f = 1.f + (float)sqrt(e); }
    for (size_t i = (size_t)blockIdx.x * 256 + threadIdx.x; i < n4; i += (size_t)gridDim.x * 256) { float4 v = ((float4*)out)[i]; v.x *= f; v.y *= f; v.z *= f; v.w *= f; ((float4*)out)[i] = v; }
}
struct WsG {
    float *modv, *H, *Z, *ZC, *AQ, *AK, *AV, *CAT, *Y, *X1, *H2, *LOG, *rw, *G, *U, *ACT, *MOE, *SG, *SU, *SA, *SD, *slot_w;
    int *ridx, *cnt, *fillc, *pstart, *blk_e, *slot_tok; double* accum;
};
static WsG carve_g(void* d_ws, size_t ws_size, size_t start) {
    char* p = (char*)d_ws + start; WsG w;
    auto take = [&](size_t bytes) { char* r = p; p += (bytes + 255) / 256 * 256; return r; };
    w.accum = (double*)take(256);
    w.cnt = (int*)take(NE * 4); w.fillc = (int*)take(NE * 4); w.pstart = (int*)take((NE + 1) * 4); w.blk_e = (int*)take(NBLK_G * 4);
    w.modv = (float*)take((size_t)9 * 6 * D * 4);
    w.H = (float*)take((size_t)(T + TC) * D * 4);
    w.Z = (float*)take((size_t)T * INC * 4); w.ZC = (float*)take((size_t)TC * CTXC * 4);
    w.AQ = (float*)take((size_t)T * 512 * 4); w.AK = (float*)take((size_t)NB * LK * 128 * 4); w.AV = (float*)take((size_t)NB * LK * 128 * 4);
    w.CAT = (float*)take((size_t)T * D * 4);
    w.Y = (float*)take((size_t)T * D * 4); w.X1 = (float*)take((size_t)T * D * 4);
    w.LOG = (float*)take((size_t)T * NE * 4); w.rw = (float*)take((size_t)NASSIGN * 4); w.ridx = (int*)take((size_t)NASSIGN * 4);
    w.slot_tok = (int*)take((size_t)NSLOT_G * 4); w.slot_w = (float*)take((size_t)NSLOT_G * 4);
    w.SD = nullptr; w.SG = (float*)take((size_t)T * FF * 4); w.SU = (float*)take((size_t)T * FF * 4); w.SA = w.SG;
    w.H2 = w.H; w.MOE = w.Y;
    w.G = w.Z; w.U = w.Z + (size_t)NSLOT_G * FF; w.ACT = w.G;
    if ((size_t)(p - (char*)d_ws) > ws_size || (char*)(w.U + (size_t)NSLOT_G * FF) > (char*)w.Y) { fprintf(stderr, "kernel_launch(DBG): workspace too small: need %zu have %zu\n", (size_t)(p - (char*)d_ws), ws_size); w.accum = nullptr; }
    return w;
}
static void run_golden(void* const* d_in, float* out, const WsG& w, hipStream_t stream) {
    const float* x = (const float*)d_in[0]; const float* c = (const float*)d_in[1]; const float* ctx = (const float*)d_in[2]; const float* cctx = (const float*)d_in[3];
    const float* w_mod = (const float*)d_in[4]; const float* b_mod = (const float*)d_in[5]; const float* n1w = (const float*)d_in[6]; const float* n2w = (const float*)d_in[7];
    const float* w_in = (const float*)d_in[8]; const float* qnw = (const float*)d_in[9]; const float* knw = (const float*)d_in[10];
    const float* dfw = (const float*)d_in[11]; const float* dbw = (const float*)d_in[12]; const float* w_out = (const float*)d_in[13];
    const float* rw = (const float*)d_in[14]; const float* rb = (const float*)d_in[15];
    const float* ewg = (const float*)d_in[16]; const float* ewu = (const float*)d_in[17]; const float* ewd = (const float*)d_in[18];
    const float* swg = (const float*)d_in[19]; const float* swu = (const float*)d_in[20]; const float* swd = (const float*)d_in[21];
    (void)hipMemsetAsync(w.cnt, 0, NE * 4, stream); (void)hipMemsetAsync(w.fillc, 0, NE * 4, stream);
    g_mod<<<dim3(6 * D / 256, 9), 256, 0, stream>>>(c, cctx, w_mod, b_mod, w.modv);
    g_norm_mod<<<T, 256, 0, stream>>>(x, n1w, w.modv, 0, D, L, -1, w.H);
    g_norm_mod<<<TC, 256, 0, stream>>>(ctx, n1w, w.modv, 0, D, LC, 8, w.H + (size_t)T * D);
    g_sgemm<0><<<dim3(INC / 64, T / 64), 256, 0, stream>>>(w.H, D, w_in, INC, 0, w.Z, INC, D, nullptr, nullptr, nullptr, 0);
    g_sgemm<0><<<dim3(CTXC / 64, TC / 64), 256, 0, stream>>>(w.H + (size_t)T * D, D, w_in, INC, 0, w.ZC, CTXC, D, nullptr, nullptr, nullptr, 0);
    g_qk_prep<<<(T * 12 + TC * 4 + 255) / 256, 256, 0, stream>>>(w.Z, w.ZC, qnw, knw, w.AQ, w.AK, w.AV);
    g_attn<<<NB * AH * L * 4 / 256, 256, 0, stream>>>(w.AQ, w.AK, w.AV, w.CAT);
    g_ret<<<NB * RH * L * 4 / 256, 256, 0, stream>>>(w.Z, w.ZC, dfw, dbw, w.CAT);
    g_sgemm<0><<<dim3(D / 64, T / 64), 256, 0, stream>>>(w.CAT, D, w_out, D, 0, w.Y, D, D, nullptr, nullptr, nullptr, 0);
    g_resid<<<T * D / 4 / 256, 256, 0, stream>>>(x, w.Y, nullptr, w.modv, 2 * D, w.X1);
}
static void run_golden_tail(void* const* d_in, float* out, const WsG& w, hipStream_t stream) {
    const float* n2w = (const float*)d_in[7]; const float* rw = (const float*)d_in[14]; const float* rb = (const float*)d_in[15];
    const float* ewg = (const float*)d_in[16]; const float* ewu = (const float*)d_in[17]; const float* ewd = (const float*)d_in[18];
    const float* swg = (const float*)d_in[19]; const float* swu = (const float*)d_in[20]; const float* swd = (const float*)d_in[21];
    g_norm_mod<<<T, 256, 0, stream>>>(w.X1, n2w, w.modv, 3 * D, 4 * D, L, -1, w.H2);
    g_sgemm<0><<<dim3(NE / 64, T / 64), 256, 0, stream>>>(w.H2, D, rw, NE, 0, w.LOG, NE, D, nullptr, nullptr, nullptr, 0);
    g_route<<<T / 4, 256, 0, stream>>>(w.LOG, rb, w.ridx, w.rw);
    g_count<<<NASSIGN / 256, 256, 0, stream>>>(w.ridx, w.cnt);
    g_offsets<<<1, 256, 0, stream>>>(w.cnt, w.pstart, w.blk_e);
    g_slot_init<<<(NSLOT_G + 255) / 256, 256, 0, stream>>>(w.slot_tok, w.slot_w);
    g_fill<<<NASSIGN / 256, 256, 0, stream>>>(w.ridx, w.rw, w.pstart, w.fillc, w.slot_tok, w.slot_w);
}
static void run_golden_tail2(void* const* d_in, float* out, const WsG& w, hipStream_t stream) {
    const float* ewg = (const float*)d_in[16]; const float* ewu = (const float*)d_in[17]; const float* ewd = (const float*)d_in[18];
    const float* swg = (const float*)d_in[19]; const float* swu = (const float*)d_in[20]; const float* swd = (const float*)d_in[21];
    g_sgemm<1><<<dim3(FF / 64, NBLK_G), 256, 0, stream>>>(w.H2, D, ewg, FF, (size_t)D * FF, w.G, FF, D, w.slot_tok, w.slot_w, w.blk_e, T);
    g_sgemm<1><<<dim3(FF / 64, NBLK_G), 256, 0, stream>>>(w.H2, D, ewu, FF, (size_t)D * FF, w.U, FF, D, w.slot_tok, w.slot_w, w.blk_e, T);
    g_act<<<(unsigned)(((size_t)NSLOT_G * FF / 4 + 255) / 256), 256, 0, stream>>>(w.G, w.U, w.ACT, (size_t)NSLOT_G * FF / 4);
    (void)hipMemsetAsync(w.MOE, 0, (size_t)T * D * 4, stream);
    g_sgemm<2><<<dim3(D / 64, NBLK_G), 256, 0, stream>>>(w.ACT, FF, ewd, D, (size_t)FF * D, w.MOE, D, FF, w.slot_tok, w.slot_w, w.blk_e, T);
    g_sgemm<0><<<dim3(FF / 64, T / 64), 256, 0, stream>>>(w.H2, D, swg, FF, 0, w.SG, FF, D, nullptr, nullptr, nullptr, 0);
    g_sgemm<0><<<dim3(FF / 64, T / 64), 256, 0, stream>>>(w.H2, D, swu, FF, 0, w.SU, FF, D, nullptr, nullptr, nullptr, 0);
    g_act<<<(unsigned)(((size_t)T * FF / 4 + 255) / 256), 256, 0, stream>>>(w.SG, w.SU, w.SA, (size_t)T * FF / 4);
    g_sgemm<3><<<dim3(D / 64, T / 64), 256, 0, stream>>>(w.SA, FF, swd, D, 0, w.MOE, D, FF, nullptr, nullptr, nullptr, 0);
    g_resid<<<T * D / 4 / 256, 256, 0, stream>>>(w.X1, w.MOE, nullptr, w.modv, 5 * D, out);
}
#endif

extern "C" void kernel_launch(void* const* d_in, const int* in_sizes, int n_in, void* d_out, int out_size, void* d_ws, size_t ws_size, hipStream_t stream) {
    static int grid = 0;
    if (grid == 0) {
        int dev = 0, cus = 0, per_cu = 0;
        if (hipGetDevice(&dev) != hipSuccess || hipDeviceGetAttribute(&cus, hipDeviceAttributeMultiprocessorCount, dev) != hipSuccess) { fprintf(stderr, "kernel_launch: device query failed\n"); grid = -1; return; }
        if (hipFuncSetAttribute((const void*)mega_fwd, hipFuncAttributeMaxDynamicSharedMemorySize, LDS_BYTES) != hipSuccess) { fprintf(stderr, "kernel_launch: hipFuncSetAttribute failed\n"); grid = -1; return; }
        if (hipOccupancyMaxActiveBlocksPerMultiprocessor(&per_cu, (const void*)mega_fwd, NTHR, LDS_BYTES) != hipSuccess || per_cu < 1) { fprintf(stderr, "kernel_launch: occupancy query says %d blocks/CU\n", per_cu); per_cu = 1; }
        (void)hipGetLastError();
        grid = cus;
        if (grid != 256) fprintf(stderr, "kernel_launch: built for 256 CUs, device has %d\n", cus);
        if (ws_size < WS_END_B) { fprintf(stderr, "kernel_launch: workspace too small\n"); grid = -1; return; }
    }
    if (grid < 0) return;
    (void)hipMemsetAsync((char*)d_ws + WS_CTL, 0, CTL_ZERO_BYTES, stream);
    Params p{};
    for (int i = 0; i < 22; ++i) p.in[i] = (const float*)d_in[i];
    p.out = (float*)d_out; p.ws = (unsigned char*)d_ws;
#if DBG
    WsG w = carve_g(d_ws, ws_size, WS_END_A);
    if (!w.accum) { (void)hipMemsetAsync(d_out, 0, (size_t)T * D * 4, stream); return; }
    run_golden(d_in, (float*)d_out, w, stream);
    p.ph_lo = 0; p.ph_hi = DBG_PH_HI;
    { void* args[] = {&p}; hipError_t e = hipLaunchCooperativeKernel((const void*)mega_fwd, dim3(grid), dim3(NTHR), args, LDS_BYTES, stream);
      if (e != hipSuccess) fprintf(stderr, "cooperative launch failed: %s\n", hipGetErrorString(e)); }
    (void)hipMemsetAsync(w.accum, 0, 16, stream);
    unsigned char* ws = (unsigned char*)d_ws;
    auto cmp = [&](const void* mp, const void* mp2, int mbf16, int rpb, int bstride, int roff, int mpitch, int mcoff, const float* gp, int gpitch, int gcoff, float gscale, int gsilu, int rows, int cols) {
        CmpArgs a{mp, mp2, mbf16, rpb, bstride, roff, mpitch, mcoff, gp, gpitch, gcoff, gscale, gsilu, rows, cols};
        dbg_compare<<<1024, 256, 0, stream>>>(a, w.accum); };
#if DBG == 1
    cmp(ws + WS_HB, nullptr, 1, TALL, 0, 0, D, 0, w.H, D, 0, 1.f, 0, TALL, D);
#elif DBG == 2
    cmp(ws + WS_QB, nullptr, 1, T, 0, 0, 512, 0, w.AQ, 512, 0, C2, 0, T, 512);
#elif DBG == 3
    cmp(ws + WS_KB, nullptr, 1, NB * LK, 0, 0, 128, 0, w.AK, 128, 0, 1.f, 0, NB * LK, 128);
    cmp(ws + WS_VB, nullptr, 1, NB * LK, 0, 0, 128, 0, w.AV, 128, 0, 1.f, 0, NB * LK, 128);
#elif DBG == 4
    cmp(ws + WS_RKB, nullptr, 1, L, LK, 0, 512, 0, w.Z, INC, OFF_RK, 0.125f, 0, T, 512);
    cmp(ws + WS_RKB, nullptr, 1, LC, LK, L, 512, 0, w.ZC, CTXC, OFF_RK, 0.125f, 0, TC, 512);
    cmp(ws + WS_RVB, nullptr, 1, L, LK, 0, 512, 0, w.Z, INC, OFF_RV, 1.f, 0, T, 512);
    cmp(ws + WS_RVB, nullptr, 1, LC, LK, L, 512, 0, w.ZC, CTXC, OFF_RV, 1.f, 0, TC, 512);
#elif DBG == 5
    cmp(ws + WS_RQB, nullptr, 1, T, 0, 0, 512, 0, w.Z, INC, OFF_RQ, 1.f, 0, T, 512);
    cmp(ws + WS_RGB, nullptr, 1, T, 0, 0, 512, 0, w.Z, INC, OFF_RG, 1.f, 1, T, 512);
#elif DBG == 9
    cmp(ws + WS_CAT, nullptr, 1, T, 0, 0, D, 0, w.CAT, D, 0, 1.f, 0, T, 512);
#elif DBG == 10
    cmp(ws + WS_CAT, nullptr, 1, T, 0, 0, D, 512, w.CAT, D, 512, 1.f, 0, T, 512);
#elif DBG == 11
    cmp(ws + WS_X1, nullptr, 0, T, 0, 0, D, 0, w.X1, D, 0, 1.f, 0, T, D);
#elif DBG == 6
    cmp(ws + WS_QB, nullptr, 1, T, 0, 0, 512, 0, w.AQ, 512, 0, C2, 0, T, 512);
    cmp(ws + WS_KB, nullptr, 1, NB * LK, 0, 0, 128, 0, w.AK, 128, 0, 1.f, 0, NB * LK, 128);
    cmp(ws + WS_VB, nullptr, 1, NB * LK, 0, 0, 128, 0, w.AV, 128, 0, 1.f, 0, NB * LK, 128);
    cmp(ws + WS_RKB, nullptr, 1, L, LK, 0, 512, 0, w.Z, INC, OFF_RK, 0.125f, 0, T, 512);
    cmp(ws + WS_RKB, nullptr, 1, LC, LK, L, 512, 0, w.ZC, CTXC, OFF_RK, 0.125f, 0, TC, 512);
    cmp(ws + WS_RVB, nullptr, 1, L, LK, 0, 512, 0, w.Z, INC, OFF_RV, 1.f, 0, T, 512);
    cmp(ws + WS_RVB, nullptr, 1, LC, LK, L, 512, 0, w.ZC, CTXC, OFF_RV, 1.f, 0, TC, 512);
    cmp(ws + WS_RQB, nullptr, 1, T, 0, 0, 512, 0, w.Z, INC, OFF_RQ, 1.f, 0, T, 512);
    cmp(ws + WS_RGB, nullptr, 1, T, 0, 0, 512, 0, w.Z, INC, OFF_RG, 1.f, 1, T, 512);
#endif
    run_golden_tail(d_in, (float*)d_out, w, stream);
#if DBG == 12
    cmp(ws + WS_H2B, ws + WS_H2B + (size_t)T * D * 2, 1, T, 0, 0, D, 0, w.H2, D, 0, 1.f, 0, T, D);
#elif DBG == 13
    cmp(ws + WS_RWT, nullptr, 0, T, 0, 0, TOPK, 0, w.rw, TOPK, 0, 1.f, 0, T, TOPK);
#endif
    run_golden_tail2(d_in, (float*)d_out, w, stream);
    dbg_encode<<<1024, 256, 0, stream>>>((float*)d_out, w.accum, (size_t)T * D / 4);
#else
    p.ph_lo = 0; p.ph_hi = N_PHASES;
    void* args[] = {&p};
    hipError_t e = hipLaunchCooperativeKernel((const void*)mega_fwd, dim3(grid), dim3(NTHR), args, LDS_BYTES, stream);
    if (e != hipSuccess) fprintf(stderr, "cooperative launch failed: %s (grid %d)\n", hipGetErrorString(e), grid);
#if defined(PROBE_LO)
    for (int r = 0; r < PROBE_N; ++r) { p.ph_lo = PROBE_LO; p.ph_hi = PROBE_HI; p.li = 1 + r;
        (void)hipLaunchCooperativeKernel((const void*)mega_fwd, dim3(grid), dim3(NTHR), args, LDS_BYTES, stream); }
#endif
#endif
}
```
